# Optimizing an MI355X kernel written in HIP

```python
import jax
import jax.numpy as jnp
from jax import lax
import numpy as np

D_MODEL = 1024
BATCH = 4
SEQ = 8192
DEPTH = 2

CHUNK = 64
Q_BLOCK = 128
EPS = 1e-6
ROPE_THETA = 10000.0

MLA_HEADS = 8
MLA_Q_RANK = 384
MLA_KV_RANK = 256
MLA_NOPE = 64
MLA_ROPE = 32
MLA_V = 64

CONV_WIDTH = 512
CONV_K = 3

RET_HEADS = 4
RET_DK = 128
RET_DV = 256

N_GROUPS = 4
EXPERTS_PER_GROUP = 8
N_EXPERTS = N_GROUPS * EXPERTS_PER_GROUP
EXPERT_FF = 512
TOP_K = 2

N_BRANCHES = 3
IN_SIZES = (MLA_Q_RANK, MLA_KV_RANK, MLA_ROPE, CONV_WIDTH, CONV_WIDTH, CONV_WIDTH, RET_HEADS * RET_DK, RET_HEADS * RET_DK, RET_HEADS * RET_DV, RET_HEADS * RET_DV, N_BRANCHES * D_MODEL)
IN_TOTAL = sum(IN_SIZES)

kernel_name = 'hybrid_mla_shortconv_retention_hmoe'


def _rmsnorm(x, g):
    xf = x.astype(jnp.float32)
    y = xf * lax.rsqrt(jnp.mean(xf * xf, axis=-1, keepdims=True) + EPS)
    return (y * g.astype(jnp.float32)).astype(x.dtype)


def _rope_tables(positions, dim):
    inv = ROPE_THETA ** (-jnp.arange(0, dim, 2, dtype=jnp.float32) / dim)
    ang = positions.astype(jnp.float32)[..., None] * inv
    return jnp.cos(ang)[:, :, None, :], jnp.sin(ang)[:, :, None, :]


def _apply_rope(x, cos, sin):
    xf = x.astype(jnp.float32)
    x1, x2 = jnp.split(xf, 2, axis=-1)
    return jnp.concatenate([x1 * cos - x2 * sin, x1 * sin + x2 * cos], axis=-1).astype(x.dtype)


def _split_cols(a, sizes):
    outs = []
    start = 0
    for size in sizes:
        outs.append(a[..., start:start + size])
        start += size
    return outs


def _mla_branch(q_lat, kv_lat, k_rope, q_norm_g, kv_norm_g, w_uq, w_ukv, w_o, cos, sin):
    b, s, _ = q_lat.shape
    dq = MLA_NOPE + MLA_ROPE
    q = (_rmsnorm(q_lat, q_norm_g) @ w_uq).reshape(b, s, MLA_HEADS, dq)
    q = jnp.concatenate([q[..., :MLA_NOPE], _apply_rope(q[..., MLA_NOPE:], cos, sin)], axis=-1)
    kv = (_rmsnorm(kv_lat, kv_norm_g) @ w_ukv).reshape(b, s, MLA_HEADS, MLA_NOPE + MLA_V)
    k_nope, v = kv[..., :MLA_NOPE], kv[..., MLA_NOPE:]
    k_pe = _apply_rope(k_rope[:, :, None, :], cos, sin)
    k = jnp.concatenate([k_nope, jnp.broadcast_to(k_pe, (b, s, MLA_HEADS, MLA_ROPE))], axis=-1)
    scale = dq ** -0.5
    n_blocks = s // Q_BLOCK
    q_blocks = q.reshape(b, n_blocks, Q_BLOCK, MLA_HEADS, dq).swapaxes(0, 1)
    key_chunk = jnp.arange(s) // CHUNK

    def attend(args):
        q_blk, blk = args
        q_chunk = (blk * Q_BLOCK + jnp.arange(Q_BLOCK)) // CHUNK
        sc = jnp.einsum('bqhd,bkhd->bhqk', q_blk, k, preferred_element_type=jnp.float32) * scale
        sc = jnp.where(key_chunk[None, :] <= q_chunk[:, None], sc, -jnp.inf)
        p = jax.nn.softmax(sc, axis=-1)
        return jnp.einsum('bhqk,bkhd->bqhd', p.astype(v.dtype), v)

    o = lax.map(attend, (q_blocks, jnp.arange(n_blocks)))
    o = o.swapaxes(0, 1).reshape(b, s, MLA_HEADS * MLA_V)
    return o @ w_o


def _shortconv_branch(b_gate, c_gate, xv, conv_w, w_o):
    u = c_gate * xv
    y = lax.conv_general_dilated(u, conv_w[:, None, :], window_strides=(1,), padding=((CONV_K - 1, 0),), dimension_numbers=('NWC', 'WIO', 'NWC'), feature_group_count=CONV_WIDTH)
    return (b_gate * y) @ w_o


def _retention_branch(q, k, v, g, w_o, cos, sin):
    b, s, _ = q.shape
    n = s // CHUNK
    q = _apply_rope(q.reshape(b, s, RET_HEADS, RET_DK), cos, sin).astype(jnp.float32)
    k = _apply_rope(k.reshape(b, s, RET_HEADS, RET_DK), cos, sin).astype(jnp.float32) * (RET_DK ** -0.5)
    v = v.reshape(b, s, RET_HEADS, RET_DV).astype(jnp.float32)
    log_gamma = jnp.log(1.0 - 2.0 ** (-5.0 - jnp.arange(RET_HEADS, dtype=jnp.float32)))
    pos = jnp.arange(CHUNK, dtype=jnp.float32)
    intra_decay = jnp.exp(log_gamma[:, None, None] * jnp.abs(pos[:, None] - pos[None, :]))[None]
    q_decay = jnp.exp(log_gamma[:, None] * (pos + 1.0))[None, :, :, None]
    k_decay = jnp.exp(log_gamma[:, None] * (CHUNK - 1.0 - pos))[None, :, :, None]
    chunk_decay = jnp.exp(log_gamma * CHUNK)[None, :, None, None]

    def to_chunks(a):
        return a.reshape(b, n, CHUNK, RET_HEADS, a.shape[-1]).transpose(1, 0, 3, 2, 4)

    def step(state, inp):
        qc, kc, vc = inp
        sc = jnp.einsum('bhid,bhjd->bhij', qc, kc) * intra_decay
        o = jnp.einsum('bhij,bhjv->bhiv', sc, vc) + jnp.einsum('bhid,bhdv->bhiv', qc, state) * q_decay
        state = state * chunk_decay + jnp.einsum('bhjd,bhjv->bhdv', kc * k_decay, vc)
        return state, o

    state0 = jnp.zeros((b, RET_HEADS, RET_DK, RET_DV), jnp.float32)
    _, o = lax.scan(step, state0, (to_chunks(q), to_chunks(k), to_chunks(v)))
    o = o.transpose(1, 0, 3, 2, 4).reshape(b, s, RET_HEADS, RET_DV)
    o = o * lax.rsqrt(jnp.mean(o * o, axis=-1, keepdims=True) + EPS)
    o = o.reshape(b, s, RET_HEADS * RET_DV).astype(g.dtype)
    return (jax.nn.silu(g) * o) @ w_o


def _hier_moe(h, w_rg, b_rg, w_re, b_re, w_gate, w_up, w_down):
    b, s, d = h.shape
    t = h.reshape(b * s, d)
    n_tok = t.shape[0]
    g_prob = jax.nn.softmax((t @ w_rg).astype(jnp.float32) + b_rg.astype(jnp.float32), axis=-1)
    g_val, g_idx = lax.top_k(g_prob, 1)
    e_logits = ((t @ w_re).astype(jnp.float32) + b_re.astype(jnp.float32)).reshape(n_tok, N_GROUPS, EXPERTS_PER_GROUP)
    e_logits = jnp.take_along_axis(e_logits, g_idx[:, :, None], axis=1)[:, 0]
    e_val, e_idx = lax.top_k(jax.nn.softmax(e_logits, axis=-1), TOP_K)
    e_val = e_val / jnp.sum(e_val, axis=-1, keepdims=True)
    weights = g_val * e_val
    expert_id = g_idx * EXPERTS_PER_GROUP + e_idx
    combine = jnp.einsum('tk,tke->et', weights, jax.nn.one_hot(expert_id, N_EXPERTS, dtype=jnp.float32))

    def expert(acc, inp):
        wg, wu, wd, gate = inp
        hid = jax.nn.silu(t @ wg) * (t @ wu)
        return acc + gate[:, None] * (hid @ wd).astype(jnp.float32), None

    out, _ = lax.scan(expert, jnp.zeros((n_tok, d), jnp.float32), (w_gate, w_up, w_down, combine))
    return out.reshape(b, s, d).astype(h.dtype)


def _normal(key, shape, scale):
    return jax.random.normal(key, shape, jnp.float32) * scale


def setup_inputs(seed: int = 0) -> dict:
    key = jax.random.key(seed)
    ks = jax.random.split(key, 32)
    D = D_MODEL
    x = _normal(ks[0], (BATCH, SEQ, D), 1.0)
    c = _normal(ks[1], (BATCH, D), 1.0)
    positions = jax.random.randint(ks[2], (BATCH, 1), 0, 4096, dtype=jnp.int32) + jnp.arange(SEQ, dtype=jnp.int32)[None, :]
    return {
        'x': x,
        'c': c,
        'positions': positions,
        'w_ada': _normal(ks[3], (DEPTH, D, 6 * D), 0.5 * D ** -0.5),
        'b_ada': _normal(ks[4], (DEPTH, 6 * D), 0.02),
        'norm_mix_g': 1.0 + _normal(ks[5], (DEPTH, D), 0.05),
        'norm_ffn_g': 1.0 + _normal(ks[6], (DEPTH, D), 0.05),
        'w_in': _normal(ks[7], (DEPTH, D, IN_TOTAL), D ** -0.5),
        'mla_q_norm_g': 1.0 + _normal(ks[8], (DEPTH, MLA_Q_RANK), 0.05),
        'mla_kv_norm_g': 1.0 + _normal(ks[9], (DEPTH, MLA_KV_RANK), 0.05),
        'w_uq': _normal(ks[10], (DEPTH, MLA_Q_RANK, MLA_HEADS * (MLA_NOPE + MLA_ROPE)), MLA_Q_RANK ** -0.5),
        'w_ukv': _normal(ks[11], (DEPTH, MLA_KV_RANK, MLA_HEADS * (MLA_NOPE + MLA_V)), MLA_KV_RANK ** -0.5),
        'w_o_mla': _normal(ks[12], (DEPTH, MLA_HEADS * MLA_V, D), (MLA_HEADS * MLA_V) ** -0.5),
        'conv_w': _normal(ks[13], (DEPTH, CONV_K, CONV_WIDTH), CONV_K ** -0.5),
        'w_o_conv': _normal(ks[14], (DEPTH, CONV_WIDTH, D), CONV_WIDTH ** -0.5),
        'w_o_ret': _normal(ks[15], (DEPTH, RET_HEADS * RET_DV, D), (RET_HEADS * RET_DV) ** -0.5),
        'w_mix_out': _normal(ks[16], (DEPTH, D, D), D ** -0.5),
        'w_route_group': _normal(ks[17], (DEPTH, D, N_GROUPS), D ** -0.5),
        'b_route_group': _normal(ks[18], (DEPTH, N_GROUPS), 0.01),
        'w_route_expert': _normal(ks[19], (DEPTH, D, N_EXPERTS), D ** -0.5),
        'b_route_expert': _normal(ks[20], (DEPTH, N_EXPERTS), 0.01),
        'w_exp_gate': _normal(ks[21], (DEPTH, N_EXPERTS, D, EXPERT_FF), D ** -0.5),
        'w_exp_up': _normal(ks[22], (DEPTH, N_EXPERTS, D, EXPERT_FF), D ** -0.5),
        'w_exp_down': _normal(ks[23], (DEPTH, N_EXPERTS, EXPERT_FF, D), EXPERT_FF ** -0.5),
        'final_g': 1.0 + _normal(ks[24], (D,), 0.05),
    }


def reference(x, c, positions, w_ada, b_ada, norm_mix_g, norm_ffn_g, w_in, mla_q_norm_g, mla_kv_norm_g, w_uq, w_ukv, w_o_mla, conv_w, w_o_conv, w_o_ret, w_mix_out, w_route_group, b_route_group, w_route_expert, b_route_expert, w_exp_gate, w_exp_up, w_exp_down, final_g):
    b, s, d = x.shape
    mla_cos, mla_sin = _rope_tables(positions, MLA_ROPE)
    ret_cos, ret_sin = _rope_tables(positions, RET_DK)
    c_act = jax.nn.silu(c)
    for l in range(DEPTH):
        mod = c_act @ w_ada[l] + b_ada[l]
        sh_mix, sc_mix, gt_mix, sh_ffn, sc_ffn, gt_ffn = [m[:, None, :] for m in jnp.split(mod, 6, axis=-1)]
        h = _rmsnorm(x, norm_mix_g[l]) * (1.0 + sc_mix) + sh_mix
        q_lat, kv_lat, k_rope, cb, cc, cx, rq, rk, rv, rg, gl = _split_cols(h @ w_in[l], IN_SIZES)
        y_mla = _mla_branch(q_lat, kv_lat, k_rope, mla_q_norm_g[l], mla_kv_norm_g[l], w_uq[l], w_ukv[l], w_o_mla[l], mla_cos, mla_sin)
        y_conv = _shortconv_branch(cb, cc, cx, conv_w[l], w_o_conv[l])
        y_ret = _retention_branch(rq, rk, rv, rg, w_o_ret[l], ret_cos, ret_sin)
        gates = jax.nn.sigmoid(gl).reshape(b, s, N_BRANCHES, d)
        merged = gates[:, :, 0] * y_mla + gates[:, :, 1] * y_conv + gates[:, :, 2] * y_ret
        x = x + gt_mix * (merged @ w_mix_out[l])
        h = _rmsnorm(x, norm_ffn_g[l]) * (1.0 + sc_ffn) + sh_ffn
        x = x + gt_ffn * _hier_moe(h, w_route_group[l], b_route_group[l], w_route_expert[l], b_route_expert[l], w_exp_gate[l], w_exp_up[l], w_exp_down[l])
    return _rmsnorm(x, final_g)
```

```cpp
#include <hip/hip_runtime.h>
#include <cstdio>
#include <cstdint>
#include <cmath>

#define LAS __attribute__((address_space(3)))
#define GAS __attribute__((address_space(1)))
typedef unsigned short bf16_t;
typedef short bf16x8 __attribute__((ext_vector_type(8)));
typedef short s16x4 __attribute__((ext_vector_type(4)));
typedef float f32x4 __attribute__((ext_vector_type(4)));
typedef float f32x2 __attribute__((ext_vector_type(2)));
typedef float f32x16 __attribute__((ext_vector_type(16)));
typedef unsigned u32x4 __attribute__((ext_vector_type(4)));
typedef unsigned u32x2 __attribute__((ext_vector_type(2)));

constexpr int DM = 1024, NBATCH = 4, SEQ = 8192, T = NBATCH * SEQ, TH = T / 2, DEPTH = 2;
constexpr int IN_TOTAL = 8352, ZLD = 8448;
constexpr int ZC_QLAT = 0, ZC_KVLAT = 384, ZC_KROPE = 640, ZC_CB = 672, ZC_CC = 1184, ZC_CX = 1696, ZC_RQ = 2208, ZC_RK = 2720, ZC_RV = 3232, ZC_RG = 4256, ZC_GL = 5280;
constexpr int NEXP = 32, EFF = 512;
constexpr int XS_ROWS = 73728;
constexpr float EPS = 1e-6f;

constexpr size_t MiB = 1u << 20;
constexpr size_t WS_CTL = 0, CTL_ZERO_BYTES = 1 * MiB;
constexpr size_t WS_MODT = 1 * MiB;
constexpr size_t WS_RSTDQ = 1 * MiB + 256 * 1024, WS_RSTDKV = 1 * MiB + 512 * 1024;
constexpr size_t WS_ROUTE = 2 * MiB;
constexpr size_t WS_COSR = 3 * MiB, WS_SINR = 11 * MiB, WS_COSM = 19 * MiB, WS_SINM = 21 * MiB;
constexpr size_t WS_WMIX = 24 * MiB, WMIX_LAYER = 26 * MiB;
constexpr size_t WM_IN = 0, WM_UQ = 17 * MiB, WM_UKV = 18 * MiB, WM_CAT = 19 * MiB, WM_MIX = 23 * MiB;
constexpr size_t WS_ARENA = 76 * MiB;
static_assert(WM_MIX + 2 * MiB <= WMIX_LAYER && WS_WMIX + 2 * WMIX_LAYER <= WS_ARENA, "weight map");
constexpr size_t AR_XN = 0, AR_QB = 0, AR_Z = 32 * MiB, AR_KB = 296 * MiB, AR_VB = 320 * MiB, AR_AC = 336 * MiB, AR_RS = 400 * MiB;
constexpr size_t AR_WEXP = 0, AR_H2 = 96 * MiB, AR_XS = 160 * MiB, AR_HID = 304 * MiB, AR_YS = 376 * MiB;
constexpr size_t WS_END = WS_ARENA + 520 * MiB;
constexpr size_t WE_GU = 0, WE_D = (size_t)NEXP * 1024 * 1024 * 2;
constexpr int CW_TMO = 0, CW_CODE = 1, CW_BAR = 4096, CW_CNT = 8192;

constexpr int LDS_BYTES = 160 * 1024;
constexpr int MISC_OFF = LDS_BYTES - 1024;

#define RLX_AGENT __ATOMIC_RELAXED, __HIP_MEMORY_SCOPE_AGENT
__device__ __forceinline__ unsigned f2bf(float f) { unsigned u = __builtin_bit_cast(unsigned, f); return (u + 0x7fffu + ((u >> 16) & 1u)) >> 16; }
__device__ __forceinline__ unsigned pk2(float lo, float hi) { return f2bf(lo) | (f2bf(hi) << 16); }
typedef __bf16 bf16x2_t __attribute__((ext_vector_type(2)));
__device__ __forceinline__ unsigned cvt_pk_bf16(float lo, float hi) { f32x2 v = {lo, hi}; bf16x2_t b = __builtin_convertvector(v, bf16x2_t); return __builtin_bit_cast(unsigned, b); }
__device__ __forceinline__ float bflo(unsigned u) { return __builtin_bit_cast(float, u << 16); }
__device__ __forceinline__ float bfhi(unsigned u) { return __builtin_bit_cast(float, u & 0xffff0000u); }
__device__ __forceinline__ float bf1(bf16_t v) { return __builtin_bit_cast(float, (unsigned)v << 16); }
__device__ __forceinline__ float dpp_f(float v, int ctrl_sel) {
    const int x = __builtin_bit_cast(int, v); int r;
    if (ctrl_sel == 0) r = __builtin_amdgcn_update_dpp(x, x, 0xB1, 0xF, 0xF, false);
    else if (ctrl_sel == 1) r = __builtin_amdgcn_update_dpp(x, x, 0x4E, 0xF, 0xF, false);
    else if (ctrl_sel == 2) r = __builtin_amdgcn_update_dpp(x, x, 0x141, 0xF, 0xF, false);
    else r = __builtin_amdgcn_update_dpp(x, x, 0x140, 0xF, 0xF, false);
    return __builtin_bit_cast(float, r);
}
__device__ __forceinline__ float wave_sum(float v) {
    v += dpp_f(v, 0); v += dpp_f(v, 1); v += dpp_f(v, 2); v += dpp_f(v, 3);
    { auto rr = __builtin_amdgcn_permlane16_swap(__float_as_uint(v), __float_as_uint(v), false, false); v = __uint_as_float(rr[0]) + __uint_as_float(rr[1]); }
    { auto rr = __builtin_amdgcn_permlane32_swap(__float_as_uint(v), __float_as_uint(v), false, false); v = __uint_as_float(rr[0]) + __uint_as_float(rr[1]); }
    return v;
}
__device__ __forceinline__ float sigmoidf_(float a) { return 1.0f / (1.0f + __expf(-a)); }
__device__ __forceinline__ float siluf_(float a) { return a / (1.0f + __expf(-a)); }

namespace pg8 {
constexpr int BM = 256, BK = 64, HALF = 128, HTB = HALF * BK * 2, STAGE_BYTES = 8 * HTB, NXCD = 8, WGM = 8;
__host__ __device__ __forceinline__ int lds_byte(int r, int c) { const int st = (r >> 4) * 2 + (c >> 5), rr = r & 15, cc = c & 31, ob = rr * 64 + cc * 2; return st * 1024 + (ob ^ (((ob >> 9) & 1) << 5)); }
__host__ __device__ __forceinline__ void stage_rc(int b, int& R, int& C) { const int st = b / 1024, sb = b % 1024, swz = sb ^ (((sb >> 9) & 1) << 5); R = (st >> 1) * 16 + swz / 64; C = (st & 1) * 32 + (swz % 64) / 2; }
__host__ __device__ __forceinline__ int perm32(int rho) { const int n = rho >> 4, i = rho & 15; return 8 * (i >> 2) + 4 * n + (i & 3); }

struct Unit { int pm, pn, e; };
struct Gemm { const bf16_t* A; const bf16_t* Bt; int lda, ldb, K; unsigned bes; };

struct StaticOrder {
    int nM, nN, nwg, G, c;
    __device__ void init(int M, int N, int G_, int c_) { nM = M / BM; nN = N / BM; nwg = nM * nN; G = G_; c = c_; }
    __device__ bool next(int i, Unit& u) const {
        const long L = (long)i * G + c; if (L >= nwg) return false;
        int wgid = (int)L; { const int q = nwg / NXCD, r = nwg % NXCD, xcd = wgid % NXCD, off = wgid / NXCD; wgid = (xcd < r ? xcd * (q + 1) : r * (q + 1) + (xcd - r) * q) + off; }
        const int nig = WGM * nN, gid = wgid / nig, fm = gid * WGM, gsz = (nM - fm) < WGM ? (nM - fm) : WGM;
        u.pm = fm + ((wgid % nig) % gsz); u.pn = (wgid % nig) / gsz; u.e = 0; return true;
    }
};
struct ExpertOrder {
    const LAS int* tp; int G, c;
    __device__ bool next(int i, Unit& u) const {
        const int L = i * G + c; const int nt = __builtin_amdgcn_readfirstlane(tp[32]);
        if (L >= nt * 4) return false;
        const int rt = L >> 2; u.pm = rt; u.pn = L & 3;
        int e = 0;
#pragma unroll
        for (int s = 16; s >= 1; s >>= 1) { const int v = __builtin_amdgcn_readfirstlane(tp[e + s]); if (v <= rt) e += s; }
        u.e = e; return true;
    }
};

typedef f32x4 Acc[2][2][4][2];

template <class Epi, class Sched, bool ALIGN_EPI>
__device__ __forceinline__ void gemm_phase(LAS unsigned char* lds, const Gemm g, const Sched& S, const Epi& E) {
    int tid_ = threadIdx.x; asm volatile("" : "+v"(tid_));
    const int tid = tid_, wid = __builtin_amdgcn_readfirstlane(tid >> 6), lane = tid & 63, wr = wid >> 2, wc = wid & 3, fr = lane & 15, fq = lane >> 4;
    int K_ = g.K; asm volatile("" : "+s"(K_));
    const int nt = K_ / BK;
    unsigned voffA, voffB;
    { int R, C; stage_rc(tid * 16, R, C); const int Rb = Epi::PERM ? ((R & ~31) + perm32(R & 31)) : R;
        voffA = (unsigned)(R * g.lda + C) * 2u; voffB = (unsigned)(Rb * g.ldb + C) * 2u; }
    constexpr unsigned kstep = BK * 2;
    const unsigned hstepA = (unsigned)(HALF * g.lda * 2), hstepB = (unsigned)(HALF * g.ldb * 2);
    const unsigned tstepA = 2 * hstepA, tstepB = 2 * hstepB, d64A = hstepA / 2, d64B = hstepB / 2;
    const unsigned ldsw = (unsigned)wid * 1024u;
    const int aoff = lds_byte(wr * 64 + fr, fq * 8), boff = lds_byte(wc * 32 + fr, fq * 8);
#define PG8_SA(b, h) (((b) * 2 + (h)) * HTB)
#define PG8_SB(b, h) ((4 + (b) * 2 + (h)) * HTB)
#define PG8_STAGE_(bufoff, gbase, voff, d64) do { _Pragma("unroll") for (int _i = 0; _i < 2; ++_i) \
        __builtin_amdgcn_global_load_lds((const unsigned*)((const char*)(gbase) + (_i ? (d64) : 0u) + (voff)), (LAS unsigned*)(lds + (bufoff) + ldsw + _i * 8192), 16, 0, 0); } while (0)
#define PG8_STAGE(bufoff, gbase, voff) PG8_STAGE_(bufoff, gbase, voff, ((&(voff) == &voffA) ? d64A : d64B))
#define PG8_LDA(dst, b, h) do { _Pragma("unroll") for (int m = 0; m < 4; ++m) _Pragma("unroll") for (int k = 0; k < 2; ++k) dst[m][k] = *(const LAS bf16x8*)(lds + PG8_SA(b, h) + aoff + m * 2048 + k * 1024); } while (0)
#define PG8_LDB(dst, b, h) do { _Pragma("unroll") for (int n = 0; n < 2; ++n) _Pragma("unroll") for (int k = 0; k < 2; ++k) dst[n][k] = *(const LAS bf16x8*)(lds + PG8_SB(b, h) + boff + n * 2048 + k * 1024); } while (0)
#define PG8_MMA(ai, bj, At, Bt) do { __builtin_amdgcn_s_setprio(1); _Pragma("unroll") for (int m = 0; m < 4; ++m) _Pragma("unroll") for (int n = 0; n < 2; ++n) _Pragma("unroll") for (int k = 0; k < 2; ++k) \
        acc[ai][bj][m][n] = __builtin_amdgcn_mfma_f32_16x16x32_bf16(Bt[n][k], At[m][k], acc[ai][bj][m][n], 0, 0, 0); __builtin_amdgcn_s_setprio(0); } while (0)
#define PG8_WAIT_V(n) asm volatile("s_waitcnt vmcnt(" #n ")" ::: "memory")
#define PG8_WAIT_L(n) asm volatile("s_waitcnt lgkmcnt(" #n ")" ::: "memory")
#define PG8_BAR __builtin_amdgcn_s_barrier()
#define PG8_SCHED __builtin_amdgcn_sched_barrier(0)
    Unit cur, nxt; int ui = 0;
    if (!S.next(0, cur)) return;
    Acc acc;
#pragma unroll
    for (int a = 0; a < 2; ++a)
#pragma unroll
        for (int b = 0; b < 2; ++b)
#pragma unroll
            for (int m = 0; m < 4; ++m)
#pragma unroll
                for (int n = 0; n < 2; ++n) acc[a][b][m][n] = (f32x4){0.f, 0.f, 0.f, 0.f};
    bf16x8 At[4][2], B0[2][2], B1[2][2];
    const char* cA = (const char*)g.A + (size_t)((unsigned)cur.pm * tstepA); const char* cB = (const char*)g.Bt + (size_t)((unsigned)cur.e * g.bes + (unsigned)cur.pn * tstepB);
    PG8_STAGE(PG8_SB(0, 0), cB, voffB); PG8_STAGE(PG8_SB(0, 1), cB + hstepB, voffB); PG8_STAGE(PG8_SA(0, 0), cA, voffA); PG8_STAGE(PG8_SA(0, 1), cA + hstepA, voffA);
    if (wr == 1) PG8_BAR;
    PG8_WAIT_V(2); PG8_BAR;
    PG8_STAGE(PG8_SB(1, 0), cB + kstep, voffB); PG8_STAGE(PG8_SA(1, 0), cA + kstep, voffA); PG8_STAGE(PG8_SB(1, 1), cB + hstepB + kstep, voffB);
    PG8_WAIT_V(6); PG8_BAR;
    for (;;) {
        const bool has_next = S.next(ui + 1, nxt);
        const char* nA = has_next ? (const char*)g.A + (size_t)((unsigned)nxt.pm * tstepA) : cA; const char* nB = has_next ? (const char*)g.Bt + (size_t)((unsigned)nxt.e * g.bes + (unsigned)nxt.pn * tstepB) : cB;
        for (int t = 0; t < nt; t += 2) {
            const bool last = (t == nt - 2);
            const char* a1 = cA + (unsigned)(t + 1) * kstep;
            const char* a2 = last ? nA : cA + (unsigned)(t + 2) * kstep; const char* b2 = last ? nB : cB + (unsigned)(t + 2) * kstep;
            const char* a3 = a2 + kstep; const char* b3 = b2 + kstep;
            if constexpr (Epi::HAS_MID) { if (t == Epi::MID0 || t == Epi::MID1) E.mid(acc, cur, t, wr, wc, fr, fq); }
            PG8_LDB(B0, 0, 0); PG8_LDB(B1, 0, 1); PG8_SCHED; PG8_LDA(At, 0, 0); PG8_STAGE(PG8_SA(1, 1), a1 + hstepA, voffA);
            PG8_WAIT_V(8); PG8_WAIT_L(0); PG8_BAR; PG8_MMA(0, 0, At, B0); PG8_MMA(0, 1, At, B1); PG8_BAR; PG8_SCHED;
            PG8_LDA(At, 0, 1); PG8_STAGE(PG8_SB(0, 0), b2, voffB); PG8_STAGE(PG8_SB(0, 1), b2 + hstepB, voffB); PG8_STAGE(PG8_SA(0, 0), a2, voffA);
            PG8_WAIT_V(8); PG8_WAIT_L(0); PG8_BAR; PG8_MMA(1, 0, At, B0); PG8_MMA(1, 1, At, B1); PG8_BAR; PG8_SCHED;
            PG8_LDB(B0, 1, 0); PG8_LDB(B1, 1, 1); PG8_SCHED; PG8_LDA(At, 1, 0); PG8_STAGE(PG8_SA(0, 1), a2 + hstepA, voffA);
            PG8_WAIT_V(8); PG8_WAIT_L(0); PG8_BAR; PG8_MMA(0, 0, At, B0); PG8_MMA(0, 1, At, B1); PG8_BAR; PG8_SCHED;
            PG8_LDA(At, 1, 1); PG8_STAGE(PG8_SB(1, 0), b3, voffB); PG8_STAGE(PG8_SB(1, 1), b3 + hstepB, voffB); PG8_STAGE(PG8_SA(1, 0), a3, voffA);
            PG8_WAIT_V(8); PG8_WAIT_L(0); PG8_BAR; PG8_MMA(1, 0, At, B0); PG8_MMA(1, 1, At, B1); PG8_BAR; PG8_SCHED;
        }
        if constexpr (ALIGN_EPI) { if (wr == 0) PG8_BAR; }
        E(acc, cur, wr, wc, fr, fq);
        if (!has_next) break;
#pragma unroll
        for (int a = 0; a < 2; ++a)
#pragma unroll
            for (int b = 0; b < 2; ++b)
#pragma unroll
                for (int m = 0; m < 4; ++m)
#pragma unroll
                    for (int n = 0; n < 2; ++n) acc[a][b][m][n] = (f32x4){0.f, 0.f, 0.f, 0.f};
        cur = nxt; cA = nA; cB = nB; ++ui;
        if constexpr (ALIGN_EPI) { if (wr == 1) PG8_BAR; }
    }
    PG8_WAIT_V(0);
    if constexpr (!ALIGN_EPI) { if (wr == 0) PG8_BAR; }
    PG8_BAR;
#undef PG8_SA
#undef PG8_SB
#undef PG8_STAGE
#undef PG8_STAGE_
#undef PG8_LDA
#undef PG8_LDB
#undef PG8_MMA
#undef PG8_WAIT_V
#undef PG8_WAIT_L
#undef PG8_BAR
#undef PG8_SCHED
}

template <int MODE> struct EpiBf16 {
    static constexpr bool PERM = true, HAS_MID = false; static constexpr int MID0 = -1, MID1 = -1;
    bf16_t* O; int ldc; const float* rs; bf16_t* O2; int ldc2;
    __device__ __forceinline__ void operator()(const Acc& acc, const Unit& u, int wr, int wc, int fr, int fq) const {
        asm volatile("" : "+v"(fr), "+v"(fq));
        const int row0 = u.pm * BM + wr * 64 + fr;
#pragma unroll
        for (int ai = 0; ai < 2; ++ai)
#pragma unroll
            for (int m = 0; m < 4; ++m) { const int row = row0 + ai * HALF + m * 16; const float s = rs ? rs[row] : 1.0f;
#pragma unroll
                for (int bj = 0; bj < 2; ++bj) { const int col = u.pn * BM + bj * HALF + wc * 32 + 8 * fq;
                    const f32x4 v0 = acc[ai][bj][m][0] * s, v1 = acc[ai][bj][m][1] * s;
                    u32x4 w; w.x = cvt_pk_bf16(v0[0], v0[1]); w.y = cvt_pk_bf16(v0[2], v0[3]); w.z = cvt_pk_bf16(v1[0], v1[1]); w.w = cvt_pk_bf16(v1[2], v1[3]);
                    bf16_t* dst;
                    if (MODE == 0) dst = O + (size_t)row * ldc + col;
                    else { const int head = u.pn * 2 + bj; dst = (wc < 2) ? O + (size_t)row * 768 + head * 96 + wc * 32 + 8 * fq : O2 + (size_t)row * 512 + head * 64 + (wc - 2) * 32 + 8 * fq; }
                    *(u32x4*)dst = w; } }
    }
};
struct EpiGU {
    static constexpr bool PERM = true, HAS_MID = false; static constexpr int MID0 = -1, MID1 = -1;
    bf16_t* O;
    __device__ __forceinline__ void operator()(const Acc& acc, const Unit& u, int wr, int wc, int fr, int fq) const {
        asm volatile("" : "+v"(fr), "+v"(fq));
        const int row0 = u.pm * BM + wr * 64 + fr; const int col = u.pn * 128 + wc * 32 + 8 * fq;
#pragma unroll
        for (int ai = 0; ai < 2; ++ai)
#pragma unroll
            for (int m = 0; m < 4; ++m) { const int row = row0 + ai * HALF + m * 16;
                float h[8];
#pragma unroll
                for (int n = 0; n < 2; ++n)
#pragma unroll
                    for (int j = 0; j < 4; ++j) { const float gv = acc[ai][0][m][n][j], uv = acc[ai][1][m][n][j]; h[n * 4 + j] = siluf_(gv) * uv; }
                u32x4 w; w.x = cvt_pk_bf16(h[0], h[1]); w.y = cvt_pk_bf16(h[2], h[3]); w.z = cvt_pk_bf16(h[4], h[5]); w.w = cvt_pk_bf16(h[6], h[7]);
                *(u32x4*)(O + (size_t)row * EFF + col) = w; }
    }
};
struct EpiMerge {
    static constexpr bool PERM = true, HAS_MID = true; static constexpr int MID0 = 8, MID1 = 16;
    const bf16_t* Z; bf16_t* O;
    __device__ __forceinline__ void mid(Acc& acc, const Unit& u, int t, int wr, int wc, int fr, int fq) const {
        asm volatile("" : "+v"(fr), "+v"(fq));
        const int gi = (t == 8) ? 0 : 1; const int row0 = u.pm * BM + wr * 64 + fr;
#pragma unroll
        for (int ai = 0; ai < 2; ++ai)
#pragma unroll
            for (int m = 0; m < 4; ++m) { const int row = row0 + ai * HALF + m * 16;
#pragma unroll
                for (int bj = 0; bj < 2; ++bj) { const int col = u.pn * BM + bj * HALF + wc * 32 + 8 * fq;
                    const bf16_t* p = Z + (size_t)row * ZLD + ZC_GL + gi * 1024 + col;
                    const u32x4 ga = *(const u32x4*)p, gb = *(const u32x4*)(p + 1024);
                    float r[8];
#pragma unroll
                    for (int j = 0; j < 4; ++j) { const unsigned wa = ga[j], wb = gb[j];
                        float a0 = fminf(fmaxf(bflo(wa), -30.f), 30.f), a1 = fminf(fmaxf(bfhi(wa), -30.f), 30.f), b0 = fminf(fmaxf(bflo(wb), -30.f), 30.f), b1 = fminf(fmaxf(bfhi(wb), -30.f), 30.f);
                        r[2 * j] = (1.0f + __expf(-b0)) / (1.0f + __expf(-a0)); r[2 * j + 1] = (1.0f + __expf(-b1)) / (1.0f + __expf(-a1)); }
                    acc[ai][bj][m][0] = acc[ai][bj][m][0] * (f32x4){r[0], r[1], r[2], r[3]}; acc[ai][bj][m][1] = acc[ai][bj][m][1] * (f32x4){r[4], r[5], r[6], r[7]};
                    asm volatile("" : "+v"(acc[ai][bj][m][0]), "+v"(acc[ai][bj][m][1]) :: "memory"); } }
    }
    __device__ __forceinline__ void operator()(const Acc& acc, const Unit& u, int wr, int wc, int fr, int fq) const {
        asm volatile("" : "+v"(fr), "+v"(fq));
        const int row0 = u.pm * BM + wr * 64 + fr;
#pragma unroll
        for (int ai = 0; ai < 2; ++ai)
#pragma unroll
            for (int m = 0; m < 4; ++m) { const int row = row0 + ai * HALF + m * 16;
#pragma unroll
                for (int bj = 0; bj < 2; ++bj) { const int col = u.pn * BM + bj * HALF + wc * 32 + 8 * fq;
                    const u32x4 gc = *(const u32x4*)(Z + (size_t)row * ZLD + ZC_GL + 2048 + col);
                    float r[8];
#pragma unroll
                    for (int j = 0; j < 4; ++j) { const unsigned w = gc[j]; r[2 * j] = sigmoidf_(fminf(fmaxf(bflo(w), -30.f), 30.f)); r[2 * j + 1] = sigmoidf_(fminf(fmaxf(bfhi(w), -30.f), 30.f)); }
                    const f32x4 v0 = acc[ai][bj][m][0] * (f32x4){r[0], r[1], r[2], r[3]}, v1 = acc[ai][bj][m][1] * (f32x4){r[4], r[5], r[6], r[7]};
                    u32x4 w; w.x = cvt_pk_bf16(v0[0], v0[1]); w.y = cvt_pk_bf16(v0[2], v0[3]); w.z = cvt_pk_bf16(v1[0], v1[1]); w.w = cvt_pk_bf16(v1[2], v1[3]);
                    *(u32x4*)(O + (size_t)row * DM + col) = w; } }
    }
};
struct EpiResid {
    static constexpr bool PERM = false, HAS_MID = false; static constexpr int MID0 = -1, MID1 = -1;
    const float* xold; float* xnew; const float* gate;
    __device__ __forceinline__ void operator()(const Acc& acc, const Unit& u, int wr, int wc, int fr, int fq) const {
        asm volatile("" : "+v"(fr), "+v"(fq));
        const int row0 = u.pm * BM + wr * 64 + fr; const float* gt = gate + (size_t)((u.pm * BM) / SEQ) * 6144;
#pragma unroll
        for (int bj = 0; bj < 2; ++bj)
#pragma unroll
            for (int n = 0; n < 2; ++n) { const int col = u.pn * BM + bj * HALF + wc * 32 + 16 * n + 4 * fq; const f32x4 gv = *(const f32x4*)(gt + col);
#pragma unroll
                for (int ai = 0; ai < 2; ++ai)
#pragma unroll
                    for (int m = 0; m < 4; ++m) { const size_t off = (size_t)(row0 + ai * HALF + m * 16) * DM + col;
                        const f32x4 xo = *(const f32x4*)(xold + off); *(f32x4*)(xnew + off) = xo + gv * acc[ai][bj][m][n]; } }
    }
};
}

#define XB_TMO      128
#define XB_XCNT(j)  (256  + 64 * (j))
#define XB_XSUB(j)  (1280 + 64 * (j))
#define XB_XGEN(j)  (2304 + 64 * (j))
#define XB_TOP      3328
#define XB_TOPGEN   3392
#define XCD_BAR_WORDS 3456
#define XB_SPIN_CAP (1u << 22)

__device__ __forceinline__ unsigned xb_ld(unsigned* p)              { return __hip_atomic_load(p, __ATOMIC_RELAXED, __HIP_MEMORY_SCOPE_AGENT); }
__device__ __forceinline__ unsigned xb_add(unsigned* p, unsigned v) { return __hip_atomic_fetch_add(p, v, __ATOMIC_RELAXED, __HIP_MEMORY_SCOPE_AGENT); }
__device__ __forceinline__ unsigned xb_xcc_id() { return (unsigned)__builtin_amdgcn_s_getreg((3 << 11) | 20) & 0xFu; }
#define XB_SPIN(cond, bar) do { unsigned _sp = 0; while (cond) { __builtin_amdgcn_s_sleep(1); \
    if ((++_sp & 255u) == 0u) { if (xb_ld(&(bar)[XB_TMO])) break; if (_sp > XB_SPIN_CAP) { atomicAdd(&(bar)[XB_TMO], 1u); break; } } } } while (0)

struct XcdBarrier { unsigned* bar; unsigned x; volatile LAS unsigned* st; };

__device__ __forceinline__ XcdBarrier xcd_barrier_post(unsigned* bar, volatile LAS unsigned* st) {
    XcdBarrier b; b.bar = bar; b.x = xb_xcc_id(); b.st = st;
    if (threadIdx.x == 0) (void)xb_add(&bar[XB_XCNT(b.x)], 1u);
    return b;
}
__device__ __forceinline__ void xcd_barrier_complete(unsigned* bar, unsigned x, unsigned& nloc, unsigned& nx) {
    const unsigned G = gridDim.x * gridDim.y * gridDim.z;
    unsigned sum, cnt, mine, sp = 0u;
    for (;;) {
        sum = 0u; cnt = 0u; mine = 0u;
#pragma unroll
        for (unsigned j = 0; j < 16; ++j) { const unsigned c = xb_ld(&bar[XB_XCNT(j)]); sum += c; cnt += (c > 0u) ? 1u : 0u; mine = (j == x) ? c : mine; }
        if (sum == G) break;
        __builtin_amdgcn_s_sleep(1);
        if ((++sp & 255u) == 0u) { if (xb_ld(&bar[XB_TMO])) break; if (sp > XB_SPIN_CAP) { atomicAdd(&bar[XB_TMO], 1u); break; } }
    }
    nloc = mine > 0u ? mine : 1u; nx = cnt > 0u ? cnt : 1u;
}
__device__ __forceinline__ void xcd_barrier(const XcdBarrier& b) {
    asm volatile("s_waitcnt vmcnt(0)" ::: "memory");
    __syncthreads();
    if (threadIdx.x == 0) {
        unsigned* bar = b.bar;
        __builtin_amdgcn_s_waitcnt(0);
        unsigned nloc = b.st[0], nx = b.st[1];
        if (nloc == 0u) { xcd_barrier_complete(bar, b.x, nloc, nx); b.st[0] = nloc; b.st[1] = nx; }
        const unsigned old = xb_add(&bar[XB_XSUB(b.x)], 1u);
        const unsigned gen = old / nloc;
        if (old + 1u == (gen + 1u) * nloc) {
            __builtin_amdgcn_fence(__ATOMIC_RELEASE, "agent");
            asm volatile("s_waitcnt vmcnt(0)" ::: "memory");
            const unsigned og = xb_add(&bar[XB_TOP], 1u);
            const unsigned tg = og / nx;
            if (og + 1u == (tg + 1u) * nx) xb_add(&bar[XB_TOPGEN], 1u);
            else XB_SPIN(xb_ld(&bar[XB_TOPGEN]) == tg, bar);
            __builtin_amdgcn_fence(__ATOMIC_ACQUIRE, "agent");
            xb_add(&bar[XB_XGEN(b.x)], 1u);
            asm volatile("s_waitcnt vmcnt(0)" ::: "memory");
        } else {
            XB_SPIN(xb_ld(&bar[XB_XGEN(b.x)]) == gen, bar);
            __builtin_amdgcn_fence(__ATOMIC_ACQUIRE, "agent");
            asm volatile("s_waitcnt vmcnt(0)" ::: "memory");
        }
    }
    __syncthreads();
}

namespace att {
constexpr int KB0 = 0, KB1 = 12288, VB0 = 24576, VB1 = 32768, WSF = 40960, OST = 43008, LDS_NEED = OST + 8 * 4096;
constexpr float QSCALE = 0.10206207261596575f * 1.4426950408889634f;
__device__ __forceinline__ int crow(int r, int hi) { return (r & 3) + 8 * (r >> 2) + 4 * hi; }
#define MFMA32(a, b, c) __builtin_amdgcn_mfma_f32_32x32x16_bf16((a), (b), (c), 0, 0, 0)

__device__ __forceinline__ void pv(f32x16* o, int vb, bf16x8 pa0, bf16x8 pa1, bf16x8 pa2, bf16x8 pa3) {
#pragma unroll
    for (int d0 = 0; d0 < 2; ++d0) { s16x4 lo[4], hi[4];
#pragma unroll
        for (int ks = 0; ks < 4; ++ks) {
            asm volatile("ds_read_b64_tr_b16 %0,%1 offset:%c2" : "=&v"(lo[ks]) : "v"(vb), "i"(d0 * 4096 + ks * 1024) : "memory");
            asm volatile("ds_read_b64_tr_b16 %0,%1 offset:%c2" : "=&v"(hi[ks]) : "v"(vb), "i"(d0 * 4096 + ks * 1024 + 512) : "memory"); }
        asm volatile("s_waitcnt lgkmcnt(0)" ::: "memory"); __builtin_amdgcn_sched_barrier(0);
#define PK(k) (bf16x8){lo[k][0], lo[k][1], lo[k][2], lo[k][3], hi[k][0], hi[k][1], hi[k][2], hi[k][3]}
        o[d0] = MFMA32(pa0, PK(0), o[d0]); o[d0] = MFMA32(pa1, PK(1), o[d0]); o[d0] = MFMA32(pa2, PK(2), o[d0]); o[d0] = MFMA32(pa3, PK(3), o[d0]);
#undef PK
    }
}

__device__ __forceinline__ void attn_unit(int bl, int h, int qb, const bf16_t* Q, const bf16_t* __restrict__ K, const bf16_t* __restrict__ V, bf16_t* O,
                                          const float* cosM, const float* sinM, int tokbase, LAS char* shm) {
    int tid_ = threadIdx.x; asm volatile("" : "+v"(tid_));
    const int tid = tid_, lane = tid & 63, r32 = lane & 31, hi = lane >> 5; const int wid = __builtin_amdgcn_readfirstlane(tid >> 6);
    const long rowbase = (long)bl * SEQ; const int q0 = qb * 256;
    const unsigned lds0 = (unsigned)(uintptr_t)shm;
    LAS float* wsf = (LAS float*)(shm + WSF) + wid * 64;
    const long qrow = rowbase + q0 + wid * 32 + r32;
    const bf16_t* qp = Q + qrow * 768 + h * 96;
    bf16x8 qr[6];
#pragma unroll
    for (int d0 = 0; d0 < 4; ++d0) { const u32x4 raw = *(const u32x4*)(qp + d0 * 16 + hi * 8); u32x4 w;
#pragma unroll
        for (int j = 0; j < 4; ++j) w[j] = cvt_pk_bf16(bflo(raw[j]) * QSCALE, bfhi(raw[j]) * QSCALE);
        qr[d0] = __builtin_bit_cast(bf16x8, w); }
    { const u32x4 r1 = *(const u32x4*)(qp + 64 + hi * 8), r2 = *(const u32x4*)(qp + 80 + hi * 8);
      const float* cp = cosM + (size_t)(tokbase + qrow) * 16 + hi * 8; const float* sp = sinM + (size_t)(tokbase + qrow) * 16 + hi * 8;
      const f32x4 c0 = *(const f32x4*)cp, c1 = *(const f32x4*)(cp + 4), s0 = *(const f32x4*)sp, s1 = *(const f32x4*)(sp + 4);
      float cs[8] = {c0[0], c0[1], c0[2], c0[3], c1[0], c1[1], c1[2], c1[3]}, sn[8] = {s0[0], s0[1], s0[2], s0[3], s1[0], s1[1], s1[2], s1[3]};
      u32x4 w1, w2;
#pragma unroll
      for (int j = 0; j < 4; ++j) { const float a0 = bflo(r1[j]), a1 = bfhi(r1[j]), b0 = bflo(r2[j]), b1 = bfhi(r2[j]);
          w1[j] = cvt_pk_bf16((a0 * cs[2 * j] - b0 * sn[2 * j]) * QSCALE, (a1 * cs[2 * j + 1] - b1 * sn[2 * j + 1]) * QSCALE);
          w2[j] = cvt_pk_bf16((a0 * sn[2 * j] + b0 * cs[2 * j]) * QSCALE, (a1 * sn[2 * j + 1] + b1 * cs[2 * j + 1]) * QSCALE); }
      qr[4] = __builtin_bit_cast(bf16x8, w1); qr[5] = __builtin_bit_cast(bf16x8, w2); }
    const bf16_t* Kh = K + rowbase * 768 + h * 96; const bf16_t* Vh = V + rowbase * 512 + h * 64;
    const bf16_t* ksrcA = Kh + (long)lane * 768 + wid * 8;
    const bf16_t* ksrcB = Kh + (long)lane * 768 + (8 + wid) * 8;
    const bf16_t* vsrc = Vh + (long)(16 * (wid & 3) + (lane >> 2)) * 512 + (wid >> 2) * 32 + (lane & 3) * 8;
    const int kdA = wid * 1024 + lane * 16, kdB = (8 + wid) * 1024 + lane * 16, vd = wid * 1024 + lane * 16;
    const int NT = q0 / 64 + 4, tq = q0 / 64 + (wid >> 1);
    u32x4 ka, kb2, vv;
#define ATT_LOAD(t) do { ka = *(const u32x4*)(ksrcA + (long)(t) * 64 * 768); if (wid < 4) kb2 = *(const u32x4*)(ksrcB + (long)(t) * 64 * 768); vv = *(const u32x4*)(vsrc + (long)(t) * 64 * 512); } while (0)
#define ATT_WRITE(kb_, vb_) do { *(LAS u32x4*)(shm + (kb_) + kdA) = ka; if (wid < 4) *(LAS u32x4*)(shm + (kb_) + kdB) = kb2; *(LAS u32x4*)(shm + (vb_) + vd) = vv; } while (0)
    ATT_LOAD(0); ATT_WRITE(KB0, VB0);
    __syncthreads();
    float mrun = -1e30f, lsum = 0.f; f32x16 o[2];
#pragma unroll
    for (int r = 0; r < 16; ++r) { o[0][r] = 0.f; o[1][r] = 0.f; }
    const int vbl = (int)lds0 + ((lane >> 4) & 1) * 32 + (lane & 3) * 8 + (4 * hi + ((lane & 15) >> 2)) * 64;
    for (int t = 0; t < NT; ++t) {
        const int kbuf = (t & 1) ? KB1 : KB0, vbuf = (t & 1) ? VB1 : VB0;
        if (t + 1 < NT) ATT_LOAD(t + 1);
        if (t <= tq) {
            f32x16 p0, p1;
#pragma unroll
            for (int r = 0; r < 16; ++r) { p0[r] = 0.f; p1[r] = 0.f; }
            const LAS char* kbp = shm + kbuf + hi * 1024 + r32 * 16;
#pragma unroll
            for (int d0 = 0; d0 < 6; ++d0) { const bf16x8 b0 = *(const LAS bf16x8*)(kbp + d0 * 2048), b1 = *(const LAS bf16x8*)(kbp + d0 * 2048 + 512);
                p0 = MFMA32(b0, qr[d0], p0); p1 = MFMA32(b1, qr[d0], p1); }
            float mt = fmaxf(p0[0], p1[0]);
#pragma unroll
            for (int r = 1; r < 16; ++r) mt = fmaxf(mt, fmaxf(p0[r], p1[r]));
            { auto rr = __builtin_amdgcn_permlane32_swap(__float_as_uint(mt), __float_as_uint(mt), false, false); mt = fmaxf(__uint_as_float(rr[0]), __uint_as_float(rr[1])); }
            const float mnew = fmaxf(mrun, mt);
            if (__any(mnew > mrun)) {
                const float alpha = __builtin_amdgcn_exp2f(mrun - mnew);
                lsum *= alpha; mrun = mnew;
                if (hi == 0) wsf[r32] = alpha;
#pragma unroll
                for (int r = 0; r < 16; ++r) { const float a = wsf[crow(r, hi)]; o[0][r] *= a; o[1][r] *= a; }
            }
            float sacc = 0.f;
#pragma unroll
            for (int r = 0; r < 16; ++r) { p0[r] = __builtin_amdgcn_exp2f(p0[r] - mrun); p1[r] = __builtin_amdgcn_exp2f(p1[r] - mrun); sacc += p0[r] + p1[r]; }
            lsum += sacc;
            u32x4 pw0, pw1, pw2, pw3;
#pragma unroll
            for (int j = 0; j < 4; ++j) { pw0[j] = cvt_pk_bf16(p0[2 * j], p0[2 * j + 1]); pw1[j] = cvt_pk_bf16(p0[8 + 2 * j], p0[8 + 2 * j + 1]);
                                          pw2[j] = cvt_pk_bf16(p1[2 * j], p1[2 * j + 1]); pw3[j] = cvt_pk_bf16(p1[8 + 2 * j], p1[8 + 2 * j + 1]); }
            pv(o, vbl + vbuf, __builtin_bit_cast(bf16x8, pw0), __builtin_bit_cast(bf16x8, pw1), __builtin_bit_cast(bf16x8, pw2), __builtin_bit_cast(bf16x8, pw3));
        }
        if (t + 1 < NT) { if (t & 1) ATT_WRITE(KB0, VB0); else ATT_WRITE(KB1, VB1); }
        __syncthreads();
    }
#undef ATT_LOAD
#undef ATT_WRITE
    { auto rr = __builtin_amdgcn_permlane32_swap(__float_as_uint(lsum), __float_as_uint(lsum), false, false); lsum = __uint_as_float(rr[0]) + __uint_as_float(rr[1]); }
    if (hi == 0) wsf[32 + r32] = lsum;
    float rli[16];
#pragma unroll
    for (int r = 0; r < 16; ++r) rli[r] = 1.0f / wsf[32 + crow(r, hi)];
    bf16_t* Ow = O + (rowbase + q0 + wid * 32) * 2048 + h * 64;
    { LAS bf16_t* stg = (LAS bf16_t*)(shm + OST) + wid * 2048;
#pragma unroll
      for (int r = 0; r < 16; ++r) { const int orow = crow(r, hi);
#pragma unroll
          for (int d0 = 0; d0 < 2; ++d0) stg[orow * 64 + d0 * 32 + r32] = (bf16_t)f2bf(o[d0][r] * rli[r]); }
#pragma unroll
      for (int i = 0; i < 4; ++i) { const int row = i * 8 + (lane >> 3), ch = lane & 7; const u32x4 v = *(const LAS u32x4*)(stg + row * 64 + ch * 8); *(u32x4*)(Ow + (long)row * 2048 + ch * 8) = v; } }
    __syncthreads();
}
}

namespace ret {
typedef short v4i16_t __attribute__((ext_vector_type(4)));
#define MFMA16(a, b, c) __builtin_amdgcn_mfma_f32_16x16x32_bf16((a), (b), (c), 0, 0, 0)
__device__ __forceinline__ bf16x8 tr16(const LAS char* base, int rs, int k0, int x0, int lane) {
    const int g = lane >> 4, i = lane & 15, q = i >> 2, p = i & 3;
    const LAS char* a = base + (k0 + 8 * g + q) * rs + (x0 + 4 * p) * 2;
    const s16x4 lo = __builtin_bit_cast(s16x4, __builtin_amdgcn_ds_read_tr16_b64_v4i16((LAS v4i16_t*)a));
    const s16x4 hi = __builtin_bit_cast(s16x4, __builtin_amdgcn_ds_read_tr16_b64_v4i16((LAS v4i16_t*)(a + 4 * rs)));
    return (bf16x8){lo[0], lo[1], lo[2], lo[3], hi[0], hi[1], hi[2], hi[3]};
}
constexpr int QI = 0, KI = 17408, VI = 34816, PI = 68608, O32 = 81920;
__device__ __forceinline__ float lg2gamma(int h) { return log2f(1.0f - exp2f(-5.0f - (float)h)); }

__device__ __forceinline__ void kvloc_unit(int u, int n, const bf16_t* Z, bf16_t* RS, LAS char* lds) {
    int tid_ = threadIdx.x; asm volatile("" : "+v"(tid_));
    const int tid = tid_, lane = tid & 63, wid = __builtin_amdgcn_readfirstlane(tid >> 6);
    const int bl = u >> 2, h = u & 3; const long row0 = (long)bl * SEQ + (long)n * 64; const float lg = lg2gamma(h);
#pragma unroll
    for (int i = 0; i < 2; ++i) { const int p = tid + 512 * i, row = p >> 4, ch = p & 15;
        const u32x4 raw = *(const u32x4*)(Z + (size_t)(row0 + row) * ZLD + ZC_RK + h * 128 + ch * 8); const float sc = exp2f(lg * (float)(63 - row)); u32x4 w;
#pragma unroll
        for (int j = 0; j < 4; ++j) w[j] = cvt_pk_bf16(bflo(raw[j]) * sc, bfhi(raw[j]) * sc);
        *(LAS u32x4*)(lds + KI + row * 272 + ch * 16) = w; }
#pragma unroll
    for (int i = 0; i < 4; ++i) { const int p = tid + 512 * i, row = p >> 5, ch = p & 31;
        *(LAS u32x4*)(lds + VI + row * 528 + ch * 16) = *(const u32x4*)(Z + (size_t)(row0 + row) * ZLD + ZC_RV + h * 256 + ch * 8); }
    __syncthreads();
    bf16x8 bfr[2][2];
#pragma unroll
    for (int n2 = 0; n2 < 2; ++n2)
#pragma unroll
        for (int ks = 0; ks < 2; ++ks) bfr[n2][ks] = tr16(lds + VI, 528, 32 * ks, 32 * wid + 16 * n2, lane);
    const int g = lane >> 4, i16 = lane & 15;
    bf16_t* dst = RS + (size_t)(u * 128 + n) * 32768;
#pragma unroll 2
    for (int mi = 0; mi < 8; ++mi) { const bf16x8 a0 = tr16(lds + KI, 272, 0, 16 * mi, lane), a1 = tr16(lds + KI, 272, 32, 16 * mi, lane);
#pragma unroll
        for (int n2 = 0; n2 < 2; ++n2) { f32x4 acc = {0.f, 0.f, 0.f, 0.f}; acc = MFMA16(a0, bfr[n2][0], acc); acc = MFMA16(a1, bfr[n2][1], acc);
            const int c = 32 * wid + 16 * n2 + i16, d = 16 * mi + 4 * g; u32x2 w; w.x = cvt_pk_bf16(acc[0], acc[1]); w.y = cvt_pk_bf16(acc[2], acc[3]);
            *(u32x2*)(dst + c * 128 + d) = w; } }
    __syncthreads();
}

__device__ __forceinline__ void scan_all(bf16_t* RS, int gtid, int gthreads) {
    for (int idx = gtid; idx < 8 * 16384; idx += gthreads) {
        const int u = idx >> 14, e2 = idx & 16383, h = u & 3; const float cd = exp2f(lg2gamma(h) * 64.0f);
        unsigned* p = (unsigned*)(RS + (size_t)u * 128 * 32768) + e2;
        float s0 = 0.f, s1 = 0.f;
        for (int n = 0; n < 128; n += 8) { unsigned v[8];
#pragma unroll
            for (int k = 0; k < 8; ++k) v[k] = p[(size_t)(n + k) * 16384];
#pragma unroll
            for (int k = 0; k < 8; ++k) { const unsigned w = cvt_pk_bf16(s0, s1); s0 = s0 * cd + bflo(v[k]); s1 = s1 * cd + bfhi(v[k]); p[(size_t)(n + k) * 16384] = w; } }
    }
}

__device__ __forceinline__ void out_unit(int u, int n, const bf16_t* Z, const bf16_t* RS, bf16_t* AC, LAS char* lds) {
    int tid_ = threadIdx.x; asm volatile("" : "+v"(tid_));
    const int tid = tid_, lane = tid & 63, wid = __builtin_amdgcn_readfirstlane(tid >> 6), g = lane >> 4, i16 = lane & 15;
    const int bl = u >> 2, h = u & 3; const long row0 = (long)bl * SEQ + (long)n * 64; const float lg = lg2gamma(h);
    bf16x8 sfr[2][4];
    { const bf16_t* sp = RS + (size_t)(u * 128 + n) * 32768;
#pragma unroll
      for (int n2 = 0; n2 < 2; ++n2)
#pragma unroll
          for (int ks = 0; ks < 4; ++ks) sfr[n2][ks] = *(const bf16x8*)(sp + (32 * wid + 16 * n2 + i16) * 128 + 32 * ks + 8 * g); }
#pragma unroll
    for (int i = 0; i < 2; ++i) { const int p = tid + 512 * i, row = p >> 4, ch = p & 15; const bf16_t* zr = Z + (size_t)(row0 + row) * ZLD + h * 128 + ch * 8;
        *(LAS u32x4*)(lds + QI + row * 272 + ch * 16) = *(const u32x4*)(zr + ZC_RQ); *(LAS u32x4*)(lds + KI + row * 272 + ch * 16) = *(const u32x4*)(zr + ZC_RK); }
#pragma unroll
    for (int i = 0; i < 4; ++i) { const int p = tid + 512 * i, row = p >> 5, ch = p & 31;
        *(LAS u32x4*)(lds + VI + row * 528 + ch * 16) = *(const u32x4*)(Z + (size_t)(row0 + row) * ZLD + ZC_RV + h * 256 + ch * 8); }
    __syncthreads();
#pragma unroll
    for (int t2 = 0; t2 < 2; ++t2) { const int id = 2 * wid + t2, mi = id >> 2, nj = id & 3; f32x4 acc = {0.f, 0.f, 0.f, 0.f};
#pragma unroll
        for (int ks = 0; ks < 4; ++ks) { const bf16x8 a = *(const LAS bf16x8*)(lds + QI + (16 * mi + i16) * 272 + (32 * ks + 8 * g) * 2), b = *(const LAS bf16x8*)(lds + KI + (16 * nj + i16) * 272 + (32 * ks + 8 * g) * 2);
            acc = MFMA16(a, b, acc); }
#pragma unroll
        for (int jj = 0; jj < 4; ++jj) { const int ii = 16 * mi + 4 * g + jj, jc = 16 * nj + i16; const int dd = ii > jc ? ii - jc : jc - ii;
            *(LAS bf16_t*)(lds + PI + ii * 144 + jc * 2) = (bf16_t)f2bf(acc[jj] * exp2f(lg * (float)dd)); } }
    __syncthreads();
    f32x4 acc1[4][2], acc2[4][2];
#pragma unroll
    for (int mi = 0; mi < 4; ++mi)
#pragma unroll
        for (int n2 = 0; n2 < 2; ++n2) { acc1[mi][n2] = (f32x4){0.f, 0.f, 0.f, 0.f}; acc2[mi][n2] = (f32x4){0.f, 0.f, 0.f, 0.f}; }
#pragma unroll
    for (int ks = 0; ks < 2; ++ks) { bf16x8 b[2]; b[0] = tr16(lds + VI, 528, 32 * ks, 32 * wid, lane); b[1] = tr16(lds + VI, 528, 32 * ks, 32 * wid + 16, lane);
#pragma unroll
        for (int mi = 0; mi < 4; ++mi) { const bf16x8 a = *(const LAS bf16x8*)(lds + PI + (16 * mi + i16) * 144 + (32 * ks + 8 * g) * 2);
            acc1[mi][0] = MFMA16(a, b[0], acc1[mi][0]); acc1[mi][1] = MFMA16(a, b[1], acc1[mi][1]); } }
#pragma unroll
    for (int ks = 0; ks < 4; ++ks)
#pragma unroll
        for (int mi = 0; mi < 4; ++mi) { const bf16x8 a = *(const LAS bf16x8*)(lds + QI + (16 * mi + i16) * 272 + (32 * ks + 8 * g) * 2);
            acc2[mi][0] = MFMA16(a, sfr[0][ks], acc2[mi][0]); acc2[mi][1] = MFMA16(a, sfr[1][ks], acc2[mi][1]); }
#pragma unroll
    for (int mi = 0; mi < 4; ++mi)
#pragma unroll
        for (int jj = 0; jj < 4; ++jj) { const int row = 16 * mi + 4 * g + jj; const float qd = exp2f(lg * (float)(row + 1));
#pragma unroll
            for (int n2 = 0; n2 < 2; ++n2) *(LAS float*)(lds + O32 + (row * 260 + 32 * wid + 16 * n2 + i16) * 4) = acc1[mi][n2][jj] + qd * acc2[mi][n2][jj]; }
    __syncthreads();
#pragma unroll 2
    for (int rr = 0; rr < 8; ++rr) { const int row = 8 * wid + rr; const f32x4 v = *(const LAS f32x4*)(lds + O32 + (row * 260 + 4 * lane) * 4);
        const float ss = wave_sum(v[0] * v[0] + v[1] * v[1] + v[2] * v[2] + v[3] * v[3]); const float rstd = rsqrtf(ss * (1.0f / 256.0f) + EPS);
        const u32x2 gr = *(const u32x2*)(Z + (size_t)(row0 + row) * ZLD + ZC_RG + h * 256 + 4 * lane);
        u32x2 w; w.x = cvt_pk_bf16(siluf_(bflo(gr.x)) * v[0] * rstd, siluf_(bfhi(gr.x)) * v[1] * rstd); w.y = cvt_pk_bf16(siluf_(bflo(gr.y)) * v[2] * rstd, siluf_(bfhi(gr.y)) * v[3] * rstd);
        *(u32x2*)(AC + (size_t)(row0 + row) * 2048 + 1024 + h * 256 + 4 * lane) = w; }
    __syncthreads();
}
}

struct Args {
    const float* in[25]; float* out; unsigned char* ws;
    float invR[64]; float invM[16];
};
constexpr int NW = 8;

__device__ __forceinline__ void tr_item(const float* W, int N, int k0, int n0, bf16_t* WT, int ldk, int drow0, int dk0, const float* kscale, LAS float* scr, int lane) {
#pragma unroll 8
    for (int i = 0; i < 32; ++i) { const int kk = 2 * i + (lane >> 5); float v = W[(size_t)(k0 + kk) * N + n0 + (lane & 31)]; if (kscale) v *= kscale[k0 + kk]; scr[kk * 33 + (lane & 31)] = v; }
    asm volatile("s_waitcnt lgkmcnt(0)" ::: "memory");
    const int c = lane & 7;
#pragma unroll
    for (int j = 0; j < 4; ++j) { const int n = (lane >> 3) + 8 * j; const LAS float* s = scr + (8 * c) * 33 + n;
        u32x4 o; o.x = pk2(s[0 * 33], s[1 * 33]); o.y = pk2(s[2 * 33], s[3 * 33]); o.z = pk2(s[4 * 33], s[5 * 33]); o.w = pk2(s[6 * 33], s[7 * 33]);
        *(u32x4*)(WT + (size_t)(drow0 + n) * ldk + dk0 + 8 * c) = o; }
    asm volatile("s_waitcnt lgkmcnt(0)" ::: "memory");
}

constexpr int MI_IN = 16 * 261, MI_UQ = 6 * 24, MI_UKV = 4 * 32, MI_OM = 8 * 32, MI_OC = 8 * 32, MI_OR = 16 * 32, MI_MX = 16 * 32, MI_PAD = 96;
constexpr int MI_TOTAL = MI_IN + MI_UQ + MI_UKV + MI_OM + MI_OC + MI_OR + MI_MX + MI_PAD;
#define PTP(i) ((const float*)(const GAS float*)PT[i])
__device__ __forceinline__ void mixer_weight_item(volatile LAS unsigned long long* PT, int l, int it, unsigned char* wl, LAS float* scr, int lane) {
    bf16_t* WinT = (bf16_t*)(wl + WM_IN); bf16_t* WuqT = (bf16_t*)(wl + WM_UQ); bf16_t* WukvT = (bf16_t*)(wl + WM_UKV); bf16_t* WcatT = (bf16_t*)(wl + WM_CAT); bf16_t* WmixT = (bf16_t*)(wl + WM_MIX);
    int r = it;
    if (r < MI_IN) { const int kb = r / 261, nb = r % 261; tr_item(PTP(7) + (size_t)l * 1024 * IN_TOTAL, IN_TOTAL, 64 * kb, 32 * nb, WinT, 1024, 32 * nb, 64 * kb, nullptr, scr, lane); return; } r -= MI_IN;
    if (r < MI_UQ) { const int kb = r / 24, nb = r % 24; tr_item(PTP(10) + (size_t)l * 384 * 768, 768, 64 * kb, 32 * nb, WuqT, 384, 32 * nb, 64 * kb, PTP(8) + l * 384, scr, lane); return; } r -= MI_UQ;
    if (r < MI_UKV) { const int kb = r / 32, nb = r % 32; tr_item(PTP(11) + (size_t)l * 256 * 1024, 1024, 64 * kb, 32 * nb, WukvT, 256, 32 * nb, 64 * kb, PTP(9) + l * 256, scr, lane); return; } r -= MI_UKV;
    if (r < MI_OM) { const int kb = r / 32, nb = r % 32; tr_item(PTP(12) + (size_t)l * 512 * 1024, 1024, 64 * kb, 32 * nb, WcatT, 2048, 32 * nb, 64 * kb, nullptr, scr, lane); return; } r -= MI_OM;
    if (r < MI_OC) { const int kb = r / 32, nb = r % 32; tr_item(PTP(14) + (size_t)l * 512 * 1024, 1024, 64 * kb, 32 * nb, WcatT, 2048, 32 * nb, 512 + 64 * kb, nullptr, scr, lane); return; } r -= MI_OC;
    if (r < MI_OR) { const int kb = r / 32, nb = r % 32; tr_item(PTP(15) + (size_t)l * 1024 * 1024, 1024, 64 * kb, 32 * nb, WcatT, 2048, 32 * nb, 1024 + 64 * kb, nullptr, scr, lane); return; } r -= MI_OR;
    if (r < MI_MX) { const int kb = r / 32, nb = r % 32; tr_item(PTP(16) + (size_t)l * 1024 * 1024, 1024, 64 * kb, 32 * nb, WmixT, 1024, 32 * nb, 64 * kb, nullptr, scr, lane); return; } r -= MI_MX;
    { u32x4* p = (u32x4*)(WinT + (size_t)(IN_TOTAL + r) * 1024); p[lane] = (u32x4){0u, 0u, 0u, 0u}; p[lane + 64] = (u32x4){0u, 0u, 0u, 0u}; }
}
constexpr int EI_G = 16 * 16, EI_D = 8 * 32, EI_PER = 2 * EI_G + EI_D, EI_TOTAL = NEXP * EI_PER;
__device__ __forceinline__ void expert_weight_item(volatile LAS unsigned long long* PT, int l, int it, unsigned char* wexp, LAS float* scr, int lane) {
    const int e = it / EI_PER; int r = it % EI_PER;
    bf16_t* Wgu = (bf16_t*)(wexp + WE_GU) + (size_t)e * 1024 * 1024; bf16_t* Wd = (bf16_t*)(wexp + WE_D) + (size_t)e * 1024 * 512;
    const size_t eo = ((size_t)l * NEXP + e) * 1024 * 512;
    if (r < EI_G) { const int kb = r / 16, nb = r % 16, n0 = 32 * nb; tr_item(PTP(21) + eo, 512, 64 * kb, n0, Wgu, 1024, (n0 >> 7) * 256 + (n0 & 127), 64 * kb, nullptr, scr, lane); return; } r -= EI_G;
    if (r < EI_G) { const int kb = r / 16, nb = r % 16, n0 = 32 * nb; tr_item(PTP(22) + eo, 512, 64 * kb, n0, Wgu, 1024, (n0 >> 7) * 256 + 128 + (n0 & 127), 64 * kb, nullptr, scr, lane); return; } r -= EI_G;
    { const int kb = r / 32, nb = r % 32; tr_item(PTP(23) + eo, 1024, 64 * kb, 32 * nb, Wd, 512, 32 * nb, 64 * kb, nullptr, scr, lane); }
}

__device__ __forceinline__ void sincos_acc(float angf, float& s, float& c) {
    const double a = (double)angf; const double k = rint(a * 0.15915494309189535); double r = a - k * 6.283185307179586;
    double sgn = 1.0; if (r > 1.5707963267948966) { r = 3.141592653589793 - r; sgn = -1.0; } else if (r < -1.5707963267948966) { r = -3.141592653589793 - r; sgn = -1.0; }
    const double x2 = r * r;
    double ps = -1.0 / 1307674368000.0; ps = ps * x2 + 1.0 / 6227020800.0; ps = ps * x2 - 1.0 / 39916800.0; ps = ps * x2 + 1.0 / 362880.0; ps = ps * x2 - 1.0 / 5040.0; ps = ps * x2 + 1.0 / 120.0; ps = ps * x2 - 1.0 / 6.0; ps = ps * x2 + 1.0;
    double pc = 1.0 / 20922789888000.0; pc = pc * x2 - 1.0 / 87178291200.0; pc = pc * x2 + 1.0 / 479001600.0; pc = pc * x2 - 1.0 / 3628800.0; pc = pc * x2 + 1.0 / 40320.0; pc = pc * x2 - 1.0 / 720.0; pc = pc * x2 + 1.0 / 24.0; pc = pc * x2 - 0.5; pc = pc * x2 + 1.0;
    s = (float)(r * ps); c = (float)(sgn * pc);
}

__device__ __forceinline__ void norm_row(const float* xrow, bf16_t* orow, const float* g, const float* mod, int which, int lane, f32x4* hout) {
    const f32x4* xr = (const f32x4*)xrow + lane;
    f32x4 v[4]; float ss = 0.f;
#pragma unroll
    for (int j = 0; j < 4; ++j) { v[j] = xr[64 * j]; ss += (v[j][0] * v[j][0] + v[j][1] * v[j][1]) + (v[j][2] * v[j][2] + v[j][3] * v[j][3]); }
    const float rstd = rsqrtf(wave_sum(ss) * (1.0f / DM) + EPS);
    const f32x4* g4 = (const f32x4*)g + lane; const f32x4* sh4 = (const f32x4*)(mod + which * 3072) + lane; const f32x4* sc4 = (const f32x4*)(mod + which * 3072 + 1024) + lane;
    u32x2* o8 = (u32x2*)orow + lane;
#pragma unroll
    for (int j = 0; j < 4; ++j) { const f32x4 hv = v[j] * rstd * g4[64 * j] * (sc4[64 * j] + 1.0f) + sh4[64 * j]; if (hout) hout[j] = hv;
        u32x2 w; w.x = cvt_pk_bf16(hv[0], hv[1]); w.y = cvt_pk_bf16(hv[2], hv[3]); o8[64 * j] = w; }
}

__device__ __forceinline__ float sumsq8(u32x4 v) { float s = 0.f;
#pragma unroll
    for (int j = 0; j < 4; ++j) { const float a = bflo(v[j]), b = bfhi(v[j]); s += a * a + b * b; } return s; }

__device__ __forceinline__ void prep_row(int r, int tg, bf16_t* Z, bf16_t* KB, bf16_t* AC, float* rstdq, float* rstdkv,
                                         const float* cosR, const float* sinR, const float* cosM, const float* sinM, const float* convw, int lane) {
    bf16_t* zr = Z + (size_t)r * ZLD;
    float sq = 0.f, skv = 0.f;
    if (lane < 48) sq = sumsq8(*(const u32x4*)(zr + ZC_QLAT + lane * 8));
    if (lane < 32) skv = sumsq8(*(const u32x4*)(zr + ZC_KVLAT + lane * 8));
    sq = wave_sum(sq); skv = wave_sum(skv);
    if (lane == 0) { rstdq[r] = rsqrtf(sq * (1.0f / 384.0f) + EPS); rstdkv[r] = rsqrtf(skv * (1.0f / 256.0f) + EPS); }
    if (lane < 16) { const float x1 = bf1(zr[ZC_KROPE + lane]), x2 = bf1(zr[ZC_KROPE + 16 + lane]); const float c = cosM[(size_t)tg * 16 + lane], s = sinM[(size_t)tg * 16 + lane];
        const bf16_t o1 = (bf16_t)f2bf(x1 * c - x2 * s), o2 = (bf16_t)f2bf(x1 * s + x2 * c); bf16_t* kr = KB + (size_t)r * 768 + 64 + lane;
#pragma unroll
        for (int h = 0; h < 8; ++h) { kr[h * 96] = o1; kr[h * 96 + 16] = o2; } }
    { const int s = tg & (SEQ - 1); const int ch = lane * 8;
      float y[8];
#pragma unroll
      for (int j = 0; j < 8; ++j) y[j] = 0.f;
#pragma unroll
      for (int k = 0; k < 3; ++k) { const int back = 2 - k; if (s >= back) { const bf16_t* zz = zr - (size_t)back * ZLD;
          const u32x4 cc = *(const u32x4*)(zz + ZC_CC + ch), cx = *(const u32x4*)(zz + ZC_CX + ch); const f32x4 w0 = *(const f32x4*)(convw + k * 512 + ch), w1 = *(const f32x4*)(convw + k * 512 + ch + 4);
          const float wv[8] = {w0[0], w0[1], w0[2], w0[3], w1[0], w1[1], w1[2], w1[3]};
#pragma unroll
          for (int j = 0; j < 4; ++j) { y[2 * j] += wv[2 * j] * (bflo(cc[j]) * bflo(cx[j])); y[2 * j + 1] += wv[2 * j + 1] * (bfhi(cc[j]) * bfhi(cx[j])); } } }
      const u32x4 cb = *(const u32x4*)(zr + ZC_CB + ch); u32x4 w;
#pragma unroll
      for (int j = 0; j < 4; ++j) w[j] = cvt_pk_bf16(bflo(cb[j]) * y[2 * j], bfhi(cb[j]) * y[2 * j + 1]);
      *(u32x4*)(AC + (size_t)r * 2048 + 512 + ch) = w; }
    { const int hh = lane >> 4, i0 = (lane & 15) * 4; const f32x4 c = *(const f32x4*)(cosR + (size_t)tg * 64 + i0), s = *(const f32x4*)(sinR + (size_t)tg * 64 + i0);
#pragma unroll
      for (int tsel = 0; tsel < 2; ++tsel) { bf16_t* base = zr + (tsel ? ZC_RK : ZC_RQ) + hh * 128 + i0; const float scl = tsel ? 0.08838834764831845f : 1.0f;
          const u32x2 a = *(const u32x2*)base, b = *(const u32x2*)(base + 64);
          const float x1[4] = {bflo(a.x), bfhi(a.x), bflo(a.y), bfhi(a.y)}, x2[4] = {bflo(b.x), bfhi(b.x), bflo(b.y), bfhi(b.y)};
          float o1[4], o2[4];
#pragma unroll
          for (int j = 0; j < 4; ++j) { o1[j] = (x1[j] * c[j] - x2[j] * s[j]) * scl; o2[j] = (x1[j] * s[j] + x2[j] * c[j]) * scl; }
          u32x2 wa, wb; wa.x = cvt_pk_bf16(o1[0], o1[1]); wa.y = cvt_pk_bf16(o1[2], o1[3]); wb.x = cvt_pk_bf16(o2[0], o2[1]); wb.y = cvt_pk_bf16(o2[2], o2[3]);
          *(u32x2*)base = wa; *(u32x2*)(base + 64) = wb; } }
}

#ifndef PH_MASK
#define PH_MASK 0xFFFFFFFFu
#endif
#define PH(n) ((PH_MASK >> (n)) & 1u)
#define WSP() ((unsigned char*)INP(25))
#define OUTP() ((float*)INP(26))
#define GRIDBAR() do { XcdBarrier _b; _b.bar = (unsigned*)(WSP() + WS_CTL) + CW_BAR; _b.x = xb_xcc_id(); _b.st = MISC + 8; xcd_barrier(_b); } while (0)
#define LDSP(off) ({ LAS unsigned char* _b = (LAS unsigned char*)lds_raw; asm volatile("" : "+v"(_b)); _b + (off); })
#define INP(i) ({ const unsigned long long _v = *(volatile LAS unsigned long long*)LDSP(MISC_OFF + 512 + 8 * (i)); (const float*)(const GAS float*)(((unsigned long long)(unsigned)__builtin_amdgcn_readfirstlane((int)(_v >> 32)) << 32) | (unsigned long long)(unsigned)__builtin_amdgcn_readfirstlane((int)_v)); })
#define PHASE_BEGIN unsigned char* w_ = WSP(); LAS unsigned char* lds = LDSP(0); LAS int* TP = (LAS int*)(lds + MISC_OFF + 256); \
    volatile LAS unsigned long long* PT = (volatile LAS unsigned long long*)(lds + MISC_OFF + 512); (void)TP; (void)PT; \
    int bx = blockIdx.x; asm volatile("" : "+s"(bx)); int tid = tid0; asm volatile("" : "+v"(tid)); \
    const int lane = tid & 63, wave = __builtin_amdgcn_readfirstlane(tid >> 6), gw = bx * NW + wave, NGW = G * NW; (void)lane; (void)gw; (void)NGW; \
    float* const xres = OUTP(); (void)xres;
__global__ void __launch_bounds__(NW * 64, 2) fwd_kernel(Args args) {
    extern __shared__ __attribute__((aligned(16))) unsigned char lds_raw[];
#define MISC ((volatile LAS unsigned*)LDSP(MISC_OFF))
#define TPTR ((LAS int*)LDSP(MISC_OFF + 256))
#define PTAB ((volatile LAS unsigned long long*)LDSP(MISC_OFF + 512))
    const int tid0 = threadIdx.x;
#define G ((int)gridDim.x)

    { LAS unsigned char* lds = LDSP(0); for (int u = tid0; u < 128; u += NW * 64) ((LAS unsigned*)(lds + MISC_OFF))[u] = 0u; }
    { volatile LAS unsigned long long* PT = PTAB;
#pragma unroll
    for (int i = 0; i < 25; ++i) if (tid0 == i) PT[i] = (unsigned long long)args.in[i];
    if (tid0 == 25) PT[25] = (unsigned long long)args.ws;
    if (tid0 == 26) PT[26] = (unsigned long long)args.out; }
    __syncthreads();
    (void)xcd_barrier_post((unsigned*)(WSP() + WS_CTL) + CW_BAR, MISC + 8);

    if (PH(0)) {
        PHASE_BEGIN
        float* MODT = (float*)(w_ + WS_MODT);
        LAS float* sc = (LAS float*)lds;
        LAS float* red = (LAS float*)(lds + 16384);
        { const float* cin = INP(1); for (int i = tid; i < 4096; i += NW * 64) sc[i] = siluf_(cin[i]); }
        __syncthreads();
        { const float* wada = INP(3); const float* bada = INP(4);
        for (int it = bx; it < 2 * 192; it += G) {
            const int l = it / 192, c0 = (it % 192) * 32, kp = tid >> 5, col = tid & 31;
            const float* w = wada + (size_t)l * 1024 * 6144 + (size_t)(kp * 64) * 6144 + c0 + col;
            float a0 = 0.f, a1 = 0.f, a2 = 0.f, a3 = 0.f;
#pragma unroll 16
            for (int k = 0; k < 64; ++k) { const float wv = w[(size_t)k * 6144]; const int kk = kp * 64 + k; a0 += sc[kk] * wv; a1 += sc[1024 + kk] * wv; a2 += sc[2048 + kk] * wv; a3 += sc[3072 + kk] * wv; }
            red[(kp * 4 + 0) * 32 + col] = a0; red[(kp * 4 + 1) * 32 + col] = a1; red[(kp * 4 + 2) * 32 + col] = a2; red[(kp * 4 + 3) * 32 + col] = a3;
            __syncthreads();
            if (tid < 128) { const int b = tid >> 5; float s = bada[l * 6144 + c0 + col];
#pragma unroll
                for (int p = 0; p < 16; ++p) s += red[(p * 4 + b) * 32 + col];
                MODT[(size_t)(l * 4 + b) * 6144 + c0 + col] = s; }
            __syncthreads();
        } }
        { const int* pos = (const int*)INP(2);
          float* COSR = (float*)(w_ + WS_COSR); float* SINR = (float*)(w_ + WS_SINR); float* COSM = (float*)(w_ + WS_COSM); float* SINM = (float*)(w_ + WS_SINM);
          for (int i = bx * NW * 64 + tid; i < T * 64; i += G * NW * 64) { const int tg = i >> 6, f = i & 63; float s, c; sincos_acc((float)pos[tg] * args.invR[f], s, c); COSR[i] = c; SINR[i] = s; }
          for (int i = bx * NW * 64 + tid; i < T * 16; i += G * NW * 64) { const int tg = i >> 4, f = i & 15; float s, c; sincos_acc((float)pos[tg] * args.invM[f], s, c); COSM[i] = c; SINM[i] = s; } }
        __syncthreads();
        LAS float* scr = (LAS float*)(lds + wave * 16384);
        for (int it = gw; it < 2 * MI_TOTAL; it += NGW) { const int l = it / MI_TOTAL; mixer_weight_item(PT, l, it % MI_TOTAL, w_ + WS_WMIX + (size_t)l * WMIX_LAYER, scr, lane); }
    }
    GRIDBAR();

    for (int l = 0; l < DEPTH; ++l) {
        for (int half = 0; half < 2; ++half) {
            const int tok0 = half * TH;
            if (PH(1)) { PHASE_BEGIN bf16_t* XN = (bf16_t*)(w_ + WS_ARENA + AR_XN); const float* MODT = (const float*)(w_ + WS_MODT);
                const float* xcur = (l == 0) ? INP(0) : (const float*)xres; const float* gmix = INP(5) + l * DM;
                for (int r = gw; r < TH; r += NGW) { const int tg = tok0 + r; const int b = tg / SEQ;
                    norm_row(xcur + (size_t)tg * DM, XN + (size_t)r * DM, gmix, MODT + (size_t)(l * 4 + b) * 6144, 0, lane, nullptr); } }
            GRIDBAR();
            if (PH(2)) { PHASE_BEGIN
              pg8::Gemm g{(const bf16_t*)(w_ + WS_ARENA + AR_XN), (const bf16_t*)(w_ + WS_WMIX + (size_t)l * WMIX_LAYER + WM_IN), DM, DM, DM, 0u}; pg8::StaticOrder S; S.init(TH, ZLD, G, bx);
              pg8::EpiBf16<0> E{(bf16_t*)(w_ + WS_ARENA + AR_Z), ZLD, nullptr, nullptr, 0};
              pg8::gemm_phase<pg8::EpiBf16<0>, pg8::StaticOrder, true>(lds, g, S, E); }
            GRIDBAR();
            if (PH(3)) { PHASE_BEGIN const float* convw = INP(13) + l * 3 * 512;
                for (int r = gw; r < TH; r += NGW)
                    prep_row(r, tok0 + r, (bf16_t*)(w_ + WS_ARENA + AR_Z), (bf16_t*)(w_ + WS_ARENA + AR_KB), (bf16_t*)(w_ + WS_ARENA + AR_AC), (float*)(w_ + WS_RSTDQ), (float*)(w_ + WS_RSTDKV),
                             (const float*)(w_ + WS_COSR), (const float*)(w_ + WS_SINR), (const float*)(w_ + WS_COSM), (const float*)(w_ + WS_SINM), convw, lane); }
            GRIDBAR();
            if (PH(4)) { PHASE_BEGIN
              pg8::Gemm g{(const bf16_t*)(w_ + WS_ARENA + AR_Z) + ZC_QLAT, (const bf16_t*)(w_ + WS_WMIX + (size_t)l * WMIX_LAYER + WM_UQ), ZLD, 384, 384, 0u}; pg8::StaticOrder S; S.init(TH, 768, G, bx);
              pg8::EpiBf16<0> E{(bf16_t*)(w_ + WS_ARENA + AR_QB), 768, (const float*)(w_ + WS_RSTDQ), nullptr, 0};
              pg8::gemm_phase<pg8::EpiBf16<0>, pg8::StaticOrder, true>(lds, g, S, E); }
            if (PH(5)) { PHASE_BEGIN
              pg8::Gemm g{(const bf16_t*)(w_ + WS_ARENA + AR_Z) + ZC_KVLAT, (const bf16_t*)(w_ + WS_WMIX + (size_t)l * WMIX_LAYER + WM_UKV), ZLD, 256, 256, 0u}; pg8::StaticOrder S; S.init(TH, 1024, G, bx);
              pg8::EpiBf16<1> E{(bf16_t*)(w_ + WS_ARENA + AR_KB), 768, (const float*)(w_ + WS_RSTDKV), (bf16_t*)(w_ + WS_ARENA + AR_VB), 512};
              pg8::gemm_phase<pg8::EpiBf16<1>, pg8::StaticOrder, true>(lds, g, S, E); }
            if (PH(6)) { PHASE_BEGIN
              for (int it = bx; it < 1024; it += G) ret::kvloc_unit(it >> 7, it & 127, (const bf16_t*)(w_ + WS_ARENA + AR_Z), (bf16_t*)(w_ + WS_ARENA + AR_RS), (LAS char*)lds); }
            GRIDBAR();
            if (PH(7)) { PHASE_BEGIN
              for (int p = bx; p < 256; p += G) { const int bh = p >> 4, s = p & 15;
#pragma unroll 1
                for (int k = 0; k < 2; ++k)
                  att::attn_unit(bh >> 3, bh & 7, k ? s : 31 - s, (const bf16_t*)(w_ + WS_ARENA + AR_QB), (const bf16_t*)(w_ + WS_ARENA + AR_KB), (const bf16_t*)(w_ + WS_ARENA + AR_VB), (bf16_t*)(w_ + WS_ARENA + AR_AC),
                                 (const float*)(w_ + WS_COSM), (const float*)(w_ + WS_SINM), tok0, (LAS char*)lds); } }
            if (PH(8)) { PHASE_BEGIN ret::scan_all((bf16_t*)(w_ + WS_ARENA + AR_RS), bx * NW * 64 + tid, G * NW * 64); }
            GRIDBAR();
            if (PH(9)) { PHASE_BEGIN
              for (int it = bx; it < 1024; it += G) ret::out_unit(it >> 7, it & 127, (const bf16_t*)(w_ + WS_ARENA + AR_Z), (const bf16_t*)(w_ + WS_ARENA + AR_RS), (bf16_t*)(w_ + WS_ARENA + AR_AC), (LAS char*)lds); }
            GRIDBAR();
            if (PH(10)) { PHASE_BEGIN
              pg8::Gemm g{(const bf16_t*)(w_ + WS_ARENA + AR_AC), (const bf16_t*)(w_ + WS_WMIX + (size_t)l * WMIX_LAYER + WM_CAT), 2048, 2048, 2048, 0u}; pg8::StaticOrder S; S.init(TH, DM, G, bx);
              pg8::EpiMerge E{(const bf16_t*)(w_ + WS_ARENA + AR_Z), (bf16_t*)(w_ + WS_ARENA + AR_XN)};
              pg8::gemm_phase<pg8::EpiMerge, pg8::StaticOrder, false>(lds, g, S, E); }
            GRIDBAR();
            if (PH(11)) { PHASE_BEGIN const float* xcur = (l == 0) ? INP(0) : (const float*)xres;
              pg8::Gemm g{(const bf16_t*)(w_ + WS_ARENA + AR_XN), (const bf16_t*)(w_ + WS_WMIX + (size_t)l * WMIX_LAYER + WM_MIX), DM, DM, DM, 0u}; pg8::StaticOrder S; S.init(TH, DM, G, bx);
              pg8::EpiResid E{xcur + (size_t)tok0 * DM, xres + (size_t)tok0 * DM, (const float*)(w_ + WS_MODT) + (size_t)(l * 4 + half * 2) * 6144 + 2048};
              pg8::gemm_phase<pg8::EpiResid, pg8::StaticOrder, false>(lds, g, S, E); }
            GRIDBAR();
        }
        if (PH(12)) {
            PHASE_BEGIN
            LAS float* WL = (LAS float*)lds;
            { const float* wrg = INP(17) + (size_t)l * 1024 * 4; const float* wre = INP(19) + (size_t)l * 1024 * 32;
              for (int k = tid; k < 1024; k += NW * 64) { const f32x4 a = *(const f32x4*)(wrg + k * 4);
                WL[0 * 1024 + k] = a[0]; WL[1 * 1024 + k] = a[1]; WL[2 * 1024 + k] = a[2]; WL[3 * 1024 + k] = a[3];
#pragma unroll
                for (int q = 0; q < 8; ++q) { const f32x4 e4 = *(const f32x4*)(wre + k * 32 + q * 4); WL[(4 + 4 * q + 0) * 1024 + k] = e4[0]; WL[(4 + 4 * q + 1) * 1024 + k] = e4[1]; WL[(4 + 4 * q + 2) * 1024 + k] = e4[2]; WL[(4 + 4 * q + 3) * 1024 + k] = e4[3]; } } }
            __syncthreads();
            float bias = 0.f; if (lane < 4) bias = (INP(18) + l * 4)[lane]; else if (lane < 36) bias = (INP(20) + l * 32)[lane - 4];
            const float* gffn = INP(6) + l * DM; const float* MODT = (const float*)(w_ + WS_MODT);
            bf16_t* H2 = (bf16_t*)(w_ + WS_ARENA + AR_H2); unsigned* ROUTE = (unsigned*)(w_ + WS_ROUTE); unsigned* cnt = (unsigned*)(w_ + WS_CTL) + CW_CNT + l * 32 * 16;
            for (int tg = gw; tg < T; tg += NGW) { const int b = tg / SEQ;
                f32x4 hv[4];
                norm_row(xres + (size_t)tg * DM, H2 + (size_t)tg * DM, gffn, MODT + (size_t)(l * 4 + b) * 6144, 1, lane, hv);
                float mylg = 0.f;
#pragma unroll 4
                for (int j = 0; j < 36; ++j) { float p = 0.f;
#pragma unroll
                    for (int q = 0; q < 4; ++q) { const f32x4 w = *(const LAS f32x4*)(WL + j * 1024 + 4 * lane + 256 * q); p += (hv[q][0] * w[0] + hv[q][1] * w[1]) + (hv[q][2] * w[2] + hv[q][3] * w[3]); }
                    p = wave_sum(p); if (lane == j) mylg = p; }
                mylg += bias;
                float gl[4];
#pragma unroll
                for (int q = 0; q < 4; ++q) gl[q] = __shfl(mylg, q);
                float gm = gl[0]; int gi = 0;
#pragma unroll
                for (int q = 1; q < 4; ++q) if (gl[q] > gm) { gm = gl[q]; gi = q; }
                float gs = 0.f;
#pragma unroll
                for (int q = 0; q < 4; ++q) gs += __expf(gl[q] - gm);
                const float gval = 1.0f / gs;
                float el[8];
#pragma unroll
                for (int k = 0; k < 8; ++k) el[k] = __shfl(mylg, 4 + gi * 8 + k);
                float m1 = el[0]; int i1 = 0;
#pragma unroll
                for (int k = 1; k < 8; ++k) if (el[k] > m1) { m1 = el[k]; i1 = k; }
                float m2 = -3.0e38f; int i2 = 0;
#pragma unroll
                for (int k = 0; k < 8; ++k) if (k != i1 && el[k] > m2) { m2 = el[k]; i2 = k; }
                const float p2 = __expf(m2 - m1); const float w1 = gval / (1.0f + p2), w2 = gval * p2 / (1.0f + p2);
                if (lane == 0) { const int e1 = gi * 8 + i1, e2 = gi * 8 + i2;
                    const unsigned r1 = atomicAdd(cnt + e1 * 16, 1u), r2 = atomicAdd(cnt + e2 * 16, 1u);
                    u32x4 a; a.x = (unsigned)e1; a.y = (unsigned)e2; a.z = __float_as_uint(w1); a.w = __float_as_uint(w2);
                    *(u32x4*)(ROUTE + (size_t)tg * 8) = a; ROUTE[(size_t)tg * 8 + 4] = r1; ROUTE[(size_t)tg * 8 + 5] = r2; }
            }
        }
        GRIDBAR();
        if (PH(13)) {
            PHASE_BEGIN unsigned* cnt = (unsigned*)(w_ + WS_CTL) + CW_CNT + l * 32 * 16;
            if (tid == 0) { int acc = 0;
                for (int e = 0; e < 32; ++e) { TP[e] = acc; const unsigned c = __hip_atomic_load(cnt + e * 16, RLX_AGENT); acc += (int)((c + 255u) >> 8); }
                TP[32] = acc; }
            __syncthreads();
            bf16_t* H2 = (bf16_t*)(w_ + WS_ARENA + AR_H2); bf16_t* XS = (bf16_t*)(w_ + WS_ARENA + AR_XS); unsigned* ROUTE = (unsigned*)(w_ + WS_ROUTE);
            for (int tg = gw; tg < T; tg += NGW) {
                const u32x4 a = *(const u32x4*)(ROUTE + (size_t)tg * 8); const unsigned r1 = ROUTE[(size_t)tg * 8 + 4], r2 = ROUTE[(size_t)tg * 8 + 5];
                const unsigned p1 = (unsigned)TP[a.x] * 256u + r1, p2 = (unsigned)TP[a.y] * 256u + r2;
                const u32x4* src = (const u32x4*)(H2 + (size_t)tg * DM); const u32x4 v0 = src[lane], v1 = src[lane + 64];
                u32x4* d1 = (u32x4*)(XS + (size_t)p1 * DM); u32x4* d2 = (u32x4*)(XS + (size_t)p2 * DM);
                d1[lane] = v0; d1[lane + 64] = v1; d2[lane] = v0; d2[lane + 64] = v1;
                if (lane == 0) { ROUTE[(size_t)tg * 8 + 6] = p1; ROUTE[(size_t)tg * 8 + 7] = p2; }
            }
            LAS float* scr = (LAS float*)(lds + wave * 16384);
            for (int it = gw; it < EI_TOTAL; it += NGW) expert_weight_item(PT, l, it, w_ + WS_ARENA + AR_WEXP, scr, lane);
        }
        GRIDBAR();
        if (PH(14)) { PHASE_BEGIN
          pg8::Gemm g{(const bf16_t*)(w_ + WS_ARENA + AR_XS), (const bf16_t*)(w_ + WS_ARENA + AR_WEXP + WE_GU), DM, DM, DM, 1024u * 1024u * 2u}; pg8::ExpertOrder S{TP, G, bx};
          pg8::EpiGU E{(bf16_t*)(w_ + WS_ARENA + AR_HID)};
          pg8::gemm_phase<pg8::EpiGU, pg8::ExpertOrder, true>(lds, g, S, E); }
        GRIDBAR();
        if (PH(15)) { PHASE_BEGIN
          pg8::Gemm g{(const bf16_t*)(w_ + WS_ARENA + AR_HID), (const bf16_t*)(w_ + WS_ARENA + AR_WEXP + WE_D), EFF, EFF, EFF, 1024u * 512u * 2u}; pg8::ExpertOrder S{TP, G, bx};
          pg8::EpiBf16<0> E{(bf16_t*)(w_ + WS_ARENA + AR_YS), DM, nullptr, nullptr, 0};
          pg8::gemm_phase<pg8::EpiBf16<0>, pg8::ExpertOrder, true>(lds, g, S, E); }
        GRIDBAR();
        if (PH(16)) { PHASE_BEGIN const unsigned* ROUTE = (const unsigned*)(w_ + WS_ROUTE); const bf16_t* YS = (const bf16_t*)(w_ + WS_ARENA + AR_YS); const float* MODT = (const float*)(w_ + WS_MODT);
          const float* fgp = INP(24);
          for (int tg = gw; tg < T; tg += NGW) { const int b = tg / SEQ;
            const u32x4 a = *(const u32x4*)(ROUTE + (size_t)tg * 8); const unsigned p1 = ROUTE[(size_t)tg * 8 + 6], p2 = ROUTE[(size_t)tg * 8 + 7];
            const float w1 = __uint_as_float(a.z), w2 = __uint_as_float(a.w);
            f32x4* xr = (f32x4*)(xres + (size_t)tg * DM) + lane; const u32x2* y1 = (const u32x2*)(YS + (size_t)p1 * DM) + lane; const u32x2* y2 = (const u32x2*)(YS + (size_t)p2 * DM) + lane;
            const f32x4* gt = (const f32x4*)(MODT + (size_t)(l * 4 + b) * 6144 + 5120) + lane;
            f32x4 v[4]; float ss = 0.f;
#pragma unroll
            for (int j = 0; j < 4; ++j) { const u32x2 ya = y1[64 * j], yb = y2[64 * j];
                const f32x4 m = (f32x4){bflo(ya.x), bfhi(ya.x), bflo(ya.y), bfhi(ya.y)} * w1 + (f32x4){bflo(yb.x), bfhi(yb.x), bflo(yb.y), bfhi(yb.y)} * w2;
                v[j] = xr[64 * j] + gt[64 * j] * m; ss += (v[j][0] * v[j][0] + v[j][1] * v[j][1]) + (v[j][2] * v[j][2] + v[j][3] * v[j][3]); }
            if (l == DEPTH - 1) { const float rstd = rsqrtf(wave_sum(ss) * (1.0f / DM) + EPS); const f32x4* fg = (const f32x4*)fgp + lane;
#pragma unroll
                for (int j = 0; j < 4; ++j) xr[64 * j] = v[j] * rstd * fg[64 * j]; }
            else {
#pragma unroll
                for (int j = 0; j < 4; ++j) xr[64 * j] = v[j]; }
          } }
        if (l + 1 < DEPTH) GRIDBAR();
    }
}

#undef G
#undef MISC
extern "C" void kernel_launch(void* const* d_in, const int* in_sizes, int n_in, void* d_out, int out_size, void* d_ws, size_t ws_size, hipStream_t stream) {
    static int grid = 0;
    if (grid == 0) {
        if (n_in != 25 || out_size != T * DM || ws_size < WS_END) { fprintf(stderr, "kernel_launch: unexpected shapes (n_in %d, out %d, ws %zu < %zu)\n", n_in, out_size, ws_size, (size_t)WS_END); grid = -1; return; }
        int dev = 0, cus = 0;
        if (hipGetDevice(&dev) != hipSuccess || hipDeviceGetAttribute(&cus, hipDeviceAttributeMultiprocessorCount, dev) != hipSuccess) { grid = -1; return; }
        if (hipFuncSetAttribute((const void*)fwd_kernel, hipFuncAttributeMaxDynamicSharedMemorySize, LDS_BYTES) != hipSuccess) { fprintf(stderr, "kernel_launch: hipFuncSetAttribute failed\n"); grid = -1; return; }
        int per_cu = 0;
        if (hipOccupancyMaxActiveBlocksPerMultiprocessor(&per_cu, (const void*)fwd_kernel, NW * 64, LDS_BYTES) != hipSuccess || per_cu < 1) { fprintf(stderr, "kernel_launch: occupancy query says %d\n", per_cu); }
        (void)hipGetLastError();
        grid = cus;
    }
    if (grid < 0) return;
    (void)hipMemsetAsync((char*)d_ws + WS_CTL, 0, CTL_ZERO_BYTES, stream);
    Args a{};
    for (int i = 0; i < 25; ++i) a.in[i] = (const float*)d_in[i];
    a.out = (float*)d_out; a.ws = (unsigned char*)d_ws;
    for (int i = 0; i < 64; ++i) a.invR[i] = powf(10000.0f, -(float)(2 * i) / 128.0f);
    for (int i = 0; i < 16; ++i) a.invM[i] = powf(10000.0f, -(float)(2 * i) / 32.0f);
    hipLaunchKernelGGL(fwd_kernel, dim3(grid), dim3(NW * 64), LDS_BYTES, stream, a);
    const hipError_t le = hipPeekAtLastError();
    if (le != hipSuccess) fprintf(stderr, "kernel_launch: launch failed: %s\n", hipGetErrorName(le));
}
```

```cpp
#include <hip/hip_runtime.h>
#include <cstdio>
#include <cstdint>
#include <cmath>

#define LAS __attribute__((address_space(3)))
#define GAS __attribute__((address_space(1)))
typedef unsigned short bf16_t;
typedef short bf16x8 __attribute__((ext_vector_type(8)));
typedef short s16x4 __attribute__((ext_vector_type(4)));
typedef float f32x4 __attribute__((ext_vector_type(4)));
typedef float f32x2 __attribute__((ext_vector_type(2)));
typedef float f32x16 __attribute__((ext_vector_type(16)));
typedef unsigned u32x4 __attribute__((ext_vector_type(4)));
typedef unsigned u32x2 __attribute__((ext_vector_type(2)));

constexpr int DM = 1024, NBATCH = 4, SEQ = 8192, T = NBATCH * SEQ, TH = T / 2, DEPTH = 2;
constexpr int IN_TOTAL = 8352, ZLD = 8448;
constexpr int ZC_QLAT = 0, ZC_KVLAT = 384, ZC_KROPE = 640, ZC_CB = 672, ZC_CC = 1184, ZC_CX = 1696, ZC_RQ = 2208, ZC_RK = 2720, ZC_RV = 3232, ZC_RG = 4256, ZC_GL = 5280;
constexpr int NEXP = 32, EFF = 512;
constexpr int ACLD = 2112;
constexpr int XS_ROWS = 73728;
constexpr float EPS = 1e-6f;

constexpr size_t MiB = 1u << 20;
constexpr size_t WS_CTL = 0, CTL_ZERO_BYTES = 64 * 1024;
constexpr size_t WS_MODT = 1 * MiB;
constexpr size_t WS_RSTDQ = 1 * MiB + 256 * 1024, WS_RSTDKV = 1 * MiB + 512 * 1024;
constexpr size_t WS_PERM = 1 * MiB + 576 * 1024;
constexpr size_t WS_AFS = 23 * MiB;
constexpr size_t WS_ROUTE = 2 * MiB;
constexpr size_t WS_COSR = 3 * MiB, WS_SINR = 11 * MiB, WS_COSM = 19 * MiB, WS_SINM = 21 * MiB;
constexpr size_t WS_WMIX = 24 * MiB, WMIX_LAYER = 26 * MiB;
constexpr size_t WM_IN = 0, WM_UQ = 17 * MiB, WM_UKV = 18 * MiB, WM_CAT = 19 * MiB, WM_MIX = 24 * MiB;
constexpr size_t WS_ARENA = 76 * MiB;
constexpr size_t AR_XN = 0, AR_QB = 0, AR_Z = 32 * MiB, AR_KB = 296 * MiB, AR_VB = 320 * MiB, AR_AC = 336 * MiB, AR_KROPE = 402 * MiB  , AR_RS = 404 * MiB;
constexpr size_t AR_WEXP = 0, AR_H2 = 96 * MiB, AR_HID = 160 * MiB, AR_YS = 232 * MiB;
static_assert(WM_MIX + 2 * MiB <= WMIX_LAYER && WS_WMIX + 2 * WMIX_LAYER <= WS_ARENA && WM_CAT + (size_t)1024 * ACLD * 2 <= WM_MIX && AR_AC + (size_t)TH * ACLD * 2 <= AR_KROPE && AR_KROPE + (size_t)TH * 64 <= AR_RS && AR_RS + 64 * MiB <= 468 * MiB, "weight / arena map");
constexpr size_t AR_XNB = 468 * MiB;
constexpr size_t AR_XR = 500 * MiB;
constexpr size_t WS_END = WS_ARENA + 564 * MiB;
constexpr size_t WE_GU = 0, WE_D = (size_t)NEXP * 1024 * 1024 * 2;
constexpr int CW_TMO = 0, CW_CODE = 1, CW_BAR = 4096, CW_CNT = 8192;

constexpr int LDS_BYTES = 160 * 1024;
constexpr int MISC_OFF = LDS_BYTES - 1024;

#define RLX_AGENT __ATOMIC_RELAXED, __HIP_MEMORY_SCOPE_AGENT
__device__ __forceinline__ unsigned f2bf(float f) { unsigned u = __builtin_bit_cast(unsigned, f); return (u + 0x7fffu + ((u >> 16) & 1u)) >> 16; }
__device__ __forceinline__ unsigned pk2(float lo, float hi) { return f2bf(lo) | (f2bf(hi) << 16); }
typedef __bf16 bf16x2_t __attribute__((ext_vector_type(2)));
__device__ __forceinline__ unsigned cvt_pk_bf16(float lo, float hi) { f32x2 v = {lo, hi}; bf16x2_t b = __builtin_convertvector(v, bf16x2_t); return __builtin_bit_cast(unsigned, b); }
__device__ __forceinline__ float bflo(unsigned u) { return __builtin_bit_cast(float, u << 16); }
__device__ __forceinline__ float bfhi(unsigned u) { return __builtin_bit_cast(float, u & 0xffff0000u); }
__device__ __forceinline__ float bf1(bf16_t v) { return __builtin_bit_cast(float, (unsigned)v << 16); }
__device__ __forceinline__ float dpp_f(float v, int ctrl_sel) {
    const int x = __builtin_bit_cast(int, v); int r;
    if (ctrl_sel == 0) r = __builtin_amdgcn_update_dpp(x, x, 0xB1, 0xF, 0xF, false);
    else if (ctrl_sel == 1) r = __builtin_amdgcn_update_dpp(x, x, 0x4E, 0xF, 0xF, false);
    else if (ctrl_sel == 2) r = __builtin_amdgcn_update_dpp(x, x, 0x141, 0xF, 0xF, false);
    else r = __builtin_amdgcn_update_dpp(x, x, 0x140, 0xF, 0xF, false);
    return __builtin_bit_cast(float, r);
}
__device__ __forceinline__ float wave_sum(float v) {
    v += dpp_f(v, 0); v += dpp_f(v, 1); v += dpp_f(v, 2); v += dpp_f(v, 3);
    { auto rr = __builtin_amdgcn_permlane16_swap(__float_as_uint(v), __float_as_uint(v), false, false); v = __uint_as_float(rr[0]) + __uint_as_float(rr[1]); }
    { auto rr = __builtin_amdgcn_permlane32_swap(__float_as_uint(v), __float_as_uint(v), false, false); v = __uint_as_float(rr[0]) + __uint_as_float(rr[1]); }
    return v;
}
__device__ __forceinline__ float vmax3_(float a, float b, float c) { float r; asm("v_max3_f32 %0, %1, %2, %3" : "=v"(r) : "v"(a), "v"(b), "v"(c)); return r; }
__device__ __forceinline__ float vmax2_(float a, float b) { float r; asm("v_max_f32 %0, %1, %2" : "=v"(r) : "v"(a), "v"(b)); return r; }
__device__ __forceinline__ float sigmoidf_(float a) { return __builtin_amdgcn_rcpf(1.0f + __expf(-a)); }
__device__ __forceinline__ float siluf_(float a) { return a * __builtin_amdgcn_rcpf(1.0f + __expf(-a)); }

namespace pg8 {
constexpr int BM = 256, BK = 64, HALF = 128, HTB = HALF * BK * 2, STAGE_BYTES = 8 * HTB, NXCD = 8, WGM = 8;
__host__ __device__ __forceinline__ int lds_byte(int r, int c) { const int st = (r >> 4) * 2 + (c >> 5), rr = r & 15, cc = c & 31, ob = rr * 64 + cc * 2; return st * 1024 + (ob ^ (((ob >> 9) & 1) << 5)); }
__host__ __device__ __forceinline__ void stage_rc(int b, int& R, int& C) { const int st = b / 1024, sb = b % 1024, swz = sb ^ (((sb >> 9) & 1) << 5); R = (st >> 1) * 16 + swz / 64; C = (st & 1) * 32 + (swz % 64) / 2; }
__host__ __device__ __forceinline__ int perm32(int rho) { const int n = rho >> 4, i = rho & 15; return 8 * (i >> 2) + 4 * n + (i & 3); }

struct Unit { int pm, pn, e; };
struct Gemm { const bf16_t* A; const bf16_t* Bt; int lda, ldb, K; unsigned bes; const int* perm; };

struct StaticOrder {
    int nM, nN, nwg, G, c;
    __device__ void init(int M, int N, int G_, int c_) { nM = M / BM; nN = N / BM; nwg = nM * nN; G = G_; c = c_; }
    __device__ bool next(int i, Unit& u) const {
        const long L = (long)i * G + c; if (L >= nwg) return false;
        int wgid = (int)L; { const int q = nwg / NXCD, r = nwg % NXCD, xcd = wgid % NXCD, off = wgid / NXCD; wgid = (xcd < r ? xcd * (q + 1) : r * (q + 1) + (xcd - r) * q) + off; }
        const int nig = WGM * nN, gid = wgid / nig, fm = gid * WGM, gsz = (nM - fm) < WGM ? (nM - fm) : WGM;
        u.pm = fm + ((wgid % nig) % gsz); u.pn = (wgid % nig) / gsz; u.e = 0; return true;
    }
};
struct ExpertOrder {
    const LAS int* tp; int G, c;
    __device__ bool next(int i, Unit& u) const {
        const int L = i * G + c; const int nt = __builtin_amdgcn_readfirstlane(tp[32]);
        if (L >= nt * 4) return false;
        const int rt = L >> 2; u.pm = rt; u.pn = L & 3;
        int e = 0;
#pragma unroll
        for (int s = 16; s >= 1; s >>= 1) { const int v = __builtin_amdgcn_readfirstlane(tp[e + s]); if (v <= rt) e += s; }
        u.e = e; return true;
    }
};

typedef f32x4 Acc[2][2][4][2];

template <class Epi, class Sched, bool ALIGN_EPI, bool GATHER = false>
__device__ __forceinline__ void gemm_phase(LAS unsigned char* lds, const Gemm g, const Sched& S, const Epi& E) {
    int tid_ = threadIdx.x; asm volatile("" : "+v"(tid_));
    const int tid = tid_, wid = __builtin_amdgcn_readfirstlane(tid >> 6), lane = tid & 63, wr = wid >> 2, wc = wid & 3, fr = lane & 15, fq = lane >> 4;
    int K_ = g.K; asm volatile("" : "+s"(K_));
    const int nt = K_ / BK;
    unsigned voffA, voffB;
    { int R, C; stage_rc(tid * 16, R, C); const int Rb = Epi::PERM ? ((R & ~31) + perm32(R & 31)) : R;
        voffA = (unsigned)(R * g.lda + C) * 2u; voffB = (unsigned)(Rb * g.ldb + C) * 2u; }
    int ropar = 0; (void)ropar;
#define PG8_ROS(par) ((LAS u32x4*)(lds + STAGE_BYTES) + (par) * 512 + tid)
#define PG8_LOADRO(dst, pm_) do { int R_, C_; stage_rc(tid * 16, R_, C_); const int* pp_ = g.perm + (size_t)(pm_) * BM + R_; int t0_ = pp_[0], t1_ = pp_[64], t2_ = pp_[128], t3_ = pp_[192]; \
        asm volatile("s_waitcnt vmcnt(0)" : "+v"(t0_), "+v"(t1_), "+v"(t2_), "+v"(t3_) :: "memory"); const unsigned c2_ = (unsigned)C_ * 2u, ls_ = (unsigned)(g.lda * 2); \
        dst[0] = (unsigned)t0_ * ls_ + c2_; dst[1] = (unsigned)t1_ * ls_ + c2_; dst[2] = (unsigned)t2_ * ls_ + c2_; dst[3] = (unsigned)t3_ * ls_ + c2_; } while (0)
    constexpr unsigned kstep = BK * 2;
    const unsigned hstepA = (unsigned)(HALF * g.lda * 2), hstepB = (unsigned)(HALF * g.ldb * 2);
    const unsigned tstepA = 2 * hstepA, tstepB = 2 * hstepB, d64A = hstepA / 2, d64B = hstepB / 2;
    const unsigned ldsw = (unsigned)wid * 1024u;
    const unsigned ldsS = (unsigned)__builtin_amdgcn_readfirstlane((int)(unsigned)(uintptr_t)lds) + ldsw;
    const int aoff = lds_byte(wr * 64 + fr, fq * 8), boff = lds_byte(wc * 32 + fr, fq * 8);
#define PG8_SA(b, h) (((b) * 2 + (h)) * HTB)
#define PG8_SB(b, h) ((4 + (b) * 2 + (h)) * HTB)
#define PG8_STAGE_(bufoff, gbase, voff, d64) do { _Pragma("unroll") for (int _i = 0; _i < 2; ++_i) \
        __builtin_amdgcn_global_load_lds((const unsigned*)((const char*)(gbase) + (_i ? (d64) : 0u) + (voff)), (LAS unsigned*)(uintptr_t)(ldsS + (unsigned)(bufoff) + _i * 8192u), 16, 0, 0); } while (0)
#define PG8_STAGE(bufoff, gbase, voff) PG8_STAGE_(bufoff, gbase, voff, ((&(voff) == &voffA) ? d64A : d64B))
#define PG8_STAGE_A(b, h, kptr, RO) do { if constexpr (GATHER) { const u32x2 o2_ = *((const LAS u32x2*)PG8_ROS(RO) + (h)); _Pragma("unroll") for (int _i = 0; _i < 2; ++_i) \
        __builtin_amdgcn_global_load_lds((const unsigned*)((const char*)(kptr) + o2_[_i]), (LAS unsigned*)(uintptr_t)(ldsS + (unsigned)PG8_SA(b, h) + _i * 8192u), 16, 0, 0); } \
    else PG8_STAGE_(PG8_SA(b, h), (const char*)(kptr) + ((h) ? hstepA : 0u), voffA, d64A); } while (0)
#define PG8_STAGE_A2(b, h, kptr) PG8_STAGE_A(b, h, kptr, (last ? (ropar ^ 1) : ropar))
#define PG8_LDA(dst, b, h) do { _Pragma("unroll") for (int m = 0; m < 4; ++m) _Pragma("unroll") for (int k = 0; k < 2; ++k) dst[m][k] = *(const LAS bf16x8*)(lds + PG8_SA(b, h) + aoff + m * 2048 + k * 1024); } while (0)
#define PG8_LDB(dst, b, h) do { _Pragma("unroll") for (int n = 0; n < 2; ++n) _Pragma("unroll") for (int k = 0; k < 2; ++k) dst[n][k] = *(const LAS bf16x8*)(lds + PG8_SB(b, h) + boff + n * 2048 + k * 1024); } while (0)
#define PG8_MMA(ai, bj, At, Bt) do { __builtin_amdgcn_s_setprio(1); _Pragma("unroll") for (int m = 0; m < 4; ++m) _Pragma("unroll") for (int n = 0; n < 2; ++n) _Pragma("unroll") for (int k = 0; k < 2; ++k) \
        acc[ai][bj][m][n] = __builtin_amdgcn_mfma_f32_16x16x32_bf16(Bt[n][k], At[m][k], acc[ai][bj][m][n], 0, 0, 0); __builtin_amdgcn_s_setprio(0); } while (0)
#define PG8_WAIT_V(n) asm volatile("s_waitcnt vmcnt(" #n ")" ::: "memory")
#define PG8_WAIT_L(n) asm volatile("s_waitcnt lgkmcnt(" #n ")" ::: "memory")
#define PG8_BAR __builtin_amdgcn_s_barrier()
#define PG8_SCHED __builtin_amdgcn_sched_barrier(0)
#define PG8_WAIT_VR(rl) do { if constexpr (Epi::NST == 16) asm volatile("s_waitcnt vmcnt(24)\n\ts_cmp_lg_u32 %0, 0\n\ts_cbranch_scc1 1f\n\ts_waitcnt vmcnt(8)\n1:" :: "s"(rl) : "scc", "memory"); \
        else asm volatile("s_waitcnt vmcnt(16)\n\ts_cmp_lg_u32 %0, 0\n\ts_cbranch_scc1 1f\n\ts_waitcnt vmcnt(8)\n1:" :: "s"(rl) : "scc", "memory"); } while (0)
    int uf_ = 0;
    Unit cur, nxt; int ui = 0;
    if (!S.next(0, cur)) return;
    Acc acc;
#pragma unroll
    for (int a = 0; a < 2; ++a)
#pragma unroll
        for (int b = 0; b < 2; ++b)
#pragma unroll
            for (int m = 0; m < 4; ++m)
#pragma unroll
                for (int n = 0; n < 2; ++n) acc[a][b][m][n] = (f32x4){0.f, 0.f, 0.f, 0.f};
    bf16x8 At[4][2], B0[2][2], B1[2][2];
    if constexpr (GATHER) { unsigned t4_[4]; PG8_LOADRO(t4_, cur.pm); *PG8_ROS(0) = (u32x4){t4_[0], t4_[1], t4_[2], t4_[3]}; asm volatile("s_waitcnt lgkmcnt(0)" ::: "memory"); }
    const char* cA = (const char*)g.A + (GATHER ? (size_t)0 : (size_t)((unsigned)cur.pm * tstepA)); const char* cB = (const char*)g.Bt + (size_t)((unsigned)cur.e * g.bes + (unsigned)cur.pn * tstepB);
    PG8_STAGE(PG8_SB(0, 0), cB, voffB); PG8_STAGE(PG8_SB(0, 1), cB + hstepB, voffB); PG8_STAGE_A(0, 0, cA, ropar); PG8_STAGE_A(0, 1, cA, ropar);
    if (wr == 1) PG8_BAR;
    PG8_WAIT_V(2); PG8_BAR;
    PG8_STAGE(PG8_SB(1, 0), cB + kstep, voffB); PG8_STAGE_A(1, 0, cA + kstep, ropar); PG8_STAGE(PG8_SB(1, 1), cB + hstepB + kstep, voffB);
    PG8_WAIT_V(6); PG8_BAR;
    for (;;) {
        const bool has_next = S.next(ui + 1, nxt);
        if constexpr (GATHER) { u32x4 n4_ = *PG8_ROS(ropar); if (has_next) { unsigned t4_[4]; PG8_LOADRO(t4_, nxt.pm); n4_ = (u32x4){t4_[0], t4_[1], t4_[2], t4_[3]}; } *PG8_ROS(ropar ^ 1) = n4_; }
        const char* nA = (has_next && !GATHER) ? (const char*)g.A + (size_t)((unsigned)nxt.pm * tstepA) : (GATHER ? (const char*)g.A : cA); const char* nB = has_next ? (const char*)g.Bt + (size_t)((unsigned)nxt.e * g.bes + (unsigned)nxt.pn * tstepB) : cB;
        int t = 0;
        do {
            const bool last = (t == nt - 2);
            const char* a1 = cA + (unsigned)(t + 1) * kstep;
            const char* a2 = last ? nA : cA + (unsigned)(t + 2) * kstep; const char* b2 = last ? nB : cB + (unsigned)(t + 2) * kstep;
            const char* a3 = a2 + kstep; const char* b3 = b2 + kstep;
            if constexpr (Epi::HAS_MID) { if (t == Epi::MID0 || t == Epi::MID1) E.mid(acc, cur, t, wr, wc, fr, fq); }
            int rl = t; asm volatile("" : "+s"(rl)); rl = (rl == 0) & uf_;
            PG8_LDB(B0, 0, 0); PG8_LDB(B1, 0, 1); PG8_SCHED; PG8_LDA(At, 0, 0); PG8_STAGE_A(1, 1, a1, ropar);
            PG8_WAIT_VR(rl);
            PG8_WAIT_L(0); PG8_BAR; PG8_MMA(0, 0, At, B0); PG8_MMA(0, 1, At, B1); PG8_BAR; PG8_SCHED;
            PG8_LDA(At, 0, 1); PG8_STAGE(PG8_SB(0, 0), b2, voffB); PG8_STAGE(PG8_SB(0, 1), b2 + hstepB, voffB); PG8_STAGE_A2(0, 0, a2);
            PG8_WAIT_VR(rl);
            PG8_WAIT_L(0); PG8_BAR; PG8_MMA(1, 0, At, B0); PG8_MMA(1, 1, At, B1); PG8_BAR; PG8_SCHED;
            PG8_LDB(B0, 1, 0); PG8_LDB(B1, 1, 1); PG8_SCHED; PG8_LDA(At, 1, 0); PG8_STAGE_A2(0, 1, a2);
            PG8_WAIT_V(8); PG8_WAIT_L(0); PG8_BAR; PG8_MMA(0, 0, At, B0); PG8_MMA(0, 1, At, B1); PG8_BAR; PG8_SCHED;
            PG8_LDA(At, 1, 1); PG8_STAGE(PG8_SB(1, 0), b3, voffB); PG8_STAGE(PG8_SB(1, 1), b3 + hstepB, voffB); PG8_STAGE_A2(1, 0, a3);
            PG8_WAIT_V(8); PG8_WAIT_L(0); PG8_BAR; PG8_MMA(1, 0, At, B0); PG8_MMA(1, 1, At, B1); PG8_BAR; PG8_SCHED;
            t += 2;
        } while (t < nt);
        if constexpr (ALIGN_EPI) { if (wr == 0) PG8_BAR; }
        E(acc, cur, wr, wc, fr, fq);
        if (!has_next) break;
#pragma unroll
        for (int a = 0; a < 2; ++a)
#pragma unroll
            for (int b = 0; b < 2; ++b)
#pragma unroll
                for (int m = 0; m < 4; ++m)
#pragma unroll
                    for (int n = 0; n < 2; ++n) acc[a][b][m][n] = (f32x4){0.f, 0.f, 0.f, 0.f};
        cur = nxt; cA = nA; cB = nB; ++ui;
        if constexpr (GATHER) ropar ^= 1; else uf_ = 1;
        if constexpr (ALIGN_EPI) { if (wr == 1) PG8_BAR; }
    }
    PG8_WAIT_V(0); __builtin_amdgcn_s_waitcnt(0x0F70);
    if constexpr (!ALIGN_EPI) { if (wr == 0) PG8_BAR; }
    PG8_BAR;
#undef PG8_SA
#undef PG8_SB
#undef PG8_STAGE
#undef PG8_STAGE_A
#undef PG8_STAGE_A2
#undef PG8_LOADRO
#undef PG8_ROS
#undef PG8_STAGE_
#undef PG8_LDA
#undef PG8_LDB
#undef PG8_MMA
#undef PG8_WAIT_V
#undef PG8_WAIT_VR
#undef PG8_WAIT_L
#undef PG8_BAR
#undef PG8_SCHED
}

template <int MODE> struct EpiBf16 {
    static constexpr bool PERM = true, HAS_MID = false; static constexpr int MID0 = -1, MID1 = -1, NST = 16;
    bf16_t* O; int ldc; const float* rs; bf16_t* O2; int ldc2;
    __device__ __forceinline__ void operator()(const Acc& acc, const Unit& u, int wr, int wc, int fr, int fq) const {
        asm volatile("" : "+v"(fr), "+v"(fq));
        const int row0 = u.pm * BM + wr * 64 + fr;
        float sv[2][4];
#pragma unroll
        for (int ai = 0; ai < 2; ++ai)
#pragma unroll
            for (int m = 0; m < 4; ++m) sv[ai][m] = rs ? rs[row0 + ai * HALF + m * 16] : 1.0f;
        if (rs) asm volatile("s_waitcnt vmcnt(0)" : "+v"(sv[0][0]), "+v"(sv[0][1]), "+v"(sv[0][2]), "+v"(sv[0][3]), "+v"(sv[1][0]), "+v"(sv[1][1]), "+v"(sv[1][2]), "+v"(sv[1][3]) :: "memory");
#pragma unroll
        for (int ai = 0; ai < 2; ++ai)
#pragma unroll
            for (int m = 0; m < 4; ++m) { const int row = row0 + ai * HALF + m * 16; const float s = sv[ai][m];
#pragma unroll
                for (int bj = 0; bj < 2; ++bj) { const int col = u.pn * BM + bj * HALF + wc * 32 + 8 * fq;
                    const f32x4 v0 = acc[ai][bj][m][0] * s, v1 = acc[ai][bj][m][1] * s;
                    u32x4 w; w.x = cvt_pk_bf16(v0[0], v0[1]); w.y = cvt_pk_bf16(v0[2], v0[3]); w.z = cvt_pk_bf16(v1[0], v1[1]); w.w = cvt_pk_bf16(v1[2], v1[3]);
                    bf16_t* dst;
                    if (MODE == 0) dst = O + (size_t)row * ldc + col;
                    else { const int head = u.pn * 2 + bj; dst = (wc < 2) ? O + (size_t)row * 768 + head * 96 + wc * 32 + 8 * fq : O2 + (size_t)row * 512 + head * 64 + (wc - 2) * 32 + 8 * fq; }
                    *(u32x4*)dst = w; } }
    }
};
struct EpiGU {
    static constexpr bool PERM = true, HAS_MID = false; static constexpr int MID0 = -1, MID1 = -1, NST = 8;
    bf16_t* O;
    __device__ __forceinline__ void operator()(const Acc& acc, const Unit& u, int wr, int wc, int fr, int fq) const {
        asm volatile("" : "+v"(fr), "+v"(fq));
        const int row0 = u.pm * BM + wr * 64 + fr; const int col = u.pn * 128 + wc * 32 + 8 * fq;
#pragma unroll
        for (int ai = 0; ai < 2; ++ai)
#pragma unroll
            for (int m = 0; m < 4; ++m) { const int row = row0 + ai * HALF + m * 16;
                float h[8];
#pragma unroll
                for (int n = 0; n < 2; ++n)
#pragma unroll
                    for (int j = 0; j < 4; ++j) { const float gv = acc[ai][0][m][n][j], uv = acc[ai][1][m][n][j]; h[n * 4 + j] = siluf_(gv) * uv; }
                u32x4 w; w.x = cvt_pk_bf16(h[0], h[1]); w.y = cvt_pk_bf16(h[2], h[3]); w.z = cvt_pk_bf16(h[4], h[5]); w.w = cvt_pk_bf16(h[6], h[7]);
                *(u32x4*)(O + (size_t)row * EFF + col) = w; }
    }
};
struct EpiMerge {
    static constexpr float GLZ = 43.28085f;
    static constexpr bool PERM = true, HAS_MID = true; static constexpr int MID0 = 8, MID1 = 16, NST = 16;
    const bf16_t* Z; bf16_t* O;
    __device__ __forceinline__ void mid(Acc& acc, const Unit& u, int t, int wr, int wc, int fr, int fq) const {
        asm volatile("" : "+v"(fr), "+v"(fq));
        const int gi = (t == 8) ? 0 : 1; const int row0 = u.pm * BM + wr * 64 + fr;
#pragma unroll
        for (int ai = 0; ai < 2; ++ai) {
            u32x4 ga[4][2], gb[4][2];
#pragma unroll
            for (int m = 0; m < 4; ++m)
#pragma unroll
                for (int bj = 0; bj < 2; ++bj) { const int row = row0 + ai * HALF + m * 16, col = u.pn * BM + bj * HALF + wc * 32 + 8 * fq;
                    const bf16_t* p = Z + (size_t)row * ZLD + ZC_GL + gi * 1024 + col; ga[m][bj] = *(const u32x4*)p; gb[m][bj] = *(const u32x4*)(p + 1024); }
#pragma unroll
            for (int m = 0; m < 4; ++m)
#pragma unroll
                for (int bj = 0; bj < 2; ++bj) { float r[8];
#pragma unroll
                    for (int j = 0; j < 4; ++j) { const unsigned wa = ga[m][bj][j], wb = gb[m][bj][j];
                        const float a0 = __builtin_amdgcn_fmed3f(bflo(wa), -GLZ, GLZ), a1 = __builtin_amdgcn_fmed3f(bfhi(wa), -GLZ, GLZ), b0 = __builtin_amdgcn_fmed3f(bflo(wb), -GLZ, GLZ), b1 = __builtin_amdgcn_fmed3f(bfhi(wb), -GLZ, GLZ);
                        r[2 * j] = (1.0f + __builtin_amdgcn_exp2f(b0)) * __builtin_amdgcn_rcpf(1.0f + __builtin_amdgcn_exp2f(a0)); r[2 * j + 1] = (1.0f + __builtin_amdgcn_exp2f(b1)) * __builtin_amdgcn_rcpf(1.0f + __builtin_amdgcn_exp2f(a1)); }
                    acc[ai][bj][m][0] = acc[ai][bj][m][0] * (f32x4){r[0], r[1], r[2], r[3]}; acc[ai][bj][m][1] = acc[ai][bj][m][1] * (f32x4){r[4], r[5], r[6], r[7]}; }
            asm volatile("" : "+v"(acc[ai][0][0][0]), "+v"(acc[ai][1][3][1]) :: "memory");
        }
    }
    __device__ __forceinline__ void operator()(const Acc& acc, const Unit& u, int wr, int wc, int fr, int fq) const {
        asm volatile("" : "+v"(fr), "+v"(fq));
        const int row0 = u.pm * BM + wr * 64 + fr;
#pragma unroll
        for (int ai = 0; ai < 2; ++ai) { u32x4 gcv[4][2];
#pragma unroll
            for (int m = 0; m < 4; ++m)
#pragma unroll
                for (int bj = 0; bj < 2; ++bj) gcv[m][bj] = *(const u32x4*)(Z + (size_t)(row0 + ai * HALF + m * 16) * ZLD + ZC_GL + 2048 + u.pn * BM + bj * HALF + wc * 32 + 8 * fq);
            asm volatile("s_waitcnt vmcnt(0)" : "+v"(gcv[0][0]), "+v"(gcv[0][1]), "+v"(gcv[1][0]), "+v"(gcv[1][1]), "+v"(gcv[2][0]), "+v"(gcv[2][1]), "+v"(gcv[3][0]), "+v"(gcv[3][1]) :: "memory");
#pragma unroll
            for (int m = 0; m < 4; ++m) { const int row = row0 + ai * HALF + m * 16;
#pragma unroll
                for (int bj = 0; bj < 2; ++bj) { const int col = u.pn * BM + bj * HALF + wc * 32 + 8 * fq;
                    const u32x4 gc = gcv[m][bj];
                    float r[8];
#pragma unroll
                    for (int j = 0; j < 4; ++j) { const unsigned w = gc[j]; r[2 * j] = __builtin_amdgcn_rcpf(1.0f + __builtin_amdgcn_exp2f(__builtin_amdgcn_fmed3f(bflo(w), -GLZ, GLZ))); r[2 * j + 1] = __builtin_amdgcn_rcpf(1.0f + __builtin_amdgcn_exp2f(__builtin_amdgcn_fmed3f(bfhi(w), -GLZ, GLZ))); }
                    const f32x4 v0 = acc[ai][bj][m][0] * (f32x4){r[0], r[1], r[2], r[3]}, v1 = acc[ai][bj][m][1] * (f32x4){r[4], r[5], r[6], r[7]};
                    u32x4 w; w.x = cvt_pk_bf16(v0[0], v0[1]); w.y = cvt_pk_bf16(v0[2], v0[3]); w.z = cvt_pk_bf16(v1[0], v1[1]); w.w = cvt_pk_bf16(v1[2], v1[3]);
                    *(u32x4*)(O + (size_t)row * DM + col) = w; } } }
    }
};
struct EpiResid {
    static constexpr bool PERM = true, HAS_MID = false; static constexpr int MID0 = -1, MID1 = -1, NST = 16;
    const float* xold32; const bf16_t* xold16; bf16_t* xnew; const float* gate;
    template <bool F32> __device__ __forceinline__ void run(const Acc& acc, const Unit& u, int wr, int wc, int fr, int fq) const {
        const int row0 = u.pm * BM + wr * 64 + fr; const float* gt = gate + (size_t)((u.pm * BM) / SEQ) * 6144;
#pragma unroll
        for (int bj = 0; bj < 2; ++bj) { const int col = u.pn * BM + bj * HALF + wc * 32 + 8 * fq; const f32x4 g0 = *(const f32x4*)(gt + col), g1 = *(const f32x4*)(gt + col + 4);
            if constexpr (F32) {
#pragma unroll
                for (int ai = 0; ai < 2; ++ai) { f32x4 x0[4], x1[4];
#pragma unroll
                    for (int m = 0; m < 4; ++m) { const size_t off = (size_t)(row0 + ai * HALF + m * 16) * DM + col; x0[m] = *(const f32x4*)(xold32 + off); x1[m] = *(const f32x4*)(xold32 + off + 4); }
                    asm volatile("s_waitcnt vmcnt(0)" : "+v"(x0[0]), "+v"(x1[0]), "+v"(x0[1]), "+v"(x1[1]), "+v"(x0[2]), "+v"(x1[2]), "+v"(x0[3]), "+v"(x1[3]) :: "memory");
#pragma unroll
                    for (int m = 0; m < 4; ++m) { const size_t off = (size_t)(row0 + ai * HALF + m * 16) * DM + col;
                        const f32x4 y0 = x0[m] + g0 * acc[ai][bj][m][0], y1 = x1[m] + g1 * acc[ai][bj][m][1];
                        u32x4 w; w.x = cvt_pk_bf16(y0[0], y0[1]); w.y = cvt_pk_bf16(y0[2], y0[3]); w.z = cvt_pk_bf16(y1[0], y1[1]); w.w = cvt_pk_bf16(y1[2], y1[3]);
                        *(u32x4*)(xnew + off) = w; } }
            } else { u32x4 r[2][4];
#pragma unroll
                for (int ai = 0; ai < 2; ++ai)
#pragma unroll
                    for (int m = 0; m < 4; ++m) r[ai][m] = *(const u32x4*)(xold16 + (size_t)(row0 + ai * HALF + m * 16) * DM + col);
                asm volatile("s_waitcnt vmcnt(0)" : "+v"(r[0][0]), "+v"(r[0][1]), "+v"(r[0][2]), "+v"(r[0][3]), "+v"(r[1][0]), "+v"(r[1][1]), "+v"(r[1][2]), "+v"(r[1][3]) :: "memory");
#pragma unroll
                for (int ai = 0; ai < 2; ++ai)
#pragma unroll
                    for (int m = 0; m < 4; ++m) { const size_t off = (size_t)(row0 + ai * HALF + m * 16) * DM + col; const u32x4 q = r[ai][m];
                        const f32x4 x0 = (f32x4){bflo(q.x), bfhi(q.x), bflo(q.y), bfhi(q.y)}, x1 = (f32x4){bflo(q.z), bfhi(q.z), bflo(q.w), bfhi(q.w)};
                        const f32x4 y0 = x0 + g0 * acc[ai][bj][m][0], y1 = x1 + g1 * acc[ai][bj][m][1];
                        u32x4 w; w.x = cvt_pk_bf16(y0[0], y0[1]); w.y = cvt_pk_bf16(y0[2], y0[3]); w.z = cvt_pk_bf16(y1[0], y1[1]); w.w = cvt_pk_bf16(y1[2], y1[3]);
                        *(u32x4*)(xnew + off) = w; } } }
    }
    __device__ __forceinline__ void operator()(const Acc& acc, const Unit& u, int wr, int wc, int fr, int fq) const {
        asm volatile("" : "+v"(fr), "+v"(fq));
        if (xold32) run<true>(acc, u, wr, wc, fr, fq); else run<false>(acc, u, wr, wc, fr, fq);
    }
};
}

#define XB_TMO      128
#define XB_XCNT(j)  (256  + 64 * (j))
#define XB_XSUB(j)  (1280 + 64 * (j))
#define XB_XGEN(j)  (2304 + 64 * (j))
#define XB_TOP      3328
#define XB_TOPGEN   3392
#define XCD_BAR_WORDS 3456
#define XB_SPIN_CAP (1u << 22)

__device__ __forceinline__ unsigned xb_ld(unsigned* p)              { return __hip_atomic_load(p, __ATOMIC_RELAXED, __HIP_MEMORY_SCOPE_AGENT); }
__device__ __forceinline__ unsigned xb_add(unsigned* p, unsigned v) { return __hip_atomic_fetch_add(p, v, __ATOMIC_RELAXED, __HIP_MEMORY_SCOPE_AGENT); }
__device__ __forceinline__ unsigned xb_xcc_id() { return (unsigned)__builtin_amdgcn_s_getreg((3 << 11) | 20) & 0xFu; }
#define XB_SPIN(cond, bar) do { unsigned _sp = 0; while (cond) { __builtin_amdgcn_s_sleep(1); \
    if ((++_sp & 255u) == 0u) { if (xb_ld(&(bar)[XB_TMO])) break; if (_sp > XB_SPIN_CAP) { atomicAdd(&(bar)[XB_TMO], 1u); break; } } } } while (0)

struct XcdBarrier { unsigned* bar; unsigned x; volatile LAS unsigned* st; };

__device__ __forceinline__ XcdBarrier xcd_barrier_post(unsigned* bar, volatile LAS unsigned* st) {
    XcdBarrier b; b.bar = bar; b.x = xb_xcc_id(); b.st = st;
    if (threadIdx.x == 0) (void)xb_add(&bar[XB_XCNT(b.x)], 1u);
    return b;
}
__device__ __forceinline__ void xcd_barrier_complete(unsigned* bar, unsigned x, unsigned& nloc, unsigned& nx) {
    const unsigned G = gridDim.x * gridDim.y * gridDim.z;
    unsigned sum, cnt, mine, sp = 0u;
    for (;;) {
        sum = 0u; cnt = 0u; mine = 0u;
#pragma unroll
        for (unsigned j = 0; j < 16; ++j) { const unsigned c = xb_ld(&bar[XB_XCNT(j)]); sum += c; cnt += (c > 0u) ? 1u : 0u; mine = (j == x) ? c : mine; }
        if (sum == G) break;
        __builtin_amdgcn_s_sleep(1);
        if ((++sp & 255u) == 0u) { if (xb_ld(&bar[XB_TMO])) break; if (sp > XB_SPIN_CAP) { atomicAdd(&bar[XB_TMO], 1u); break; } }
    }
    nloc = mine > 0u ? mine : 1u; nx = cnt > 0u ? cnt : 1u;
}
__device__ __forceinline__ void xcd_barrier(const XcdBarrier& b) {
    asm volatile("s_waitcnt vmcnt(0)" ::: "memory");
    __syncthreads();
    if (threadIdx.x == 0) {
        unsigned* bar = b.bar;
        __builtin_amdgcn_s_waitcnt(0);
        unsigned nloc = b.st[0], nx = b.st[1];
        if (nloc == 0u) { xcd_barrier_complete(bar, b.x, nloc, nx); b.st[0] = nloc; b.st[1] = nx; }
        const unsigned old = xb_add(&bar[XB_XSUB(b.x)], 1u);
        const unsigned gen = old / nloc;
        if (old + 1u == (gen + 1u) * nloc) {
            __builtin_amdgcn_fence(__ATOMIC_RELEASE, "agent");
            asm volatile("s_waitcnt vmcnt(0)" ::: "memory");
            const unsigned og = xb_add(&bar[XB_TOP], 1u);
            const unsigned tg = og / nx;
            if (og + 1u == (tg + 1u) * nx) xb_add(&bar[XB_TOPGEN], 1u);
            else XB_SPIN(xb_ld(&bar[XB_TOPGEN]) == tg, bar);
            __builtin_amdgcn_fence(__ATOMIC_ACQUIRE, "agent");
            xb_add(&bar[XB_XGEN(b.x)], 1u);
            asm volatile("s_waitcnt vmcnt(0)" ::: "memory");
        } else {
            XB_SPIN(xb_ld(&bar[XB_XGEN(b.x)]) == gen, bar);
            __builtin_amdgcn_fence(__ATOMIC_ACQUIRE, "agent");
            asm volatile("s_waitcnt vmcnt(0)" ::: "memory");
        }
    }
    __syncthreads();
}

namespace att {
constexpr int KSL = 12288, VSL = 8192, KS0 = 0, VS0 = 3 * KSL, WSF = VS0 + 3 * VSL, OST = WSF + 2048, LDS_NEED = OST + 8 * 4096;
constexpr float QSCALE = 0.10206207261596575f * 1.4426950408889634f;
__device__ __forceinline__ int crow(int r, int hi) { return (r & 3) + 8 * (r >> 2) + 4 * hi; }
#define MFMA32(a, b, c) __builtin_amdgcn_mfma_f32_32x32x16_bf16((a), (b), (c), 0, 0, 0)

__device__ __forceinline__ void pv(f32x16* o, int vb, bf16x8 pa0, bf16x8 pa1, bf16x8 pa2, bf16x8 pa3) {
    { const bf16x8 ones = {0x3F80, 0x3F80, 0x3F80, 0x3F80, 0x3F80, 0x3F80, 0x3F80, 0x3F80};
      o[2] = MFMA32(pa0, ones, o[2]); o[2] = MFMA32(pa1, ones, o[2]); o[2] = MFMA32(pa2, ones, o[2]); o[2] = MFMA32(pa3, ones, o[2]); }
#pragma unroll
    for (int d0 = 0; d0 < 2; ++d0) { s16x4 lo[4], hi[4];
#pragma unroll
        for (int ks = 0; ks < 4; ++ks) {
            asm volatile("ds_read_b64_tr_b16 %0,%1 offset:%c2" : "=&v"(lo[ks]) : "v"(vb), "i"(d0 * 4096 + ks * 1024) : "memory");
            asm volatile("ds_read_b64_tr_b16 %0,%1 offset:%c2" : "=&v"(hi[ks]) : "v"(vb), "i"(d0 * 4096 + ks * 1024 + 512) : "memory"); }
        asm volatile("s_waitcnt lgkmcnt(0)" ::: "memory"); __builtin_amdgcn_sched_barrier(0);
#define PK(k) (bf16x8){lo[k][0], lo[k][1], lo[k][2], lo[k][3], hi[k][0], hi[k][1], hi[k][2], hi[k][3]}
        o[d0] = MFMA32(pa0, PK(0), o[d0]); o[d0] = MFMA32(pa1, PK(1), o[d0]); o[d0] = MFMA32(pa2, PK(2), o[d0]); o[d0] = MFMA32(pa3, PK(3), o[d0]);
#undef PK
    }
}

template <int THR> __device__ __forceinline__ void attn_unit(int bl, int h, int qb, const bf16_t* Q, const bf16_t* __restrict__ K, const bf16_t* __restrict__ KR, const bf16_t* __restrict__ V, bf16_t* O,
                                          const float* cosM, const float* sinM, int tokbase, LAS char* shm) {
    int tid_ = threadIdx.x; asm volatile("" : "+v"(tid_));
    const int tid = tid_, lane = tid & 63, r32 = lane & 31, hi = lane >> 5; const int wid = __builtin_amdgcn_readfirstlane(tid >> 6);
    const long rowbase = (long)bl * SEQ; const int q0 = qb * 256;
    const unsigned lds0 = (unsigned)(uintptr_t)shm;
    const unsigned shmS = (unsigned)__builtin_amdgcn_readfirstlane((int)lds0);
    LAS float* wsf = (LAS float*)(shm + WSF) + wid * 64;
    const long qrow = rowbase + q0 + wid * 32 + r32;
    const bf16_t* qp = Q + qrow * 768 + h * 96;
    bf16x8 qr[6];
#pragma unroll
    for (int d0 = 0; d0 < 4; ++d0) { const u32x4 raw = *(const u32x4*)(qp + d0 * 16 + hi * 8); u32x4 w;
#pragma unroll
        for (int j = 0; j < 4; ++j) w[j] = cvt_pk_bf16(bflo(raw[j]) * QSCALE, bfhi(raw[j]) * QSCALE);
        qr[d0] = __builtin_bit_cast(bf16x8, w); }
    { const u32x4 r1 = *(const u32x4*)(qp + 64 + hi * 8), r2 = *(const u32x4*)(qp + 80 + hi * 8);
      const float* cp = cosM + (size_t)(tokbase + qrow) * 16 + hi * 8; const float* sp = sinM + (size_t)(tokbase + qrow) * 16 + hi * 8;
      const f32x4 c0 = *(const f32x4*)cp, c1 = *(const f32x4*)(cp + 4), s0 = *(const f32x4*)sp, s1 = *(const f32x4*)(sp + 4);
      float cs[8] = {c0[0], c0[1], c0[2], c0[3], c1[0], c1[1], c1[2], c1[3]}, sn[8] = {s0[0], s0[1], s0[2], s0[3], s1[0], s1[1], s1[2], s1[3]};
      u32x4 w1, w2;
#pragma unroll
      for (int j = 0; j < 4; ++j) { const float a0 = bflo(r1[j]), a1 = bfhi(r1[j]), b0 = bflo(r2[j]), b1 = bfhi(r2[j]);
          w1[j] = cvt_pk_bf16((a0 * cs[2 * j] - b0 * sn[2 * j]) * QSCALE, (a1 * cs[2 * j + 1] - b1 * sn[2 * j + 1]) * QSCALE);
          w2[j] = cvt_pk_bf16((a0 * sn[2 * j] + b0 * cs[2 * j]) * QSCALE, (a1 * sn[2 * j + 1] + b1 * cs[2 * j + 1]) * QSCALE); }
      qr[4] = __builtin_bit_cast(bf16x8, w1); qr[5] = __builtin_bit_cast(bf16x8, w2); }
    const bf16_t* Kh = K + rowbase * 768 + h * 96; const bf16_t* Vh = V + rowbase * 512 + h * 64;
    const bf16_t* ksrcA = Kh + (long)lane * 768 + wid * 8;
    const bf16_t* ksrcB = KR + (rowbase + lane) * 32 + wid * 8;
    const bf16_t* vsrc = Vh + (long)(16 * (wid & 3) + (lane >> 2)) * 512 + (wid >> 2) * 32 + (lane & 3) * 8;
    const int NT = q0 / 64 + 4, tq = q0 / 64 + (wid >> 1);
#define ATT_DMA_K(t, kb_) do { __builtin_amdgcn_global_load_lds((const unsigned*)(ksrcA + (long)(t) * 64 * 768), (LAS unsigned*)(uintptr_t)(shmS + (unsigned)(kb_) + (unsigned)wid * 1024u), 16, 0, 0); \
        if (wid < 4) __builtin_amdgcn_global_load_lds((const unsigned*)(ksrcB + (long)(t) * 64 * 32), (LAS unsigned*)(uintptr_t)(shmS + (unsigned)(kb_) + (8u + (unsigned)wid) * 1024u), 16, 0, 0); } while (0)
#define ATT_DMA_V(t, vb_) __builtin_amdgcn_global_load_lds((const unsigned*)(vsrc + (long)(t) * 64 * 512), (LAS unsigned*)(uintptr_t)(shmS + (unsigned)(vb_) + (unsigned)wid * 1024u), 16, 0, 0)
#define ATT_QK(P0, P1, kb_, C) do { const LAS char* kbp = shm + (kb_) + hi * 1024 + r32 * 16; bf16x8 kf_[12]; \
        _Pragma("unroll") for (int d0 = 0; d0 < 6; ++d0) { kf_[2 * d0] = *(const LAS bf16x8*)(kbp + d0 * 2048); kf_[2 * d0 + 1] = *(const LAS bf16x8*)(kbp + d0 * 2048 + 512); } \
        __builtin_amdgcn_sched_barrier(0); \
        P0 = MFMA32(kf_[0], qr[0], C); P1 = MFMA32(kf_[1], qr[0], C); \
        _Pragma("unroll") for (int d0 = 1; d0 < 6; ++d0) { P0 = MFMA32(kf_[2 * d0], qr[d0], P0); P1 = MFMA32(kf_[2 * d0 + 1], qr[d0], P1); } } while (0)
#define ATT_VRD(lo, hi, vb, d0) do { _Pragma("unroll") for (int ks = 0; ks < 4; ++ks) { \
        asm volatile("ds_read_b64_tr_b16 %0,%1 offset:%c2" : "=&v"(lo[ks]) : "v"(vb), "i"((d0) * 4096 + ks * 1024) : "memory"); \
        asm volatile("ds_read_b64_tr_b16 %0,%1 offset:%c2" : "=&v"(hi[ks]) : "v"(vb), "i"((d0) * 4096 + ks * 1024 + 512) : "memory"); } } while (0)
#define ATT_PK(lo, hi, k) (bf16x8){lo[k][0], lo[k][1], lo[k][2], lo[k][3], hi[k][0], hi[k][1], hi[k][2], hi[k][3]}
#define ATT_MX3(a, b, c) vmax3_((a), (b), (c))
#define ATT_ROWMAX(P0, P1, out) do { float ma_ = ATT_MX3(P0[0], P0[1], P1[0]), mb_ = ATT_MX3(P0[2], P0[3], P1[1]); ma_ = ATT_MX3(ma_, P1[2], P1[3]); \
        _Pragma("unroll") for (int r = 4; r < 16; r += 4) { ma_ = ATT_MX3(ma_, P0[r], P0[r + 1]); mb_ = ATT_MX3(mb_, P0[r + 2], P0[r + 3]); ma_ = ATT_MX3(ma_, P1[r], P1[r + 1]); mb_ = ATT_MX3(mb_, P1[r + 2], P1[r + 3]); } \
        float mt_ = vmax2_(ma_, mb_); \
        auto rr_ = __builtin_amdgcn_permlane32_swap(__float_as_uint(mt_), __float_as_uint(mt_), false, false); out = vmax2_(__uint_as_float(rr_[0]), __uint_as_float(rr_[1])); } while (0)
    ATT_DMA_K(0, KS0); ATT_DMA_V(0, VS0); ATT_DMA_K(1, KS0 + KSL); ATT_DMA_K(2, KS0 + 2 * KSL); ATT_DMA_V(1, VS0 + VSL);
    __syncthreads();
    float mhat = 0.f; f32x16 o[3], negm;
#pragma unroll
    for (int r = 0; r < 16; ++r) { o[0][r] = 0.f; o[1][r] = 0.f; o[2][r] = 0.f; negm[r] = 0.f; }
    const int vbl = (int)lds0 + ((lane >> 4) & 1) * 32 + (lane & 3) * 8 + (4 * hi + ((lane & 15) >> 2)) * 64;
    f32x16 sA0, sA1, sB0, sB1;
    ATT_QK(sA0, sA1, KS0, negm);
    { float rm; ATT_ROWMAX(sA0, sA1, rm); mhat = rm;
#pragma unroll
      for (int r = 0; r < 16; ++r) { sA0[r] -= rm; sA1[r] -= rm; negm[r] = -rm; } }
    __syncthreads();
    int k0 = KS0, k1 = KS0 + KSL, k2 = KS0 + 2 * KSL, v0 = VS0, v1 = VS0 + VSL, v2 = VS0 + 2 * VSL;
#define ATT_WAITBAR(n) asm volatile("s_waitcnt vmcnt(" #n ") lgkmcnt(0)\n\ts_barrier" ::: "memory")
#define ATT_EXPCVT(C0, C1, lo_, hi_) do { _Pragma("unroll") for (int e = (lo_); e < (hi_); e += 2) { \
            if (e < 16) { const float x0_ = __builtin_amdgcn_exp2f(C0[e & 15]), x1_ = __builtin_amdgcn_exp2f(C0[(e + 1) & 15]); C0[e & 15] = x0_; C0[(e + 1) & 15] = x1_; pw[e >> 3][(e & 7) >> 1] = cvt_pk_bf16(x0_, x1_); } \
            else { const float x0_ = __builtin_amdgcn_exp2f(C1[e & 15]), x1_ = __builtin_amdgcn_exp2f(C1[(e + 1) & 15]); C1[e & 15] = x0_; C1[(e + 1) & 15] = x1_; pw[e >> 3][(e & 7) >> 1] = cvt_pk_bf16(x0_, x1_); } } } while (0)
#define ATT_EXPV(x) ({ float r_; asm volatile("v_exp_f32 %0, %1" : "=v"(r_) : "v"(x)); r_; })
#define ATT_EXPCVTV(C0, C1, lo_, hi_) do { _Pragma("unroll") for (int e = (lo_); e < (hi_); e += 2) { \
            if (e < 16) { const float x0_ = ATT_EXPV(C0[e & 15]), x1_ = ATT_EXPV(C0[(e + 1) & 15]); pw[e >> 3][(e & 7) >> 1] = cvt_pk_bf16(x0_, x1_); } \
            else { const float x0_ = ATT_EXPV(C1[e & 15]), x1_ = ATT_EXPV(C1[(e + 1) & 15]); pw[e >> 3][(e & 7) >> 1] = cvt_pk_bf16(x0_, x1_); } } } while (0)
#define ATT_KRD(fa, fb, d0) do { asm volatile("ds_read_b128 %0, %1 offset:%c2" : "=&v"(fa) : "v"(kbp), "i"((d0) * 2048) : "memory"); asm volatile("ds_read_b128 %0, %1 offset:%c2" : "=&v"(fb) : "v"(kbp), "i"((d0) * 2048 + 512) : "memory"); } while (0)
#define ATT_LW(n, fa, fb) do { asm volatile("s_waitcnt lgkmcnt(" #n ")" : "+v"(fa), "+v"(fb) :: "memory"); __builtin_amdgcn_sched_barrier(0); } while (0)
#define ATT_STEP(t, CUR0, CUR1, NXT0, NXT1) do { \
        const bool dk_ = (t) + 3 < NT, dv_ = (t) + 2 < NT; \
        if (dk_) ATT_DMA_K((t) + 3, k0); \
        if (dv_) ATT_DMA_V((t) + 2, v2); \
        if ((t) <= tq) { \
            const LAS char* kbp = shm + k1 + hi * 1024 + r32 * 16; bf16x8 ka0, kb0, ka1, kb1, ka2, kb2; \
            const int vb_ = vbl + v0; s16x4 vl0[4], vh0[4], vl1[4], vh1[4]; \
            float rm; ATT_ROWMAX(CUR0, CUR1, rm); \
            if (__any(rm > (float)THR)) { const float dl = fmaxf(rm, 0.f); mhat += dl; const float f = __builtin_amdgcn_exp2f(-dl); \
                _Pragma("unroll") for (int r = 0; r < 16; ++r) { CUR0[r] -= dl; CUR1[r] -= dl; negm[r] = -mhat; }        \
                if (hi == 0) wsf[r32] = f; \
                _Pragma("unroll") for (int r = 0; r < 16; ++r) { const float a = wsf[crow(r, hi)]; o[0][r] *= a; o[1][r] *= a; o[2][r] *= a; } \
                asm volatile("s_waitcnt lgkmcnt(0)" ::: "memory"); } \
            u32x4 pw[4]; \
            {                                                      \
                ATT_KRD(ka0, kb0, 0); ATT_KRD(ka1, kb1, 1); ATT_KRD(ka2, kb2, 2); ATT_LW(4, ka0, kb0); \
                NXT0 = MFMA32(ka0, qr[0], negm); NXT1 = MFMA32(kb0, qr[0], negm); ATT_EXPCVTV(CUR0, CUR1, 0, 6); __builtin_amdgcn_sched_barrier(0); \
                ATT_KRD(ka0, kb0, 3); ATT_LW(4, ka1, kb1); \
                NXT0 = MFMA32(ka1, qr[1], NXT0); NXT1 = MFMA32(kb1, qr[1], NXT1); ATT_EXPCVTV(CUR0, CUR1, 6, 12); __builtin_amdgcn_sched_barrier(0); \
                ATT_KRD(ka1, kb1, 4); ATT_LW(4, ka2, kb2); \
                NXT0 = MFMA32(ka2, qr[2], NXT0); NXT1 = MFMA32(kb2, qr[2], NXT1); ATT_EXPCVTV(CUR0, CUR1, 12, 18); __builtin_amdgcn_sched_barrier(0); \
                ATT_KRD(ka2, kb2, 5); ATT_LW(4, ka0, kb0); \
                NXT0 = MFMA32(ka0, qr[3], NXT0); NXT1 = MFMA32(kb0, qr[3], NXT1); ATT_EXPCVTV(CUR0, CUR1, 18, 24); __builtin_amdgcn_sched_barrier(0); \
                ATT_VRD(vl0, vh0, vb_, 0); ATT_LW(10, ka1, kb1); \
                NXT0 = MFMA32(ka1, qr[4], NXT0); NXT1 = MFMA32(kb1, qr[4], NXT1); ATT_EXPCVTV(CUR0, CUR1, 24, 28); __builtin_amdgcn_sched_barrier(0); \
                ATT_LW(8, ka2, kb2); \
                NXT0 = MFMA32(ka2, qr[5], NXT0); NXT1 = MFMA32(kb2, qr[5], NXT1); ATT_EXPCVTV(CUR0, CUR1, 28, 32); __builtin_amdgcn_sched_barrier(0); \
            } \
            { const bf16x8 pa0 = __builtin_bit_cast(bf16x8, pw[0]), pa1 = __builtin_bit_cast(bf16x8, pw[1]), pa2 = __builtin_bit_cast(bf16x8, pw[2]), pa3 = __builtin_bit_cast(bf16x8, pw[3]); \
              const bf16x8 ones = {0x3F80, 0x3F80, 0x3F80, 0x3F80, 0x3F80, 0x3F80, 0x3F80, 0x3F80}; \
              ATT_VRD(vl1, vh1, vb_, 1); \
              o[2] = MFMA32(pa0, ones, o[2]); o[2] = MFMA32(pa1, ones, o[2]); o[2] = MFMA32(pa2, ones, o[2]); o[2] = MFMA32(pa3, ones, o[2]); \
              asm volatile("s_waitcnt lgkmcnt(8)" : "+v"(vl0[0]), "+v"(vh0[0]), "+v"(vl0[1]), "+v"(vh0[1]), "+v"(vl0[2]), "+v"(vh0[2]), "+v"(vl0[3]), "+v"(vh0[3]) :: "memory"); __builtin_amdgcn_sched_barrier(0); \
              o[0] = MFMA32(pa0, ATT_PK(vl0, vh0, 0), o[0]); o[0] = MFMA32(pa1, ATT_PK(vl0, vh0, 1), o[0]); o[0] = MFMA32(pa2, ATT_PK(vl0, vh0, 2), o[0]); o[0] = MFMA32(pa3, ATT_PK(vl0, vh0, 3), o[0]); \
              asm volatile("s_waitcnt lgkmcnt(0)" : "+v"(vl1[0]), "+v"(vh1[0]), "+v"(vl1[1]), "+v"(vh1[1]), "+v"(vl1[2]), "+v"(vh1[2]), "+v"(vl1[3]), "+v"(vh1[3]) :: "memory"); __builtin_amdgcn_sched_barrier(0); \
              o[1] = MFMA32(pa0, ATT_PK(vl1, vh1, 0), o[1]); o[1] = MFMA32(pa1, ATT_PK(vl1, vh1, 1), o[1]); o[1] = MFMA32(pa2, ATT_PK(vl1, vh1, 2), o[1]); o[1] = MFMA32(pa3, ATT_PK(vl1, vh1, 3), o[1]); } } \
        if (dk_) { if (wid < 4) ATT_WAITBAR(3); else ATT_WAITBAR(2); } else ATT_WAITBAR(0); \
        { const int tk_ = k0; k0 = k1; k1 = k2; k2 = tk_; const int tv_ = v0; v0 = v1; v1 = v2; v2 = tv_; } } while (0)
#pragma unroll
    for (int r = 0; r < 16; ++r) { sB0[r] = 0.f; sB1[r] = 0.f; }
    for (int t = 0; t < NT; t += 2) {
        ATT_STEP(t, sA0, sA1, sB0, sB1);
        ATT_STEP(t + 1, sB0, sB1, sA0, sA1);
    }
#undef ATT_WAITBAR
#undef ATT_STEP
#undef ATT_EXPCVT
#undef ATT_EXPCVTV
#undef ATT_EXPV
#undef ATT_KRD
#undef ATT_LW
#undef ATT_DMA_K
#undef ATT_DMA_V
#undef ATT_QK
#undef ATT_ROWMAX
    float rli[16];
#pragma unroll
    for (int r = 0; r < 16; ++r) rli[r] = 1.0f / o[2][r];
    bf16_t* Ow = O + (rowbase + q0 + wid * 32) * ACLD + h * 64;
    { LAS bf16_t* stg = (LAS bf16_t*)(shm + OST) + wid * 2048;
#pragma unroll
      for (int r = 0; r < 16; ++r) { const int orow = crow(r, hi);
#pragma unroll
          for (int d0 = 0; d0 < 2; ++d0) stg[orow * 64 + d0 * 32 + r32] = (bf16_t)f2bf(o[d0][r] * rli[r]); }
#pragma unroll
      for (int i = 0; i < 4; ++i) { const int row = i * 8 + (lane >> 3), ch = lane & 7; const u32x4 v = *(const LAS u32x4*)(stg + row * 64 + ch * 8); *(u32x4*)(Ow + (long)row * ACLD + ch * 8) = v; } }
    __syncthreads();
    __builtin_amdgcn_s_waitcnt(0x0F70);
}
}

namespace ret {
typedef short v4i16_t __attribute__((ext_vector_type(4)));
#define MFMA16(a, b, c) __builtin_amdgcn_mfma_f32_16x16x32_bf16((a), (b), (c), 0, 0, 0)
__device__ __forceinline__ bf16x8 tr16(const LAS char* base, int rs, int k0, int x0, int lane) {
    const int g = lane >> 4, i = lane & 15, q = i >> 2, p = i & 3;
    const LAS char* a = base + (k0 + 8 * g + q) * rs + (x0 + 4 * p) * 2;
    const s16x4 lo = __builtin_bit_cast(s16x4, __builtin_amdgcn_ds_read_tr16_b64_v4i16((LAS v4i16_t*)a));
    const s16x4 hi = __builtin_bit_cast(s16x4, __builtin_amdgcn_ds_read_tr16_b64_v4i16((LAS v4i16_t*)(a + 4 * rs)));
    return (bf16x8){lo[0], lo[1], lo[2], lo[3], hi[0], hi[1], hi[2], hi[3]};
}
constexpr int QI = 0, KI = 17408, VI = 34816, PI = 68608, O32 = 81920;
__device__ __forceinline__ float lg2gamma(int h) { return __builtin_amdgcn_logf(1.0f - __builtin_amdgcn_exp2f(-5.0f - (float)h)); }

constexpr int KVO = 69632;
__device__ __forceinline__ void kvloc_phase(int first, int stride, const bf16_t* Z, bf16_t* RS, LAS char* lds) {
    int tid_ = threadIdx.x; asm volatile("" : "+v"(tid_));
    const int tid = tid_, lane = tid & 63, wid = __builtin_amdgcn_readfirstlane(tid >> 6), g = lane >> 4, i16 = lane & 15;
    if (first >= 1024) return;
    u32x4 kr[2], vr[4];
#define KVL_LOAD(it_) do { const int u_ = (it_) >> 7, n_ = (it_) & 127, bl_ = u_ >> 2, h_ = u_ & 3; const long r0_ = (long)bl_ * SEQ + (long)n_ * 64; \
        _Pragma("unroll") for (int i = 0; i < 2; ++i) { const int p = tid + 512 * i, row = p >> 4, ch = p & 15; kr[i] = *(const u32x4*)(Z + (size_t)(r0_ + row) * ZLD + ZC_RK + h_ * 128 + ch * 8); } \
        _Pragma("unroll") for (int i = 0; i < 4; ++i) { const int p = tid + 512 * i, row = p >> 5, ch = p & 31; vr[i] = *(const u32x4*)(Z + (size_t)(r0_ + row) * ZLD + ZC_RV + h_ * 256 + ch * 8); } } while (0)
    KVL_LOAD(first);
    for (int it = first; it < 1024; it += stride) {
        const int u = it >> 7, n = it & 127, h = u & 3; const float lg = lg2gamma(h);
#pragma unroll
        for (int i = 0; i < 2; ++i) { const int p = tid + 512 * i, row = p >> 4, ch = p & 15; const float sc = __builtin_amdgcn_exp2f(lg * (float)(63 - row)); u32x4 w;
#pragma unroll
            for (int j = 0; j < 4; ++j) w[j] = cvt_pk_bf16(bflo(kr[i][j]) * sc, bfhi(kr[i][j]) * sc);
            *(LAS u32x4*)(lds + KI + row * 272 + ch * 16) = w; }
#pragma unroll
        for (int i = 0; i < 4; ++i) { const int p = tid + 512 * i, row = p >> 5, ch = p & 31; *(LAS u32x4*)(lds + VI + row * 528 + ch * 16) = vr[i]; }
        __syncthreads();
        if (it + stride < 1024) KVL_LOAD(it + stride);
        bf16x8 bfr[2][2];
#pragma unroll
        for (int n2 = 0; n2 < 2; ++n2)
#pragma unroll
            for (int ks = 0; ks < 2; ++ks) bfr[n2][ks] = tr16(lds + VI, 528, 32 * ks, 32 * wid + 16 * n2, lane);
#pragma unroll 2
        for (int mi = 0; mi < 8; ++mi) { const bf16x8 a0 = tr16(lds + KI, 272, 0, 16 * mi, lane), a1 = tr16(lds + KI, 272, 32, 16 * mi, lane);
#pragma unroll
            for (int n2 = 0; n2 < 2; ++n2) { f32x4 acc = {0.f, 0.f, 0.f, 0.f}; acc = MFMA16(a0, bfr[n2][0], acc); acc = MFMA16(a1, bfr[n2][1], acc);
                const int c = 32 * wid + 16 * n2 + i16, d = 16 * mi + 4 * g; u32x2 w; w.x = cvt_pk_bf16(acc[0], acc[1]); w.y = cvt_pk_bf16(acc[2], acc[3]);
                *(LAS u32x2*)(lds + KVO + c * 272 + d * 2) = w; } }
        __syncthreads();
        u32x4* dst = (u32x4*)(RS + (size_t)(u * 128 + n) * 32768);
#pragma unroll
        for (int i = 0; i < 8; ++i) { const int p = tid + 512 * i, row = p >> 4, ch = p & 15; dst[p] = *(const LAS u32x4*)(lds + KVO + row * 272 + ch * 16); }
    }
    __syncthreads();
#undef KVL_LOAD
}

__device__ __forceinline__ void scan_all(bf16_t* RS, int gtid, int gthreads) {
    for (int idx = gtid; idx < 8 * 16384; idx += gthreads) {
        const int u = idx >> 14, e2 = idx & 16383, h = u & 3; const float cd = __builtin_amdgcn_exp2f(lg2gamma(h) * 64.0f);
        unsigned* p = (unsigned*)(RS + (size_t)u * 128 * 32768) + e2;
        float s0 = 0.f, s1 = 0.f; unsigned v[8], vn[8];
#pragma unroll
        for (int k = 0; k < 8; ++k) vn[k] = p[(size_t)k * 16384];
        for (int n = 0; n < 128; n += 8) {
#pragma unroll
            for (int k = 0; k < 8; ++k) v[k] = vn[k];
            if (n + 8 < 128) {
#pragma unroll
                for (int k = 0; k < 8; ++k) vn[k] = p[(size_t)(n + 8 + k) * 16384]; }
#pragma unroll
            for (int k = 0; k < 8; ++k) { const unsigned w = cvt_pk_bf16(s0, s1); s0 = s0 * cd + bflo(v[k]); s1 = s1 * cd + bfhi(v[k]); p[(size_t)(n + k) * 16384] = w; } }
    }
}

__device__ __forceinline__ void out_phase(int first, int stride, const bf16_t* Z, const bf16_t* RS, bf16_t* AC, LAS char* lds) {
    int tid_ = threadIdx.x; asm volatile("" : "+v"(tid_));
    const int tid = tid_, lane = tid & 63, wid = __builtin_amdgcn_readfirstlane(tid >> 6), g = lane >> 4, i16 = lane & 15;
    if (first >= 1024) return;
    u32x4 qr_[2], kr_[2], vr_[4]; bf16x8 sfr[2][4];
#define RO_LOAD_S(it_) do { const int u_ = (it_) >> 7, n_ = (it_) & 127; const bf16_t* sp = RS + (size_t)(u_ * 128 + n_) * 32768; \
        _Pragma("unroll") for (int n2 = 0; n2 < 2; ++n2) _Pragma("unroll") for (int ks = 0; ks < 4; ++ks) sfr[n2][ks] = *(const bf16x8*)(sp + (32 * wid + 16 * n2 + i16) * 128 + 32 * ks + 8 * g); } while (0)
#define RO_LOAD(it_) do { const int u_ = (it_) >> 7, n_ = (it_) & 127, bl_ = u_ >> 2, h_ = u_ & 3; const long r0_ = (long)bl_ * SEQ + (long)n_ * 64; \
        _Pragma("unroll") for (int i = 0; i < 2; ++i) { const int p = tid + 512 * i, row = p >> 4, ch = p & 15; const bf16_t* zr = Z + (size_t)(r0_ + row) * ZLD + h_ * 128 + ch * 8; \
            qr_[i] = *(const u32x4*)(zr + ZC_RQ); kr_[i] = *(const u32x4*)(zr + ZC_RK); } \
        _Pragma("unroll") for (int i = 0; i < 4; ++i) { const int p = tid + 512 * i, row = p >> 5, ch = p & 31; vr_[i] = *(const u32x4*)(Z + (size_t)(r0_ + row) * ZLD + ZC_RV + h_ * 256 + ch * 8); } } while (0)
    RO_LOAD_S(first);
    RO_LOAD(first);
    for (int it = first; it < 1024; it += stride) {
        const int u = it >> 7, n = it & 127, bl = u >> 2, h = u & 3; const long row0 = (long)bl * SEQ + (long)n * 64; const float lg = lg2gamma(h);
        u32x2 gr[8];
#pragma unroll
        for (int i = 0; i < 2; ++i) { const int p = tid + 512 * i, row = p >> 4, ch = p & 15;
            *(LAS u32x4*)(lds + QI + row * 272 + ch * 16) = qr_[i]; *(LAS u32x4*)(lds + KI + row * 272 + ch * 16) = kr_[i]; }
#pragma unroll
        for (int i = 0; i < 4; ++i) { const int p = tid + 512 * i, row = p >> 5, ch = p & 31; *(LAS u32x4*)(lds + VI + row * 528 + ch * 16) = vr_[i]; }
        __syncthreads();
#pragma unroll
        for (int rr = 0; rr < 8; ++rr) gr[rr] = *(const u32x2*)(Z + (size_t)(row0 + 8 * wid + rr) * ZLD + ZC_RG + h * 256 + 4 * lane);
        if (it + stride < 1024) RO_LOAD(it + stride);
#pragma unroll
        for (int t2 = 0; t2 < 2; ++t2) { const int id = 2 * wid + t2, mi = id >> 2, nj = id & 3; f32x4 acc = {0.f, 0.f, 0.f, 0.f};
#pragma unroll
            for (int ks = 0; ks < 4; ++ks) { const bf16x8 a = *(const LAS bf16x8*)(lds + QI + (16 * mi + i16) * 272 + (32 * ks + 8 * g) * 2), b = *(const LAS bf16x8*)(lds + KI + (16 * nj + i16) * 272 + (32 * ks + 8 * g) * 2);
                acc = MFMA16(a, b, acc); }
#pragma unroll
            for (int jj = 0; jj < 4; ++jj) { const int ii = 16 * mi + 4 * g + jj, jc = 16 * nj + i16; const int dd = ii > jc ? ii - jc : jc - ii;
                *(LAS bf16_t*)(lds + PI + ii * 144 + jc * 2) = (bf16_t)f2bf(acc[jj] * __builtin_amdgcn_exp2f(lg * (float)dd)); } }
        __syncthreads();
        f32x4 acc1[4][2], acc2[4][2];
#pragma unroll
        for (int mi = 0; mi < 4; ++mi)
#pragma unroll
            for (int n2 = 0; n2 < 2; ++n2) { acc1[mi][n2] = (f32x4){0.f, 0.f, 0.f, 0.f}; acc2[mi][n2] = (f32x4){0.f, 0.f, 0.f, 0.f}; }
#pragma unroll
        for (int ks = 0; ks < 2; ++ks) { bf16x8 b[2]; b[0] = tr16(lds + VI, 528, 32 * ks, 32 * wid, lane); b[1] = tr16(lds + VI, 528, 32 * ks, 32 * wid + 16, lane);
#pragma unroll
            for (int mi = 0; mi < 4; ++mi) { const bf16x8 a = *(const LAS bf16x8*)(lds + PI + (16 * mi + i16) * 144 + (32 * ks + 8 * g) * 2);
                acc1[mi][0] = MFMA16(a, b[0], acc1[mi][0]); acc1[mi][1] = MFMA16(a, b[1], acc1[mi][1]); } }
#pragma unroll
        for (int ks = 0; ks < 4; ++ks)
#pragma unroll
            for (int mi = 0; mi < 4; ++mi) { const bf16x8 a = *(const LAS bf16x8*)(lds + QI + (16 * mi + i16) * 272 + (32 * ks + 8 * g) * 2);
                acc2[mi][0] = MFMA16(a, sfr[0][ks], acc2[mi][0]); acc2[mi][1] = MFMA16(a, sfr[1][ks], acc2[mi][1]); }
        if (it + stride < 1024) RO_LOAD_S(it + stride);
#pragma unroll
        for (int mi = 0; mi < 4; ++mi)
#pragma unroll
            for (int jj = 0; jj < 4; ++jj) { const int row = 16 * mi + 4 * g + jj; const float qd = __builtin_amdgcn_exp2f(lg * (float)(row + 1));
#pragma unroll
                for (int n2 = 0; n2 < 2; ++n2) *(LAS float*)(lds + O32 + (row * 260 + 32 * wid + 16 * n2 + i16) * 4) = acc1[mi][n2][jj] + qd * acc2[mi][n2][jj]; }
        __syncthreads();
#pragma unroll
        for (int rr = 0; rr < 8; ++rr) { const int row = 8 * wid + rr; const f32x4 v = *(const LAS f32x4*)(lds + O32 + (row * 260 + 4 * lane) * 4);
            const float ss = wave_sum(v[0] * v[0] + v[1] * v[1] + v[2] * v[2] + v[3] * v[3]); const float rstd = rsqrtf(ss * (1.0f / 256.0f) + EPS);
            u32x2 w; w.x = cvt_pk_bf16(siluf_(bflo(gr[rr].x)) * v[0] * rstd, siluf_(bfhi(gr[rr].x)) * v[1] * rstd); w.y = cvt_pk_bf16(siluf_(bflo(gr[rr].y)) * v[2] * rstd, siluf_(bfhi(gr[rr].y)) * v[3] * rstd);
            *(u32x2*)(AC + (size_t)(row0 + row) * ACLD + 1024 + h * 256 + 4 * lane) = w; }
    }
    __syncthreads();
#undef RO_LOAD
#undef RO_LOAD_S
}
}

__device__ __forceinline__ float rs36_xor_dpp(float v, int which) {
    const int x = __builtin_bit_cast(int, v); int r;
    if (which == 8) r = __builtin_amdgcn_update_dpp(x, x, 0x128, 0xF, 0xF, false);
    else if (which == 2) r = __builtin_amdgcn_update_dpp(x, x, 0x4E, 0xF, 0xF, false);
    else r = __builtin_amdgcn_update_dpp(x, x, 0xB1, 0xF, 0xF, false);
    return __builtin_bit_cast(float, r);
}
__device__ __forceinline__ float reduce_scatter36(const float (&v)[36], int lane) {
    float a[18], b[9], c[5], d[3], e[2];
#pragma unroll
    for (int i = 0; i < 18; ++i) { auto rr = __builtin_amdgcn_permlane32_swap(__float_as_uint(v[i]), __float_as_uint(v[i + 18]), false, false); a[i] = __uint_as_float(rr[0]) + __uint_as_float(rr[1]); }
#pragma unroll
    for (int i = 0; i < 9; ++i) { auto rr = __builtin_amdgcn_permlane16_swap(__float_as_uint(a[i]), __float_as_uint(a[i + 9]), false, false); b[i] = __uint_as_float(rr[0]) + __uint_as_float(rr[1]); }
    const bool b3 = (lane & 8) != 0, b2 = (lane & 4) != 0, b1 = (lane & 2) != 0, b0 = (lane & 1) != 0;
#pragma unroll
    for (int i = 0; i < 5; ++i) { const float x = b[i], y = (i + 5 < 9) ? b[i + 5] : 0.f; c[i] = (b3 ? y : x) + rs36_xor_dpp(b3 ? x : y, 8); }
#pragma unroll
    for (int i = 0; i < 3; ++i) { const float x = c[i], y = (i + 3 < 5) ? c[i + 3] : 0.f; const float snd = b2 ? x : y;
        d[i] = (b2 ? y : x) + __builtin_bit_cast(float, __builtin_amdgcn_ds_swizzle(__builtin_bit_cast(int, snd), 0x101F)); }
#pragma unroll
    for (int i = 0; i < 2; ++i) { const float x = d[i], y = (i + 2 < 3) ? d[i + 2] : 0.f; e[i] = (b1 ? y : x) + rs36_xor_dpp(b1 ? x : y, 2); }
    return (b0 ? e[1] : e[0]) + rs36_xor_dpp(b0 ? e[0] : e[1], 1);
}
__device__ __forceinline__ int rs36_index(int lane) { return (lane & 1) + 2 * ((lane >> 1) & 1) + 3 * ((lane >> 2) & 1) + 5 * ((lane >> 3) & 1) + 9 * ((lane >> 4) & 1) + 18 * ((lane >> 5) & 1); }
__device__ __forceinline__ bool rs36_valid(int lane) { const int r = (lane & 1) + 2 * ((lane >> 1) & 1), q = r + 3 * ((lane >> 2) & 1), pp = q + 5 * ((lane >> 3) & 1); return r < 3 && q < 5 && pp < 9; }

struct Args {
    const float* in[25]; float* out; unsigned char* ws;
    float invR[64]; float invM[16];
};
constexpr int NW = 8;

__device__ __forceinline__ void tr_item(const float* W, int N, int k0, int n0, bf16_t* WT, int ldk, int drow0, int dk0, const float* kscale, LAS float* scr, int lane, float cs = 1.0f) {
    f32x4 v[8]; const int rsub = lane >> 3, c4 = (lane & 7) * 4;
#pragma unroll
    for (int i = 0; i < 8; ++i) v[i] = *(const f32x4*)(W + (size_t)(k0 + 8 * i + rsub) * N + n0 + c4);
    if (kscale) {
#pragma unroll
        for (int i = 0; i < 8; ++i) v[i] = v[i] * kscale[k0 + 8 * i + rsub]; }
    if (cs != 1.0f) {
#pragma unroll
        for (int i = 0; i < 8; ++i) v[i] = v[i] * cs; }
#pragma unroll
    for (int i = 0; i < 8; ++i) { LAS float* d = scr + (8 * i + rsub) * 33 + c4; d[0] = v[i][0]; d[1] = v[i][1]; d[2] = v[i][2]; d[3] = v[i][3]; }
    asm volatile("s_waitcnt lgkmcnt(0)" ::: "memory");
    const int c = lane & 7;
#pragma unroll
    for (int j = 0; j < 4; ++j) { const int n = (lane >> 3) + 8 * j; const LAS float* s = scr + (8 * c) * 33 + n;
        u32x4 o; o.x = pk2(s[0 * 33], s[1 * 33]); o.y = pk2(s[2 * 33], s[3 * 33]); o.z = pk2(s[4 * 33], s[5 * 33]); o.w = pk2(s[6 * 33], s[7 * 33]);
        *(u32x4*)(WT + (size_t)(drow0 + n) * ldk + dk0 + 8 * c) = o; }
    asm volatile("s_waitcnt lgkmcnt(0)" ::: "memory");
}

constexpr int MI_IN = 16 * 261, MI_UQ = 6 * 24, MI_UKV = 4 * 32, MI_OM = 8 * 32, MI_OC = 8 * 32, MI_OR = 16 * 32, MI_MX = 16 * 32, MI_PAD = 96;
constexpr int MI_TOTAL = MI_IN + MI_UQ + MI_UKV + MI_OM + MI_OC + MI_OR + MI_MX + MI_PAD;
#define PTP(i) ((const float*)(const GAS float*)PT[i])
__device__ __forceinline__ void mixer_weight_item(volatile LAS unsigned long long* PT, int l, int it, unsigned char* wl, LAS float* scr, int lane) {
    bf16_t* WinT = (bf16_t*)(wl + WM_IN); bf16_t* WuqT = (bf16_t*)(wl + WM_UQ); bf16_t* WukvT = (bf16_t*)(wl + WM_UKV); bf16_t* WcatT = (bf16_t*)(wl + WM_CAT); bf16_t* WmixT = (bf16_t*)(wl + WM_MIX);
    int r = it;
    if (r < MI_IN) { const int kb = r / 261, nb = r % 261; tr_item(PTP(7) + (size_t)l * 1024 * IN_TOTAL, IN_TOTAL, 64 * kb, 32 * nb, WinT, 1024, 32 * nb, 64 * kb, nullptr, scr, lane, (32 * nb >= ZC_GL) ? -1.4426950408889634f : 1.0f); return; } r -= MI_IN;
    if (r < MI_UQ) { const int kb = r / 24, nb = r % 24; tr_item(PTP(10) + (size_t)l * 384 * 768, 768, 64 * kb, 32 * nb, WuqT, 384, 32 * nb, 64 * kb, PTP(8) + l * 384, scr, lane); return; } r -= MI_UQ;
    if (r < MI_UKV) { const int kb = r / 32, nb = r % 32; tr_item(PTP(11) + (size_t)l * 256 * 1024, 1024, 64 * kb, 32 * nb, WukvT, 256, 32 * nb, 64 * kb, PTP(9) + l * 256, scr, lane); return; } r -= MI_UKV;
    if (r < MI_OM) { const int kb = r / 32, nb = r % 32; tr_item(PTP(12) + (size_t)l * 512 * 1024, 1024, 64 * kb, 32 * nb, WcatT, ACLD, 32 * nb, 64 * kb, nullptr, scr, lane); return; } r -= MI_OM;
    if (r < MI_OC) { const int kb = r / 32, nb = r % 32; tr_item(PTP(14) + (size_t)l * 512 * 1024, 1024, 64 * kb, 32 * nb, WcatT, ACLD, 32 * nb, 512 + 64 * kb, nullptr, scr, lane); return; } r -= MI_OC;
    if (r < MI_OR) { const int kb = r / 32, nb = r % 32; tr_item(PTP(15) + (size_t)l * 1024 * 1024, 1024, 64 * kb, 32 * nb, WcatT, ACLD, 32 * nb, 1024 + 64 * kb, nullptr, scr, lane); return; } r -= MI_OR;
    if (r < MI_MX) { const int kb = r / 32, nb = r % 32; tr_item(PTP(16) + (size_t)l * 1024 * 1024, 1024, 64 * kb, 32 * nb, WmixT, 1024, 32 * nb, 64 * kb, nullptr, scr, lane); return; } r -= MI_MX;
    { u32x4* p = (u32x4*)(WinT + (size_t)(IN_TOTAL + r) * 1024); unsigned zz = 0u; asm volatile("" : "+v"(zz)); const u32x4 z4 = {zz, zz, zz, zz}; p[lane] = z4; p[lane + 64] = z4; }
}
constexpr int EI_G = 16 * 16, EI_D = 8 * 32, EI_GU_TOTAL = NEXP * 2 * EI_G, EI_D_TOTAL = NEXP * EI_D;
__device__ __forceinline__ void expert_gu_item(volatile LAS unsigned long long* PT, int l, int it, unsigned char* wexp, LAS float* scr, int lane) {
    const int e = it / (2 * EI_G); int r = it % (2 * EI_G);
    bf16_t* Wgu = (bf16_t*)(wexp + WE_GU) + (size_t)e * 1024 * 1024;
    const size_t eo = ((size_t)l * NEXP + e) * 1024 * 512;
    if (r < EI_G) { const int kb = r / 16, nb = r % 16, n0 = 32 * nb; tr_item(PTP(21) + eo, 512, 64 * kb, n0, Wgu, 1024, (n0 >> 7) * 256 + (n0 & 127), 64 * kb, nullptr, scr, lane); return; } r -= EI_G;
    { const int kb = r / 16, nb = r % 16, n0 = 32 * nb; tr_item(PTP(22) + eo, 512, 64 * kb, n0, Wgu, 1024, (n0 >> 7) * 256 + 128 + (n0 & 127), 64 * kb, nullptr, scr, lane); }
}
__device__ __forceinline__ void expert_d_item(volatile LAS unsigned long long* PT, int l, int it, unsigned char* wexp, LAS float* scr, int lane) {
    const int e = it / EI_D, r = it % EI_D;
    bf16_t* Wd = (bf16_t*)(wexp + WE_D) + (size_t)e * 1024 * 512;
    const size_t eo = ((size_t)l * NEXP + e) * 1024 * 512;
    { const int kb = r / 32, nb = r % 32; tr_item(PTP(23) + eo, 1024, 64 * kb, 32 * nb, Wd, 512, 32 * nb, 64 * kb, nullptr, scr, lane); }
}

__device__ __forceinline__ void sincos_acc(float angf, float& s, float& c) {
    const double a = (double)angf; const double k = rint(a * 0.15915494309189535); double r = a - k * 6.283185307179586;
    double sgn = 1.0; if (r > 1.5707963267948966) { r = 3.141592653589793 - r; sgn = -1.0; } else if (r < -1.5707963267948966) { r = -3.141592653589793 - r; sgn = -1.0; }
    const double x2 = r * r;
    double ps = -1.0 / 1307674368000.0; ps = ps * x2 + 1.0 / 6227020800.0; ps = ps * x2 - 1.0 / 39916800.0; ps = ps * x2 + 1.0 / 362880.0; ps = ps * x2 - 1.0 / 5040.0; ps = ps * x2 + 1.0 / 120.0; ps = ps * x2 - 1.0 / 6.0; ps = ps * x2 + 1.0;
    double pc = 1.0 / 20922789888000.0; pc = pc * x2 - 1.0 / 87178291200.0; pc = pc * x2 + 1.0 / 479001600.0; pc = pc * x2 - 1.0 / 3628800.0; pc = pc * x2 + 1.0 / 40320.0; pc = pc * x2 - 1.0 / 720.0; pc = pc * x2 + 1.0 / 24.0; pc = pc * x2 - 0.5; pc = pc * x2 + 1.0;
    s = (float)(r * ps); c = (float)(sgn * pc);
}

__device__ __forceinline__ void norm_row(const float* xrow, bf16_t* orow, const float* g, const float* mod, int which, int lane, f32x4* hout) {
    const f32x4* xr = (const f32x4*)xrow + lane;
    f32x4 v[4]; float ss = 0.f;
#pragma unroll
    for (int j = 0; j < 4; ++j) { v[j] = xr[64 * j]; ss += (v[j][0] * v[j][0] + v[j][1] * v[j][1]) + (v[j][2] * v[j][2] + v[j][3] * v[j][3]); }
    const float rstd = rsqrtf(wave_sum(ss) * (1.0f / DM) + EPS);
    const f32x4* g4 = (const f32x4*)g + lane; const f32x4* sh4 = (const f32x4*)(mod + which * 3072) + lane; const f32x4* sc4 = (const f32x4*)(mod + which * 3072 + 1024) + lane;
    u32x2* o8 = (u32x2*)orow + lane;
#pragma unroll
    for (int j = 0; j < 4; ++j) { const f32x4 hv = v[j] * rstd * g4[64 * j] * (sc4[64 * j] + 1.0f) + sh4[64 * j]; if (hout) hout[j] = hv;
        u32x2 w; w.x = cvt_pk_bf16(hv[0], hv[1]); w.y = cvt_pk_bf16(hv[2], hv[3]); o8[64 * j] = w; }
}

__device__ __forceinline__ float sumsq8(u32x4 v) { float s = 0.f;
#pragma unroll
    for (int j = 0; j < 4; ++j) { const float a = bflo(v[j]), b = bfhi(v[j]); s += a * a + b * b; } return s; }

__device__ __forceinline__ void prep_rows2(int r0, int tg0, bf16_t* Z, bf16_t* KR, bf16_t* AC, float* rstdq, float* rstdkv,
                                           const float* cosR, const float* sinR, const float* cosM, const float* sinM, const f32x4 (&cw)[3][2], int lane) {
    bf16_t* zr = Z + (size_t)r0 * ZLD;
    const int s0 = tg0 & (SEQ - 1); const int ch = lane * 8;
    u32x4 ql[2], kvl[2];
#pragma unroll
    for (int i = 0; i < 2; ++i) { ql[i] = (lane < 48) ? *(const u32x4*)(zr + i * ZLD + ZC_QLAT + lane * 8) : (u32x4){0u, 0u, 0u, 0u}; kvl[i] = (lane < 32) ? *(const u32x4*)(zr + i * ZLD + ZC_KVLAT + lane * 8) : (u32x4){0u, 0u, 0u, 0u}; }
    u32x4 cc[4], cx[4], cb[2];
#pragma unroll
    for (int i = 0; i < 4; ++i) { const int back = 2 - i; if (s0 >= back) { const bf16_t* zz = zr - (long)back * ZLD; cc[i] = *(const u32x4*)(zz + ZC_CC + ch); cx[i] = *(const u32x4*)(zz + ZC_CX + ch); } else { cc[i] = (u32x4){0u, 0u, 0u, 0u}; cx[i] = cc[i]; } }
    cb[0] = *(const u32x4*)(zr + ZC_CB + ch); cb[1] = *(const u32x4*)(zr + ZLD + ZC_CB + ch);
    const int hl = lane >> 5, hh = (lane & 31) >> 3, i0 = (lane & 7) * 8;
    u32x4 ra[2], rb[2]; f32x4 rc[2], rs[2];
#pragma unroll
    for (int q = 0; q < 2; ++q) { rc[q] = *(const f32x4*)(cosR + (size_t)(tg0 + hl) * 64 + i0 + 4 * q); rs[q] = *(const f32x4*)(sinR + (size_t)(tg0 + hl) * 64 + i0 + 4 * q); }
#pragma unroll
    for (int tsel = 0; tsel < 2; ++tsel) { const bf16_t* base = zr + hl * ZLD + (tsel ? ZC_RK : ZC_RQ) + hh * 128 + i0; ra[tsel] = *(const u32x4*)base; rb[tsel] = *(const u32x4*)(base + 64); }
    const int prow = (lane >> 4) & 1, pi = lane & 15;
    float kx1 = 0.f, kx2 = 0.f, kc = 0.f, ks = 0.f;
    if (lane < 32) { kx1 = bf1(zr[prow * ZLD + ZC_KROPE + pi]); kx2 = bf1(zr[prow * ZLD + ZC_KROPE + 16 + pi]); kc = cosM[(size_t)(tg0 + prow) * 16 + pi]; ks = sinM[(size_t)(tg0 + prow) * 16 + pi]; }
#pragma unroll
    for (int i = 0; i < 2; ++i) { const float sq = wave_sum(sumsq8(ql[i])), skv = wave_sum(sumsq8(kvl[i]));
        if (lane == 0) { rstdq[r0 + i] = rsqrtf(sq * (1.0f / 384.0f) + EPS); rstdkv[r0 + i] = rsqrtf(skv * (1.0f / 256.0f) + EPS); } }
    if (lane < 32) { const bf16_t o1 = (bf16_t)f2bf(kx1 * kc - kx2 * ks), o2 = (bf16_t)f2bf(kx1 * ks + kx2 * kc); bf16_t* kr = KR + (size_t)(r0 + prow) * 32 + pi; kr[0] = o1; kr[16] = o2; }
    { float u[4][8];
#pragma unroll
      for (int i = 0; i < 4; ++i)
#pragma unroll
          for (int j = 0; j < 4; ++j) { u[i][2 * j] = bflo(cc[i][j]) * bflo(cx[i][j]); u[i][2 * j + 1] = bfhi(cc[i][j]) * bfhi(cx[i][j]); }
#pragma unroll
      for (int i = 0; i < 2; ++i) { float y[8];
#pragma unroll
          for (int j = 0; j < 8; ++j) y[j] = cw[0][j >> 2][j & 3] * u[i][j] + cw[1][j >> 2][j & 3] * u[i + 1][j] + cw[2][j >> 2][j & 3] * u[i + 2][j];
          u32x4 w;
#pragma unroll
          for (int j = 0; j < 4; ++j) w[j] = cvt_pk_bf16(bflo(cb[i][j]) * y[2 * j], bfhi(cb[i][j]) * y[2 * j + 1]);
          *(u32x4*)(AC + (size_t)(r0 + i) * ACLD + 512 + ch) = w; } }
#pragma unroll
    for (int tsel = 0; tsel < 2; ++tsel) { bf16_t* base = zr + hl * ZLD + (tsel ? ZC_RK : ZC_RQ) + hh * 128 + i0; const float scl = tsel ? 0.08838834764831845f : 1.0f;
        const u32x4 a = ra[tsel], b = rb[tsel]; u32x4 wa, wb;
#pragma unroll
        for (int j = 0; j < 4; ++j) { const float xa0 = bflo(a[j]), xa1 = bfhi(a[j]), xb0 = bflo(b[j]), xb1 = bfhi(b[j]);
            const float c0 = rc[j >> 1][(2 * j) & 3], c1 = rc[j >> 1][(2 * j + 1) & 3], s0 = rs[j >> 1][(2 * j) & 3], s1 = rs[j >> 1][(2 * j + 1) & 3];
            wa[j] = cvt_pk_bf16((xa0 * c0 - xb0 * s0) * scl, (xa1 * c1 - xb1 * s1) * scl); wb[j] = cvt_pk_bf16((xa0 * s0 + xb0 * c0) * scl, (xa1 * s1 + xb1 * c1) * scl); }
        *(u32x4*)base = wa; *(u32x4*)(base + 64) = wb; }
}
#ifndef PH_MASK
#define PH_MASK 0xFFFFFFFFu
#endif
#define PH(n) ((PH_MASK >> (n)) & 1u)
#ifndef DUP_MASK
#define DUP_MASK 0u
#endif
#define DUPN(n) (1 + (int)((DUP_MASK >> (n)) & 1u))
#define WSP() ((unsigned char*)INP(25))
#define OUTP() ((float*)INP(26))
#define GRIDBAR() do { XcdBarrier _b; _b.bar = (unsigned*)(WSP() + WS_CTL) + CW_BAR; _b.x = xb_xcc_id(); _b.st = MISC + 8; xcd_barrier(_b); __builtin_amdgcn_s_waitcnt(0x0F70);   } while (0)
#define LDSP(off) ({ LAS unsigned char* _b = (LAS unsigned char*)lds_raw; asm volatile("" : "+v"(_b)); _b + (off); })
#define INP(i) ({ const unsigned long long _v = *(volatile LAS unsigned long long*)LDSP(MISC_OFF + 512 + 8 * (i)); (const float*)(const GAS float*)(((unsigned long long)(unsigned)__builtin_amdgcn_readfirstlane((int)(_v >> 32)) << 32) | (unsigned long long)(unsigned)__builtin_amdgcn_readfirstlane((int)_v)); })
#ifndef TPROBE_MASK
#define TPROBE_MASK 0u
#endif
#define TPROBE_AMP 4ull
#ifndef TPROBE2_MASK
#define TPROBE2_MASK 0u
#endif
#define TSEGB(k) do { if (TPROBE2_MASK != 0u && blockIdx.x == 0 && threadIdx.x == 0) { volatile LAS unsigned long long* tp_ = (volatile LAS unsigned long long*)LDSP(MISC_OFF + 64); \
    const unsigned long long now_ = __builtin_amdgcn_s_memrealtime(); if ((TPROBE2_MASK >> (k)) & 1u) tp_[1] += now_ - tp_[0]; } } while (0)
#define TSEG(k) do { if ((TPROBE_MASK | TPROBE2_MASK) != 0u && blockIdx.x == 0 && threadIdx.x == 0) { volatile LAS unsigned long long* tp_ = (volatile LAS unsigned long long*)LDSP(MISC_OFF + 64); \
    const unsigned long long now_ = __builtin_amdgcn_s_memrealtime(); if ((TPROBE_MASK >> (k)) & 1u) tp_[1] += now_ - tp_[0]; tp_[0] = now_; } } while (0)
#define PHASE_BEGIN unsigned char* w_ = WSP(); LAS unsigned char* lds = LDSP(0); LAS int* TP = (LAS int*)(lds + MISC_OFF + 256); \
    volatile LAS unsigned long long* PT = (volatile LAS unsigned long long*)(lds + MISC_OFF + 512); (void)TP; (void)PT; \
    int bx = blockIdx.x; asm volatile("" : "+s"(bx)); int tid = tid0; asm volatile("" : "+v"(tid)); \
    const int lane = tid & 63, wave = __builtin_amdgcn_readfirstlane(tid >> 6), gw = bx * NW + wave, NGW = G * NW; (void)lane; (void)gw; (void)NGW; \
    float* const xres = OUTP(); (void)xres;
__global__ void __launch_bounds__(NW * 64, 2) fwd_kernel(Args args) {
    extern __shared__ __attribute__((aligned(16))) unsigned char lds_raw[];
#define MISC ((volatile LAS unsigned*)LDSP(MISC_OFF))
#define TPTR ((LAS int*)LDSP(MISC_OFF + 256))
#define PTAB ((volatile LAS unsigned long long*)LDSP(MISC_OFF + 512))
    const int tid0 = threadIdx.x;
#define G ((int)gridDim.x)

    { LAS unsigned char* lds = LDSP(0); for (int u = tid0; u < 128; u += NW * 64) ((LAS unsigned*)(lds + MISC_OFF))[u] = 0u; }
    { volatile LAS unsigned long long* PT = PTAB;
#pragma unroll
    for (int i = 0; i < 25; ++i) if (tid0 == i) PT[i] = (unsigned long long)args.in[i];
    if (tid0 == 25) PT[25] = (unsigned long long)args.ws;
    if (tid0 == 26) PT[26] = (unsigned long long)args.out; }
    __syncthreads();
    (void)xcd_barrier_post((unsigned*)(WSP() + WS_CTL) + CW_BAR, MISC + 8);
    if ((TPROBE_MASK | TPROBE2_MASK) != 0u && blockIdx.x == 0 && threadIdx.x == 0) { volatile LAS unsigned long long* tp_ = (volatile LAS unsigned long long*)LDSP(MISC_OFF + 64); tp_[0] = __builtin_amdgcn_s_memrealtime(); tp_[1] = 0ull; }

    if (PH(0)) for (int rep_ = 0; rep_ < DUPN(0); ++rep_) {
        PHASE_BEGIN
        float* MODT = (float*)(w_ + WS_MODT);
        LAS float* sc = (LAS float*)lds;
        LAS float* red = (LAS float*)(lds + 16384);
        { const float* cin = INP(1); for (int i = tid; i < 4096; i += NW * 64) sc[i] = siluf_(cin[i]); }
        __syncthreads();
        { const float* wada = INP(3); const float* bada = INP(4);
        for (int it = bx; it < 2 * 192; it += G) {
            const int l = it / 192, c0 = (it % 192) * 32, kp = tid >> 5, col = tid & 31;
            const float* w = wada + (size_t)l * 1024 * 6144 + (size_t)(kp * 64) * 6144 + c0 + col;
            float a0 = 0.f, a1 = 0.f, a2 = 0.f, a3 = 0.f;
#pragma unroll 16
            for (int k = 0; k < 64; ++k) { const float wv = w[(size_t)k * 6144]; const int kk = kp * 64 + k; a0 += sc[kk] * wv; a1 += sc[1024 + kk] * wv; a2 += sc[2048 + kk] * wv; a3 += sc[3072 + kk] * wv; }
            red[(kp * 4 + 0) * 32 + col] = a0; red[(kp * 4 + 1) * 32 + col] = a1; red[(kp * 4 + 2) * 32 + col] = a2; red[(kp * 4 + 3) * 32 + col] = a3;
            __syncthreads();
            if (tid < 128) { const int b = tid >> 5; float s = bada[l * 6144 + c0 + col];
#pragma unroll
                for (int p = 0; p < 16; ++p) s += red[(p * 4 + b) * 32 + col];
                MODT[(size_t)(l * 4 + b) * 6144 + c0 + col] = s; }
            __syncthreads();
        } }
        { const int* pos = (const int*)INP(2);
          float* COSR = (float*)(w_ + WS_COSR); float* SINR = (float*)(w_ + WS_SINR); float* COSM = (float*)(w_ + WS_COSM); float* SINM = (float*)(w_ + WS_SINM);
          for (int i = bx * NW * 64 + tid; i < T * 64; i += G * NW * 64) { const int tg = i >> 6, f = i & 63; float s, c; sincos_acc((float)pos[tg] * args.invR[f], s, c); COSR[i] = c; SINR[i] = s; }
          for (int i = bx * NW * 64 + tid; i < T * 16; i += G * NW * 64) { const int tg = i >> 4, f = i & 15; float s, c; sincos_acc((float)pos[tg] * args.invM[f], s, c); COSM[i] = c; SINM[i] = s; } }
        __syncthreads();
        LAS float* scr = (LAS float*)(lds + wave * 16384);
        for (int it = gw; it < MI_TOTAL; it += NGW) mixer_weight_item(PT, 0, it, w_ + WS_WMIX, scr, lane);
    }
    TSEGB(0); GRIDBAR(); TSEG(0);

    for (int l = 0; l < DEPTH; ++l) {
        for (int half = 0; half < 2; ++half) {
            const int tok0 = half * TH;
            if (l == 0 && half == 0) {
            if (PH(1)) for (int rep_ = 0; rep_ < DUPN(1); ++rep_) { PHASE_BEGIN bf16_t* XN = (bf16_t*)(w_ + WS_ARENA + AR_XN); bf16_t* XNB = (bf16_t*)(w_ + WS_ARENA + AR_XNB); const float* MODT = (const float*)(w_ + WS_MODT);
                const float* xcur = INP(0); const float* gmix = INP(5);
                for (int tg = gw * 2; tg < T; tg += NGW * 2) { const int b = tg / SEQ; const float* mod = MODT + (size_t)(l * 4 + b) * 6144;
                    const f32x4* xa = (const f32x4*)(xcur + (size_t)tg * DM) + lane; const f32x4* xb = xa + DM / 4;
                    f32x4 h0[4], h1[4]; float s0 = 0.f, s1 = 0.f;
#pragma unroll
                    for (int j = 0; j < 4; ++j) { h0[j] = xa[64 * j]; h1[j] = xb[64 * j]; }
#pragma unroll
                    for (int j = 0; j < 4; ++j) { s0 += (h0[j][0] * h0[j][0] + h0[j][1] * h0[j][1]) + (h0[j][2] * h0[j][2] + h0[j][3] * h0[j][3]); s1 += (h1[j][0] * h1[j][0] + h1[j][1] * h1[j][1]) + (h1[j][2] * h1[j][2] + h1[j][3] * h1[j][3]); }
                    const float r0 = rsqrtf(wave_sum(s0) * (1.0f / DM) + EPS), r1 = rsqrtf(wave_sum(s1) * (1.0f / DM) + EPS);
                    const f32x4* g4 = (const f32x4*)gmix + lane; const f32x4* sh4 = (const f32x4*)mod + lane; const f32x4* sc4 = (const f32x4*)(mod + 1024) + lane;
                    u32x2* oa = (u32x2*)((tg < TH ? XN + (size_t)tg * DM : XNB + (size_t)(tg - TH) * DM)) + lane; u32x2* ob = oa + DM / 4;
#pragma unroll
                    for (int j = 0; j < 4; ++j) { const f32x4 a = g4[64 * j] * (sc4[64 * j] + 1.0f), sh = sh4[64 * j]; const f32x4 y0 = h0[j] * r0 * a + sh, y1 = h1[j] * r1 * a + sh;
                        u32x2 w; w.x = cvt_pk_bf16(y0[0], y0[1]); w.y = cvt_pk_bf16(y0[2], y0[3]); oa[64 * j] = w;
                        w.x = cvt_pk_bf16(y1[0], y1[1]); w.y = cvt_pk_bf16(y1[2], y1[3]); ob[64 * j] = w; } } }
            TSEGB(1); GRIDBAR(); TSEG(1);
            }
            if (PH(2)) for (int rep_ = 0; rep_ < DUPN(2); ++rep_) { PHASE_BEGIN
              pg8::Gemm g{(const bf16_t*)(w_ + WS_ARENA + (half ? AR_XNB : AR_XN)), (const bf16_t*)(w_ + WS_WMIX + (size_t)l * WMIX_LAYER + WM_IN), DM, DM, DM, 0u}; pg8::StaticOrder S; S.init(TH, 8192, G, bx);
              pg8::EpiBf16<0> E{(bf16_t*)(w_ + WS_ARENA + AR_Z), ZLD, nullptr, nullptr, 0};
              pg8::gemm_phase<pg8::EpiBf16<0>, pg8::StaticOrder, true>(lds, g, S, E); }
            TSEGB(2); GRIDBAR(); TSEG(2);
            if (PH(3)) for (int rep_ = 0; rep_ < DUPN(3); ++rep_) { PHASE_BEGIN const float* convw = INP(13) + l * 3 * 512;
                { pg8::Gemm g{(const bf16_t*)(w_ + WS_ARENA + (half ? AR_XNB : AR_XN)), (const bf16_t*)(w_ + WS_WMIX + (size_t)l * WMIX_LAYER + WM_IN) + (size_t)8192 * DM, DM, DM, DM, 0u}; pg8::StaticOrder S; S.init(TH, 256, G, bx);
                  pg8::EpiBf16<0> E{(bf16_t*)(w_ + WS_ARENA + AR_Z) + 8192, ZLD, nullptr, nullptr, 0};
                  pg8::gemm_phase<pg8::EpiBf16<0>, pg8::StaticOrder, true>(lds, g, S, E); }
                f32x4 cw[3][2];
#pragma unroll
                for (int k = 0; k < 3; ++k) { cw[k][0] = *(const f32x4*)(convw + k * 512 + lane * 8); cw[k][1] = *(const f32x4*)(convw + k * 512 + lane * 8 + 4); }
                const int nlead = (G > 64) ? 64 : 0;
                const int R1 = nlead ? 9216 : 0;
                for (int pass = 0; pass < 2; ++pass) { const int rlo = pass ? R1 : 0, rhi = pass ? TH : R1;
                  const int vw = pass ? gw : (bx < nlead ? -1 : (bx - nlead) * NW + wave), nvw = pass ? NGW : (G - nlead) * NW;
                  if (vw >= 0) for (int r = rlo + vw * 2; r < rhi; r += nvw * 2)
                    prep_rows2(r, tok0 + r, (bf16_t*)(w_ + WS_ARENA + AR_Z), (bf16_t*)(w_ + WS_ARENA + AR_KROPE), (bf16_t*)(w_ + WS_ARENA + AR_AC), (float*)(w_ + WS_RSTDQ), (float*)(w_ + WS_RSTDKV),
                             (const float*)(w_ + WS_COSR), (const float*)(w_ + WS_SINR), (const float*)(w_ + WS_COSM), (const float*)(w_ + WS_SINM), cw, lane); } }
            TSEGB(3); GRIDBAR(); TSEG(3);
            if (PH(4)) for (int rep_ = 0; rep_ < DUPN(4); ++rep_) { PHASE_BEGIN
              pg8::Gemm g{(const bf16_t*)(w_ + WS_ARENA + AR_Z) + ZC_QLAT, (const bf16_t*)(w_ + WS_WMIX + (size_t)l * WMIX_LAYER + WM_UQ), ZLD, 384, 384, 0u}; pg8::StaticOrder S; S.init(TH, 768, G, bx);
              pg8::EpiBf16<0> E{(bf16_t*)(w_ + WS_ARENA + AR_QB), 768, (const float*)(w_ + WS_RSTDQ), nullptr, 0};
              pg8::gemm_phase<pg8::EpiBf16<0>, pg8::StaticOrder, true>(lds, g, S, E); }
            if (PH(5)) for (int rep_ = 0; rep_ < DUPN(5); ++rep_) { PHASE_BEGIN
              pg8::Gemm g{(const bf16_t*)(w_ + WS_ARENA + AR_Z) + ZC_KVLAT, (const bf16_t*)(w_ + WS_WMIX + (size_t)l * WMIX_LAYER + WM_UKV), ZLD, 256, 256, 0u}; pg8::StaticOrder S; S.init(TH, 1024, G, bx);
              pg8::EpiBf16<1> E{(bf16_t*)(w_ + WS_ARENA + AR_KB), 768, (const float*)(w_ + WS_RSTDKV), (bf16_t*)(w_ + WS_ARENA + AR_VB), 512};
              pg8::gemm_phase<pg8::EpiBf16<1>, pg8::StaticOrder, true>(lds, g, S, E); }
            if (PH(6)) for (int rep_ = 0; rep_ < DUPN(6); ++rep_) { PHASE_BEGIN
              ret::kvloc_phase(bx, G, (const bf16_t*)(w_ + WS_ARENA + AR_Z), (bf16_t*)(w_ + WS_ARENA + AR_RS), (LAS char*)lds); }
            TSEGB(4); GRIDBAR(); TSEG(4);
            if (PH(7)) for (int rep_ = 0; rep_ < DUPN(7); ++rep_) { PHASE_BEGIN
              for (int p = bx; p < 256; p += G) { const int bh = p >> 4, s = p & 15;
#pragma unroll 1
                for (int k = 0; k < 2; ++k)
                  att::attn_unit<8>(bh >> 3, bh & 7, k ? s : 31 - s, (const bf16_t*)(w_ + WS_ARENA + AR_QB), (const bf16_t*)(w_ + WS_ARENA + AR_KB), (const bf16_t*)(w_ + WS_ARENA + AR_KROPE), (const bf16_t*)(w_ + WS_ARENA + AR_VB), (bf16_t*)(w_ + WS_ARENA + AR_AC),
                                 (const float*)(w_ + WS_COSM), (const float*)(w_ + WS_SINM), tok0, (LAS char*)lds); } }
            if (PH(8)) for (int rep_ = 0; rep_ < DUPN(8); ++rep_) { PHASE_BEGIN ret::scan_all((bf16_t*)(w_ + WS_ARENA + AR_RS), bx * NW * 64 + tid, G * NW * 64); }
            TSEGB(5); GRIDBAR(); TSEG(5);
            if (PH(9)) for (int rep_ = 0; rep_ < DUPN(9); ++rep_) { PHASE_BEGIN
              ret::out_phase(bx, G, (const bf16_t*)(w_ + WS_ARENA + AR_Z), (const bf16_t*)(w_ + WS_ARENA + AR_RS), (bf16_t*)(w_ + WS_ARENA + AR_AC), (LAS char*)lds); }
            TSEGB(6); GRIDBAR(); TSEG(6);
            if (PH(10)) for (int rep_ = 0; rep_ < DUPN(10); ++rep_) { PHASE_BEGIN
              pg8::Gemm g{(const bf16_t*)(w_ + WS_ARENA + AR_AC), (const bf16_t*)(w_ + WS_WMIX + (size_t)l * WMIX_LAYER + WM_CAT), ACLD, ACLD, 2048, 0u}; pg8::StaticOrder S; S.init(TH, DM, G, bx);
              pg8::EpiMerge E{(const bf16_t*)(w_ + WS_ARENA + AR_Z), (bf16_t*)(w_ + WS_ARENA + AR_XN)};
              pg8::gemm_phase<pg8::EpiMerge, pg8::StaticOrder, true>(lds, g, S, E); }
            TSEGB(7); GRIDBAR(); TSEG(7);
            if (PH(11)) for (int rep_ = 0; rep_ < DUPN(11); ++rep_) { PHASE_BEGIN bf16_t* XR = (bf16_t*)(w_ + WS_ARENA + AR_XR) + (size_t)tok0 * DM;
              pg8::Gemm g{(const bf16_t*)(w_ + WS_ARENA + AR_XN), (const bf16_t*)(w_ + WS_WMIX + (size_t)l * WMIX_LAYER + WM_MIX), DM, DM, DM, 0u}; pg8::StaticOrder S; S.init(TH, DM, G, bx);
              pg8::EpiResid E{(l == 0) ? INP(0) + (size_t)tok0 * DM : nullptr, (l == 0) ? nullptr : (const bf16_t*)XR, XR, (const float*)(w_ + WS_MODT) + (size_t)(l * 4 + half * 2) * 6144 + 2048};
              pg8::gemm_phase<pg8::EpiResid, pg8::StaticOrder, true>(lds, g, S, E); }
            TSEGB(8); GRIDBAR(); TSEG(8);
        }
        if (PH(12)) for (int rep_ = 0; rep_ < DUPN(12); ++rep_) {
            PHASE_BEGIN
            constexpr int WPITCH = 2064;
            LAS unsigned char* WAH = lds; LAS unsigned char* WAL = lds + 36 * WPITCH;
            LAS float* SHW = (LAS float*)(lds + 72 * WPITCH);
            LAS float* RSTD = SHW + 48;
            LAS float* LG = (LAS float*)(lds + 72 * WPITCH + 704);
            LAS unsigned* LCNT = (LAS unsigned*)(lds + 72 * WPITCH + 704 + 9472); LAS unsigned* LBASE = LCNT + 32; LAS unsigned* LTOK = LCNT + 64;
            static_assert(72 * WPITCH + 704 + 9472 + 256 + 128 * 24 <= MISC_OFF, "routing LDS map");
            const float* gffn = INP(6) + l * DM; const float* MODT = (const float*)(w_ + WS_MODT);
            bf16_t* H2 = (bf16_t*)(w_ + WS_ARENA + AR_H2); const bf16_t* XR = (const bf16_t*)(w_ + WS_ARENA + AR_XR); unsigned* ROUTE = (unsigned*)(w_ + WS_ROUTE); unsigned* cnt = (unsigned*)(w_ + WS_CTL) + CW_CNT + l * 32 * 16;
            float* AFS = (float*)(w_ + WS_AFS) + (size_t)bx * DM;
            const float* wrg = INP(17) + (size_t)l * 1024 * 4; const float* wre = INP(19) + (size_t)l * 1024 * 32; const float* brg = INP(18) + l * 4; const float* bre = INP(20) + l * 32;
            if (tid < 32) LCNT[tid] = 0u;
            for (int chunk = bx; chunk < T / 128; chunk += G) {
              const int b = (chunk * 128) / SEQ; const float* mod = MODT + (size_t)(l * 4 + b) * 6144;
              { float part[36];
#pragma unroll
                for (int j = 0; j < 36; ++j) part[j] = 0.f;
                for (int k = tid; k < 1024; k += NW * 64) { const float ak = gffn[k] * (mod[4096 + k] + 1.0f), shk = mod[3072 + k]; AFS[k] = ak;
                    float wv[36]; { const f32x4 a = *(const f32x4*)(wrg + k * 4); wv[0] = a[0]; wv[1] = a[1]; wv[2] = a[2]; wv[3] = a[3]; }
#pragma unroll
                    for (int q = 0; q < 8; ++q) { const f32x4 e4 = *(const f32x4*)(wre + k * 32 + q * 4); wv[4 + 4 * q] = e4[0]; wv[5 + 4 * q] = e4[1]; wv[6 + 4 * q] = e4[2]; wv[7 + 4 * q] = e4[3]; }
#pragma unroll
                    for (int j = 0; j < 36; ++j) { const float wa = wv[j] * ak; const unsigned hi = f2bf(wa); const float rem = wa - __builtin_bit_cast(float, hi << 16);
                        *(LAS bf16_t*)(WAH + j * WPITCH + k * 2) = (bf16_t)hi; *(LAS bf16_t*)(WAL + j * WPITCH + k * 2) = (bf16_t)f2bf(rem); part[j] += shk * wv[j]; } }
                const float tot = reduce_scatter36(part, lane);
                if (rs36_valid(lane)) LG[wave * 36 + rs36_index(lane)] = tot; }
              __syncthreads();
              if (tid < 36) { float sacc = (tid < 4) ? brg[tid] : bre[tid - 4];
#pragma unroll
                  for (int w8 = 0; w8 < 8; ++w8) sacc += LG[w8 * 36 + tid];
                  SHW[tid] = sacc; }
              __syncthreads();
              const int i16 = lane & 15, g4 = lane >> 4; const int tok = chunk * 128 + wave * 16 + i16;
              const bf16_t* xrow = XR + (size_t)tok * DM + 8 * g4;
              float ss = 0.f; f32x4 acc[3];
#pragma unroll
              for (int nt = 0; nt < 3; ++nt) acc[nt] = (f32x4){0.f, 0.f, 0.f, 0.f};
#pragma unroll 1
              for (int kh = 0; kh < 2; ++kh) {
                  bf16x8 af[16];
#pragma unroll
                  for (int ks = 0; ks < 16; ++ks) af[ks] = *(const bf16x8*)(xrow + 512 * kh + 32 * ks);
#pragma unroll
                  for (int ks = 0; ks < 16; ++ks) { const u32x4 r = __builtin_bit_cast(u32x4, af[ks]);
#pragma unroll
                      for (int e = 0; e < 4; ++e) { const float x0 = bflo(r[e]), x1 = bfhi(r[e]); ss += x0 * x0 + x1 * x1; } }
                  const int r2 = (32 + i16 < 36) ? 32 + i16 : 35;
                  const LAS unsigned char* wh = WAH + i16 * WPITCH + (512 * kh + 8 * g4) * 2; const LAS unsigned char* wl = WAL + i16 * WPITCH + (512 * kh + 8 * g4) * 2;
                  const int o2 = (r2 - i16) * WPITCH;
#pragma unroll
                  for (int ks = 0; ks < 16; ++ks)
#pragma unroll
                      for (int nt = 0; nt < 3; ++nt) { const int ro = (nt == 2) ? o2 : 16 * nt * WPITCH; const bf16x8 bh = *(const LAS bf16x8*)(wh + ro + 64 * ks), bl = *(const LAS bf16x8*)(wl + ro + 64 * ks);
                          acc[nt] = __builtin_amdgcn_mfma_f32_16x16x32_bf16(af[ks], bh, acc[nt], 0, 0, 0); acc[nt] = __builtin_amdgcn_mfma_f32_16x16x32_bf16(af[ks], bl, acc[nt], 0, 0, 0);
                          if (nt == 2 && (ks & 1)) __builtin_amdgcn_sched_barrier(0); }
              }
              { auto rr = __builtin_amdgcn_permlane16_swap(__float_as_uint(ss), __float_as_uint(ss), false, false); ss = __uint_as_float(rr[0]) + __uint_as_float(rr[1]); }
              { auto rr = __builtin_amdgcn_permlane32_swap(__float_as_uint(ss), __float_as_uint(ss), false, false); ss = __uint_as_float(rr[0]) + __uint_as_float(rr[1]); }
              const float rstd = rsqrtf(ss * (1.0f / DM) + EPS);
              if (g4 == 0) RSTD[wave * 16 + i16] = rstd;
              float lgv[3][4];
#pragma unroll
              for (int jj = 0; jj < 4; ++jj) { const float rt = RSTD[wave * 16 + 4 * g4 + jj];
#pragma unroll
                  for (int nt = 0; nt < 3; ++nt) lgv[nt][jj] = acc[nt][jj] * rt + ((16 * nt + i16 < 36) ? SHW[16 * nt + i16] : 0.f); }
              { bf16_t* hr = H2 + (size_t)tok * DM + 8 * g4; const float* ap = AFS + 8 * g4; const float* sp = mod + 3072 + 8 * g4;
#pragma unroll 4
                for (int ks = 0; ks < 32; ++ks) { const u32x4 r = *(const u32x4*)(xrow + 32 * ks); const f32x4 a0 = *(const f32x4*)(ap + 32 * ks), a1 = *(const f32x4*)(ap + 32 * ks + 4), s0 = *(const f32x4*)(sp + 32 * ks), s1 = *(const f32x4*)(sp + 32 * ks + 4);
                    u32x4 w; w.x = cvt_pk_bf16(bflo(r.x) * rstd * a0[0] + s0[0], bfhi(r.x) * rstd * a0[1] + s0[1]); w.y = cvt_pk_bf16(bflo(r.y) * rstd * a0[2] + s0[2], bfhi(r.y) * rstd * a0[3] + s0[3]);
                    w.z = cvt_pk_bf16(bflo(r.z) * rstd * a1[0] + s1[0], bfhi(r.z) * rstd * a1[1] + s1[1]); w.w = cvt_pk_bf16(bflo(r.w) * rstd * a1[2] + s1[2], bfhi(r.w) * rstd * a1[3] + s1[3]);
                    *(u32x4*)(hr + 32 * ks) = w; } }
#pragma unroll 1
              for (int batch = 0; batch < 2; ++batch) {
                if ((wave >> 2) == batch) {
#pragma unroll
                    for (int jj = 0; jj < 4; ++jj)
#pragma unroll
                        for (int nt = 0; nt < 3; ++nt) if (16 * nt + i16 < 36) LG[((wave & 3) * 16 + 4 * g4 + jj) * 37 + 16 * nt + i16] = lgv[nt][jj]; }
                __syncthreads();
                if (tid < 64) {
                    const int tg = chunk * 128 + batch * 64 + tid; const LAS float* lgp = LG + tid * 37;
                    float gl[4];
#pragma unroll
                    for (int q = 0; q < 4; ++q) gl[q] = lgp[q];
                    float gm = gl[0]; int gi = 0;
#pragma unroll
                    for (int q = 1; q < 4; ++q) if (gl[q] > gm) { gm = gl[q]; gi = q; }
                    float gs = 0.f;
#pragma unroll
                    for (int q = 0; q < 4; ++q) gs += __expf(gl[q] - gm);
                    const float gval = 1.0f / gs;
                    float el[8];
#pragma unroll
                    for (int k = 0; k < 8; ++k) el[k] = lgp[4 + gi * 8 + k];
                    float m1 = el[0]; int i1 = 0;
#pragma unroll
                    for (int k = 1; k < 8; ++k) if (el[k] > m1) { m1 = el[k]; i1 = k; }
                    float m2 = -3.0e38f; int i2 = 0;
#pragma unroll
                    for (int k = 0; k < 8; ++k) if (k != i1 && el[k] > m2) { m2 = el[k]; i2 = k; }
                    const float p2 = __expf(m2 - m1); const float w1 = gval / (1.0f + p2), w2 = gval * p2 / (1.0f + p2);
                    const int e1 = gi * 8 + i1, e2 = gi * 8 + i2;
                    const unsigned r1 = __hip_atomic_fetch_add(LCNT + e1, 1u, __ATOMIC_RELAXED, __HIP_MEMORY_SCOPE_WORKGROUP), r2 = __hip_atomic_fetch_add(LCNT + e2, 1u, __ATOMIC_RELAXED, __HIP_MEMORY_SCOPE_WORKGROUP);
                    LAS unsigned* te = LTOK + (batch * 64 + tid) * 6; te[0] = (unsigned)e1; te[1] = (unsigned)e2; te[2] = __float_as_uint(w1); te[3] = __float_as_uint(w2); te[4] = r1; te[5] = r2;
                }
                __syncthreads();
              }
              if (tid < 32) { const unsigned c = LCNT[tid]; LBASE[tid] = c ? atomicAdd(cnt + tid * 16, c) : 0u; }
              __syncthreads();
              if (tid < 128) { const LAS unsigned* te = LTOK + tid * 6; const int tg = chunk * 128 + tid;
                  u32x4 a; a.x = te[0]; a.y = te[1]; a.z = te[2]; a.w = te[3]; u32x2 rr; rr.x = te[4] + LBASE[te[0]]; rr.y = te[5] + LBASE[te[1]];
                  *(u32x4*)(ROUTE + (size_t)tg * 8) = a; *(u32x2*)(ROUTE + (size_t)tg * 8 + 4) = rr; }
              if (tid < 32) LCNT[tid] = 0u;
              __syncthreads();
            }
        }
        TSEGB(9); GRIDBAR(); TSEG(9);
        if (PH(13)) for (int rep_ = 0; rep_ < DUPN(13); ++rep_) {
            PHASE_BEGIN unsigned* cnt = (unsigned*)(w_ + WS_CTL) + CW_CNT + l * 32 * 16;
            LAS int* CN = (LAS int*)(lds + MISC_OFF + 128);
            if (tid < 32) CN[tid] = (int)__hip_atomic_load(cnt + tid * 16, RLX_AGENT);
            __syncthreads();
            if (tid == 0) { int acc = 0;
                for (int e = 0; e < 32; ++e) { TP[e] = acc; acc += (int)(((unsigned)CN[e] + 255u) >> 8); }
                TP[32] = acc; }
            __syncthreads();
            unsigned* ROUTE = (unsigned*)(w_ + WS_ROUTE); int* PERM = (int*)(w_ + WS_PERM);
            for (int tg = bx * NW * 64 + tid; tg < T; tg += G * NW * 64) {
                const u32x4 a = *(const u32x4*)(ROUTE + (size_t)tg * 8); const u32x2 rk = *(const u32x2*)(ROUTE + (size_t)tg * 8 + 4);
                u32x2 pp; pp.x = (unsigned)TP[a.x] * 256u + rk.x; pp.y = (unsigned)TP[a.y] * 256u + rk.y;
                PERM[pp.x] = tg; PERM[pp.y] = tg; *(u32x2*)(ROUTE + (size_t)tg * 8 + 6) = pp; }
            for (int idx = bx * NW * 64 + tid; idx < 32 * 256; idx += G * NW * 64) { const int e = idx >> 8, i = idx & 255, c = CN[e] & 255;
                if (c != 0 && i >= c) PERM[(TP[e + 1] - 1) * 256 + i] = 0; }
            LAS float* scr = (LAS float*)(lds + wave * 16384);
            for (int it = gw; it < EI_GU_TOTAL; it += NGW) expert_gu_item(PT, l, it, w_ + WS_ARENA + AR_WEXP, scr, lane);
        }
        TSEGB(10); GRIDBAR(); TSEG(10);
        if (PH(14)) for (int rep_ = 0; rep_ < DUPN(14); ++rep_) { PHASE_BEGIN
          pg8::Gemm g{(const bf16_t*)(w_ + WS_ARENA + AR_H2), (const bf16_t*)(w_ + WS_ARENA + AR_WEXP + WE_GU), DM, DM, DM, 1024u * 1024u * 2u, (const int*)(w_ + WS_PERM)}; pg8::ExpertOrder S{TP, G, (G % 8 == 0) ? (bx % 8) * (G / 8) + bx / 8 : bx};
          pg8::EpiGU E{(bf16_t*)(w_ + WS_ARENA + AR_HID)};
          pg8::gemm_phase<pg8::EpiGU, pg8::ExpertOrder, true, true>(lds, g, S, E);
          { const int units = __builtin_amdgcn_readfirstlane(TP[32]) * 4, rem = units % G, nidle = rem ? G - rem : G, ii = rem ? S.c - rem : S.c;
            if (ii >= 0) { LAS float* scr = (LAS float*)(lds + wave * 16384);
              for (int it = ii * NW + wave; it < EI_D_TOTAL; it += nidle * NW) expert_d_item(PT, l, it, w_ + WS_ARENA + AR_WEXP, scr, lane); } } }
        TSEGB(11); GRIDBAR(); TSEG(11);
        if (PH(15)) for (int rep_ = 0; rep_ < DUPN(15); ++rep_) { PHASE_BEGIN
          pg8::Gemm g{(const bf16_t*)(w_ + WS_ARENA + AR_HID), (const bf16_t*)(w_ + WS_ARENA + AR_WEXP + WE_D), EFF, EFF, EFF, 1024u * 512u * 2u}; pg8::ExpertOrder S{TP, G, (G % 8 == 0) ? (bx % 8) * (G / 8) + bx / 8 : bx};
          pg8::EpiBf16<0> E{(bf16_t*)(w_ + WS_ARENA + AR_YS), DM, nullptr, nullptr, 0};
          pg8::gemm_phase<pg8::EpiBf16<0>, pg8::ExpertOrder, true>(lds, g, S, E);
          if (l + 1 < DEPTH) { const int units = __builtin_amdgcn_readfirstlane(TP[32]) * 4, rem = units % G, nidle = rem ? G - rem : G, ii = rem ? S.c - rem : S.c;
            if (ii >= 0) { LAS float* scr = (LAS float*)(lds + wave * 16384);
              for (int it = ii * NW + wave; it < MI_TOTAL; it += nidle * NW) mixer_weight_item(PT, l + 1, it, w_ + WS_WMIX + (size_t)(l + 1) * WMIX_LAYER, scr, lane); } } }
        TSEGB(12); GRIDBAR(); TSEG(12);
        if (PH(16)) for (int rep_ = 0; rep_ < DUPN(16); ++rep_) { PHASE_BEGIN const unsigned* ROUTE = (const unsigned*)(w_ + WS_ROUTE); const bf16_t* YS = (const bf16_t*)(w_ + WS_ARENA + AR_YS); const float* MODT = (const float*)(w_ + WS_MODT);
          bf16_t* XR = (bf16_t*)(w_ + WS_ARENA + AR_XR); const float* fgp = INP(24); const float* gnext = INP(5) + (l + 1 < DEPTH ? (l + 1) * DM : 0); bf16_t* XN = (bf16_t*)(w_ + WS_ARENA + AR_XN); bf16_t* XNB = (bf16_t*)(w_ + WS_ARENA + AR_XNB);
          for (int t4 = gw * 4; t4 < T; t4 += NGW * 4) { const int b = t4 / SEQ;
            const f32x4* gt = (const f32x4*)(MODT + (size_t)(l * 4 + b) * 6144 + 5120) + lane;
            u32x4 a[4]; u32x2 pp[4];
#pragma unroll
            for (int i = 0; i < 4; ++i) { a[i] = *(const u32x4*)(ROUTE + (size_t)(t4 + i) * 8); pp[i] = *(const u32x2*)(ROUTE + (size_t)(t4 + i) * 8 + 6); }
            f32x4 xv[4][4]; u32x2 ya[4][4], yb[4][4];
#pragma unroll
            for (int i = 0; i < 4; ++i) { const u32x2* xr = (const u32x2*)(XR + (size_t)(t4 + i) * DM) + lane; const u32x2* y1 = (const u32x2*)(YS + (size_t)pp[i].x * DM) + lane; const u32x2* y2 = (const u32x2*)(YS + (size_t)pp[i].y * DM) + lane;
#pragma unroll
                for (int j = 0; j < 4; ++j) { const u32x2 rx = xr[64 * j]; xv[i][j] = (f32x4){bflo(rx.x), bfhi(rx.x), bflo(rx.y), bfhi(rx.y)}; ya[i][j] = y1[64 * j]; yb[i][j] = y2[64 * j]; } }
            f32x4 gv[4], na[4], nsh[4];
#pragma unroll
            for (int j = 0; j < 4; ++j) gv[j] = gt[64 * j];
            if (l + 1 < DEPTH) { const float* nmod = MODT + (size_t)((l + 1) * 4 + b) * 6144; const f32x4* g4 = (const f32x4*)gnext + lane; const f32x4* sh4 = (const f32x4*)nmod + lane; const f32x4* sc4 = (const f32x4*)(nmod + 1024) + lane;
#pragma unroll
                for (int j = 0; j < 4; ++j) { na[j] = g4[64 * j] * (sc4[64 * j] + 1.0f); nsh[j] = sh4[64 * j]; } }
            else {
#pragma unroll
                for (int j = 0; j < 4; ++j) { na[j] = (f32x4){0.f, 0.f, 0.f, 0.f}; nsh[j] = na[j]; } }
#pragma unroll
            for (int i = 0; i < 4; ++i) { const float w1 = __uint_as_float(a[i].z), w2 = __uint_as_float(a[i].w); f32x4* xr = (f32x4*)(xres + (size_t)(t4 + i) * DM) + lane; u32x2* xq = (u32x2*)(XR + (size_t)(t4 + i) * DM) + lane; float ss = 0.f;
#pragma unroll
                for (int j = 0; j < 4; ++j) { const f32x4 m = (f32x4){bflo(ya[i][j].x), bfhi(ya[i][j].x), bflo(ya[i][j].y), bfhi(ya[i][j].y)} * w1 + (f32x4){bflo(yb[i][j].x), bfhi(yb[i][j].x), bflo(yb[i][j].y), bfhi(yb[i][j].y)} * w2;
                    xv[i][j] = xv[i][j] + gv[j] * m; ss += (xv[i][j][0] * xv[i][j][0] + xv[i][j][1] * xv[i][j][1]) + (xv[i][j][2] * xv[i][j][2] + xv[i][j][3] * xv[i][j][3]); }
                if (l == DEPTH - 1) { const float rstd = rsqrtf(wave_sum(ss) * (1.0f / DM) + EPS); const f32x4* fg = (const f32x4*)fgp + lane;
#pragma unroll
                    for (int j = 0; j < 4; ++j) xr[64 * j] = xv[i][j] * rstd * fg[64 * j]; }
                else { const float rstd = rsqrtf(wave_sum(ss) * (1.0f / DM) + EPS); const int t_ = t4 + i;
                    u32x2* oh = (u32x2*)((t_ < TH ? XN + (size_t)t_ * DM : XNB + (size_t)(t_ - TH) * DM)) + lane;
#pragma unroll
                    for (int j = 0; j < 4; ++j) { { u32x2 wq; wq.x = cvt_pk_bf16(xv[i][j][0], xv[i][j][1]); wq.y = cvt_pk_bf16(xv[i][j][2], xv[i][j][3]); xq[64 * j] = wq; } const f32x4 y = xv[i][j] * rstd * na[j] + nsh[j]; u32x2 w; w.x = cvt_pk_bf16(y[0], y[1]); w.y = cvt_pk_bf16(y[2], y[3]); oh[64 * j] = w; } } }
          } }
        if (l + 1 < DEPTH) { TSEGB(13); GRIDBAR(); } TSEG(13);
    }
    if ((TPROBE_MASK | TPROBE2_MASK) != 0u && blockIdx.x == 0 && threadIdx.x == 0) { volatile LAS unsigned long long* tp_ = (volatile LAS unsigned long long*)LDSP(MISC_OFF + 64);
        const unsigned long long t0_ = __builtin_amdgcn_s_memrealtime(), w_ = TPROBE_AMP * tp_[1]; while (__builtin_amdgcn_s_memrealtime() - t0_ < w_) __builtin_amdgcn_s_sleep(8); }
}

#undef G
#undef MISC
extern "C" void kernel_launch(void* const* d_in, const int* in_sizes, int n_in, void* d_out, int out_size, void* d_ws, size_t ws_size, hipStream_t stream) {
    static int grid = 0;
    if (grid == 0) {
        if (n_in != 25 || out_size != T * DM || ws_size < WS_END) { fprintf(stderr, "kernel_launch: unexpected shapes (n_in %d, out %d, ws %zu < %zu)\n", n_in, out_size, ws_size, (size_t)WS_END); grid = -1; return; }
        int dev = 0, cus = 0;
        if (hipGetDevice(&dev) != hipSuccess || hipDeviceGetAttribute(&cus, hipDeviceAttributeMultiprocessorCount, dev) != hipSuccess) { grid = -1; return; }
        if (hipFuncSetAttribute((const void*)fwd_kernel, hipFuncAttributeMaxDynamicSharedMemorySize, LDS_BYTES) != hipSuccess) { fprintf(stderr, "kernel_launch: hipFuncSetAttribute failed\n"); grid = -1; return; }
        int per_cu = 0;
        if (hipOccupancyMaxActiveBlocksPerMultiprocessor(&per_cu, (const void*)fwd_kernel, NW * 64, LDS_BYTES) != hipSuccess || per_cu < 1) { fprintf(stderr, "kernel_launch: occupancy query says %d\n", per_cu); }
        (void)hipGetLastError();
        grid = cus;
    }
    if (grid < 0) return;
    (void)hipMemsetAsync((char*)d_ws + WS_CTL, 0, CTL_ZERO_BYTES, stream);
    Args a{};
    for (int i = 0; i < 25; ++i) a.in[i] = (const float*)d_in[i];
    a.out = (float*)d_out; a.ws = (unsigned char*)d_ws;
    for (int i = 0; i < 64; ++i) a.invR[i] = powf(10000.0f, -(float)(2 * i) / 128.0f);
    for (int i = 0; i < 16; ++i) a.invM[i] = powf(10000.0f, -(float)(2 * i) / 32.0f);
    hipLaunchKernelGGL(fwd_kernel, dim3(grid), dim3(NW * 64), LDS_BYTES, stream, a);
    const hipError_t le = hipPeekAtLastError();
    if (le != hipSuccess) fprintf(stderr, "kernel_launch: launch failed: %s\n", hipGetErrorName(le));
}
```

```cpp
#include <hip/hip_runtime.h>
#include <cstdio>
#include <cstdint>
#include <cmath>

#define LAS __attribute__((address_space(3)))
#define GAS __attribute__((address_space(1)))
typedef unsigned short bf16_t;
typedef short bf16x8 __attribute__((ext_vector_type(8)));
typedef short s16x4 __attribute__((ext_vector_type(4)));
typedef float f32x4 __attribute__((ext_vector_type(4)));
typedef float f32x2 __attribute__((ext_vector_type(2)));
typedef float f32x16 __attribute__((ext_vector_type(16)));
typedef unsigned u32x4 __attribute__((ext_vector_type(4)));
typedef unsigned u32x2 __attribute__((ext_vector_type(2)));

constexpr int DM = 1024, NBATCH = 4, SEQ = 8192, T = NBATCH * SEQ, TH = T / 2, DEPTH = 2;
constexpr int IN_TOTAL = 8352, ZLD = 8448;
constexpr int ZC_QLAT = 0, ZC_KVLAT = 384, ZC_KROPE = 640, ZC_CB = 672, ZC_CC = 1184, ZC_CX = 1696, ZC_RQ = 2208, ZC_RK = 2720, ZC_RV = 3232, ZC_RG = 4256, ZC_GL = 5280;
constexpr int NEXP = 32, EFF = 512;
constexpr int ACLD = 2112;
constexpr int XS_ROWS = 73728;
constexpr float EPS = 1e-6f;

constexpr size_t MiB = 1u << 20;
constexpr size_t WS_CTL = 0, CTL_ZERO_BYTES = 64 * 1024;
constexpr size_t WS_MODT = 1 * MiB;
constexpr size_t WS_RSTDQ = 1 * MiB + 256 * 1024, WS_RSTDKV = 1 * MiB + 512 * 1024;
constexpr size_t WS_PERM = 1 * MiB + 576 * 1024;
constexpr size_t WS_AFS = 23 * MiB;
constexpr size_t WS_ROUTE = 2 * MiB;
constexpr size_t WS_COSR = 3 * MiB, WS_SINR = 11 * MiB, WS_COSM = 19 * MiB, WS_SINM = 21 * MiB;
constexpr size_t WS_WMIX = 24 * MiB, WMIX_LAYER = 26 * MiB;
constexpr size_t WM_IN = 0, WM_UQ = 17 * MiB, WM_UKV = 18 * MiB, WM_CAT = 19 * MiB, WM_MIX = 24 * MiB;
constexpr size_t WS_ARENA = 76 * MiB;
constexpr size_t AR_XN = 0, AR_QB = 0, AR_Z = 32 * MiB, AR_KB = 296 * MiB, AR_VB = 320 * MiB, AR_AC = 336 * MiB, AR_KROPE = 402 * MiB  , AR_RS = 404 * MiB;
constexpr size_t AR_WEXP = 0, AR_H2 = 96 * MiB, AR_HID = 160 * MiB, AR_YS = 232 * MiB;
static_assert(WM_MIX + 2 * MiB <= WMIX_LAYER && WS_WMIX + 2 * WMIX_LAYER <= WS_ARENA && WM_CAT + (size_t)1024 * ACLD * 2 <= WM_MIX && AR_AC + (size_t)TH * ACLD * 2 <= AR_KROPE && AR_KROPE + (size_t)TH * 64 <= AR_RS && AR_RS + 64 * MiB <= 468 * MiB, "weight / arena map");
constexpr size_t AR_XNB = 468 * MiB;
constexpr size_t AR_XR = 500 * MiB;
constexpr size_t WS_END = WS_ARENA + 564 * MiB;
constexpr size_t WE_GU = 0, WE_D = (size_t)NEXP * 1024 * 1024 * 2;
constexpr int CW_TMO = 0, CW_CODE = 1, CW_BAR = 4096, CW_CNT = 8192;

constexpr int LDS_BYTES = 160 * 1024;
constexpr int MISC_OFF = LDS_BYTES - 1024;

#define RLX_AGENT __ATOMIC_RELAXED, __HIP_MEMORY_SCOPE_AGENT
__device__ __forceinline__ unsigned f2bf(float f) { unsigned u = __builtin_bit_cast(unsigned, f); return (u + 0x7fffu + ((u >> 16) & 1u)) >> 16; }
__device__ __forceinline__ unsigned pk2(float lo, float hi) { return f2bf(lo) | (f2bf(hi) << 16); }
typedef __bf16 bf16x2_t __attribute__((ext_vector_type(2)));
__device__ __forceinline__ unsigned cvt_pk_bf16(float lo, float hi) { f32x2 v = {lo, hi}; bf16x2_t b = __builtin_convertvector(v, bf16x2_t); return __builtin_bit_cast(unsigned, b); }
__device__ __forceinline__ float bflo(unsigned u) { return __builtin_bit_cast(float, u << 16); }
__device__ __forceinline__ float bfhi(unsigned u) { return __builtin_bit_cast(float, u & 0xffff0000u); }
__device__ __forceinline__ float bf1(bf16_t v) { return __builtin_bit_cast(float, (unsigned)v << 16); }
__device__ __forceinline__ float dpp_f(float v, int ctrl_sel) {
    const int x = __builtin_bit_cast(int, v); int r;
    if (ctrl_sel == 0) r = __builtin_amdgcn_update_dpp(x, x, 0xB1, 0xF, 0xF, false);
    else if (ctrl_sel == 1) r = __builtin_amdgcn_update_dpp(x, x, 0x4E, 0xF, 0xF, false);
    else if (ctrl_sel == 2) r = __builtin_amdgcn_update_dpp(x, x, 0x141, 0xF, 0xF, false);
    else r = __builtin_amdgcn_update_dpp(x, x, 0x140, 0xF, 0xF, false);
    return __builtin_bit_cast(float, r);
}
__device__ __forceinline__ float wave_sum(float v) {
    v += dpp_f(v, 0); v += dpp_f(v, 1); v += dpp_f(v, 2); v += dpp_f(v, 3);
    { auto rr = __builtin_amdgcn_permlane16_swap(__float_as_uint(v), __float_as_uint(v), false, false); v = __uint_as_float(rr[0]) + __uint_as_float(rr[1]); }
    { auto rr = __builtin_amdgcn_permlane32_swap(__float_as_uint(v), __float_as_uint(v), false, false); v = __uint_as_float(rr[0]) + __uint_as_float(rr[1]); }
    return v;
}
__device__ __forceinline__ float vmax3_(float a, float b, float c) { float r; asm("v_max3_f32 %0, %1, %2, %3" : "=v"(r) : "v"(a), "v"(b), "v"(c)); return r; }
__device__ __forceinline__ float vmax2_(float a, float b) { float r; asm("v_max_f32 %0, %1, %2" : "=v"(r) : "v"(a), "v"(b)); return r; }
__device__ __forceinline__ float sigmoidf_(float a) { return __builtin_amdgcn_rcpf(1.0f + __expf(-a)); }
__device__ __forceinline__ float siluf_(float a) { return a * __builtin_amdgcn_rcpf(1.0f + __expf(-a)); }

namespace pg8 {
constexpr int BM = 256, BK = 64, HALF = 128, HTB = HALF * BK * 2, STAGE_BYTES = 8 * HTB, NXCD = 8, WGM = 8;
__host__ __device__ __forceinline__ int lds_byte(int r, int c) { const int st = (r >> 4) * 2 + (c >> 5), rr = r & 15, cc = c & 31, ob = rr * 64 + cc * 2; return st * 1024 + (ob ^ (((ob >> 9) & 1) << 5)); }
__host__ __device__ __forceinline__ void stage_rc(int b, int& R, int& C) { const int st = b / 1024, sb = b % 1024, swz = sb ^ (((sb >> 9) & 1) << 5); R = (st >> 1) * 16 + swz / 64; C = (st & 1) * 32 + (swz % 64) / 2; }
__host__ __device__ __forceinline__ int perm32(int rho) { const int n = rho >> 4, i = rho & 15; return 8 * (i >> 2) + 4 * n + (i & 3); }

struct Unit { int pm, pn, e; };
struct Gemm { const bf16_t* A; const bf16_t* Bt; int lda, ldb, K; unsigned bes; const int* perm; };

struct StaticOrder {
    int nM, nN, nwg, G, c;
    __device__ void init(int M, int N, int G_, int c_) { nM = M / BM; nN = N / BM; nwg = nM * nN; G = G_; c = c_; }
    __device__ bool next(int i, Unit& u) const {
        const long L = (long)i * G + c; if (L >= nwg) return false;
        int wgid = (int)L; { const int q = nwg / NXCD, r = nwg % NXCD, xcd = wgid % NXCD, off = wgid / NXCD; wgid = (xcd < r ? xcd * (q + 1) : r * (q + 1) + (xcd - r) * q) + off; }
        const int nig = WGM * nN, gid = wgid / nig, fm = gid * WGM, gsz = (nM - fm) < WGM ? (nM - fm) : WGM;
        u.pm = fm + ((wgid % nig) % gsz); u.pn = (wgid % nig) / gsz; u.e = 0; return true;
    }
};
struct ExpertOrder {
    const LAS int* tp; int G, c;
    __device__ bool next(int i, Unit& u) const {
        const int L = i * G + c; const int nt = __builtin_amdgcn_readfirstlane(tp[32]);
        if (L >= nt * 4) return false;
        const int rt = L >> 2; u.pm = rt; u.pn = L & 3;
        int e = 0;
#pragma unroll
        for (int s = 16; s >= 1; s >>= 1) { const int v = __builtin_amdgcn_readfirstlane(tp[e + s]); if (v <= rt) e += s; }
        u.e = e; return true;
    }
};

typedef f32x4 Acc[2][2][4][2];

template <class Epi, class Sched, bool ALIGN_EPI, bool GATHER = false>
__device__ __forceinline__ void gemm_phase(LAS unsigned char* lds, const Gemm g, const Sched& S, const Epi& E) {
    int tid_ = threadIdx.x; asm volatile("" : "+v"(tid_));
    const int tid = tid_, wid = __builtin_amdgcn_readfirstlane(tid >> 6), lane = tid & 63, wr = wid >> 2, wc = wid & 3, fr = lane & 15, fq = lane >> 4;
    int K_ = g.K; asm volatile("" : "+s"(K_));
    const int nt = K_ / BK;
    unsigned voffA, voffB;
    { int R, C; stage_rc(tid * 16, R, C); const int Rb = Epi::PERM ? ((R & ~31) + perm32(R & 31)) : R;
        voffA = (unsigned)(R * g.lda + C) * 2u; voffB = (unsigned)(Rb * g.ldb + C) * 2u; }
    int ropar = 0; (void)ropar;
#define PG8_ROS(par) ((LAS u32x4*)(lds + STAGE_BYTES) + (par) * 512 + tid)
#define PG8_LOADRO(dst, pm_) do { int R_, C_; stage_rc(tid * 16, R_, C_); const int* pp_ = g.perm + (size_t)(pm_) * BM + R_; int t0_ = pp_[0], t1_ = pp_[64], t2_ = pp_[128], t3_ = pp_[192]; \
        asm volatile("s_waitcnt vmcnt(0)" : "+v"(t0_), "+v"(t1_), "+v"(t2_), "+v"(t3_) :: "memory"); const unsigned c2_ = (unsigned)C_ * 2u, ls_ = (unsigned)(g.lda * 2); \
        dst[0] = (unsigned)t0_ * ls_ + c2_; dst[1] = (unsigned)t1_ * ls_ + c2_; dst[2] = (unsigned)t2_ * ls_ + c2_; dst[3] = (unsigned)t3_ * ls_ + c2_; } while (0)
    constexpr unsigned kstep = BK * 2;
    const unsigned hstepA = (unsigned)(HALF * g.lda * 2), hstepB = (unsigned)(HALF * g.ldb * 2);
    const unsigned tstepA = 2 * hstepA, tstepB = 2 * hstepB, d64A = hstepA / 2, d64B = hstepB / 2;
    const unsigned ldsw = (unsigned)wid * 1024u;
    const unsigned ldsS = (unsigned)__builtin_amdgcn_readfirstlane((int)(unsigned)(uintptr_t)lds) + ldsw;
    const int aoff = lds_byte(wr * 64 + fr, fq * 8), boff = lds_byte(wc * 32 + fr, fq * 8);
#define PG8_SA(b, h) (((b) * 2 + (h)) * HTB)
#define PG8_SB(b, h) ((4 + (b) * 2 + (h)) * HTB)
#define PG8_STAGE_(bufoff, gbase, voff, d64) do { _Pragma("unroll") for (int _i = 0; _i < 2; ++_i) \
        __builtin_amdgcn_global_load_lds((const unsigned*)((const char*)(gbase) + (_i ? (d64) : 0u) + (voff)), (LAS unsigned*)(uintptr_t)(ldsS + (unsigned)(bufoff) + _i * 8192u), 16, 0, 0); } while (0)
#define PG8_STAGE(bufoff, gbase, voff) PG8_STAGE_(bufoff, gbase, voff, ((&(voff) == &voffA) ? d64A : d64B))
#define PG8_STAGE_A(b, h, kptr, RO) do { if constexpr (GATHER) { const u32x2 o2_ = *((const LAS u32x2*)PG8_ROS(RO) + (h)); _Pragma("unroll") for (int _i = 0; _i < 2; ++_i) \
        __builtin_amdgcn_global_load_lds((const unsigned*)((const char*)(kptr) + o2_[_i]), (LAS unsigned*)(uintptr_t)(ldsS + (unsigned)PG8_SA(b, h) + _i * 8192u), 16, 0, 0); } \
    else PG8_STAGE_(PG8_SA(b, h), (const char*)(kptr) + ((h) ? hstepA : 0u), voffA, d64A); } while (0)
#define PG8_STAGE_A2(b, h, kptr) PG8_STAGE_A(b, h, kptr, (last ? (ropar ^ 1) : ropar))
#define PG8_LDA(dst, b, h) do { _Pragma("unroll") for (int m = 0; m < 4; ++m) _Pragma("unroll") for (int k = 0; k < 2; ++k) dst[m][k] = *(const LAS bf16x8*)(lds + PG8_SA(b, h) + aoff + m * 2048 + k * 1024); } while (0)
#define PG8_LDB(dst, b, h) do { _Pragma("unroll") for (int n = 0; n < 2; ++n) _Pragma("unroll") for (int k = 0; k < 2; ++k) dst[n][k] = *(const LAS bf16x8*)(lds + PG8_SB(b, h) + boff + n * 2048 + k * 1024); } while (0)
#define PG8_MMA(ai, bj, At, Bt) do { __builtin_amdgcn_s_setprio(1); _Pragma("unroll") for (int m = 0; m < 4; ++m) _Pragma("unroll") for (int n = 0; n < 2; ++n) _Pragma("unroll") for (int k = 0; k < 2; ++k) \
        acc[ai][bj][m][n] = __builtin_amdgcn_mfma_f32_16x16x32_bf16(Bt[n][k], At[m][k], acc[ai][bj][m][n], 0, 0, 0); __builtin_amdgcn_s_setprio(0); } while (0)
#define PG8_WAIT_V(n) asm volatile("s_waitcnt vmcnt(" #n ")" ::: "memory")
#define PG8_WAIT_L(n) asm volatile("s_waitcnt lgkmcnt(" #n ")" ::: "memory")
#define PG8_BAR __builtin_amdgcn_s_barrier()
#define PG8_SCHED __builtin_amdgcn_sched_barrier(0)
#define PG8_WAIT_VR(rl) do { if constexpr (Epi::NST == 16) asm volatile("s_waitcnt vmcnt(24)\n\ts_cmp_lg_u32 %0, 0\n\ts_cbranch_scc1 1f\n\ts_waitcnt vmcnt(8)\n1:" :: "s"(rl) : "scc", "memory"); \
        else asm volatile("s_waitcnt vmcnt(16)\n\ts_cmp_lg_u32 %0, 0\n\ts_cbranch_scc1 1f\n\ts_waitcnt vmcnt(8)\n1:" :: "s"(rl) : "scc", "memory"); } while (0)
    int uf_ = 0;
    Unit cur, nxt; int ui = 0;
    if (!S.next(0, cur)) return;
    Acc acc;
#pragma unroll
    for (int a = 0; a < 2; ++a)
#pragma unroll
        for (int b = 0; b < 2; ++b)
#pragma unroll
            for (int m = 0; m < 4; ++m)
#pragma unroll
                for (int n = 0; n < 2; ++n) acc[a][b][m][n] = (f32x4){0.f, 0.f, 0.f, 0.f};
    bf16x8 At[4][2], B0[2][2], B1[2][2];
    if constexpr (GATHER) { unsigned t4_[4]; PG8_LOADRO(t4_, cur.pm); *PG8_ROS(0) = (u32x4){t4_[0], t4_[1], t4_[2], t4_[3]}; asm volatile("s_waitcnt lgkmcnt(0)" ::: "memory"); }
    const char* cA = (const char*)g.A + (GATHER ? (size_t)0 : (size_t)((unsigned)cur.pm * tstepA)); const char* cB = (const char*)g.Bt + (size_t)((unsigned)cur.e * g.bes + (unsigned)cur.pn * tstepB);
    PG8_STAGE(PG8_SB(0, 0), cB, voffB); PG8_STAGE(PG8_SB(0, 1), cB + hstepB, voffB); PG8_STAGE_A(0, 0, cA, ropar); PG8_STAGE_A(0, 1, cA, ropar);
    if (wr == 1) PG8_BAR;
    PG8_WAIT_V(2); PG8_BAR;
    PG8_STAGE(PG8_SB(1, 0), cB + kstep, voffB); PG8_STAGE_A(1, 0, cA + kstep, ropar); PG8_STAGE(PG8_SB(1, 1), cB + hstepB + kstep, voffB);
    PG8_WAIT_V(6); PG8_BAR;
    for (;;) {
        const bool has_next = S.next(ui + 1, nxt);
        if constexpr (GATHER) { u32x4 n4_ = *PG8_ROS(ropar); if (has_next) { unsigned t4_[4]; PG8_LOADRO(t4_, nxt.pm); n4_ = (u32x4){t4_[0], t4_[1], t4_[2], t4_[3]}; } *PG8_ROS(ropar ^ 1) = n4_; }
        const char* nA = (has_next && !GATHER) ? (const char*)g.A + (size_t)((unsigned)nxt.pm * tstepA) : (GATHER ? (const char*)g.A : cA); const char* nB = has_next ? (const char*)g.Bt + (size_t)((unsigned)nxt.e * g.bes + (unsigned)nxt.pn * tstepB) : cB;
        int t = 0;
        do {
            const bool last = (t == nt - 2);
            const char* a1 = cA + (unsigned)(t + 1) * kstep;
            const char* a2 = last ? nA : cA + (unsigned)(t + 2) * kstep; const char* b2 = last ? nB : cB + (unsigned)(t + 2) * kstep;
            const char* a3 = a2 + kstep; const char* b3 = b2 + kstep;
            if constexpr (Epi::HAS_MID) { if (t == Epi::MID0 || t == Epi::MID1) E.mid(acc, cur, t, wr, wc, fr, fq); }
            int rl = t; asm volatile("" : "+s"(rl)); rl = (rl == 0) & uf_;
            PG8_LDB(B0, 0, 0); PG8_LDB(B1, 0, 1); PG8_SCHED; PG8_LDA(At, 0, 0); PG8_STAGE_A(1, 1, a1, ropar);
            PG8_WAIT_VR(rl);
            PG8_WAIT_L(0); PG8_BAR; PG8_MMA(0, 0, At, B0); PG8_MMA(0, 1, At, B1); PG8_BAR; PG8_SCHED;
            PG8_LDA(At, 0, 1); PG8_STAGE(PG8_SB(0, 0), b2, voffB); PG8_STAGE(PG8_SB(0, 1), b2 + hstepB, voffB); PG8_STAGE_A2(0, 0, a2);
            PG8_WAIT_VR(rl);
            PG8_WAIT_L(0); PG8_BAR; PG8_MMA(1, 0, At, B0); PG8_MMA(1, 1, At, B1); PG8_BAR; PG8_SCHED;
            PG8_LDB(B0, 1, 0); PG8_LDB(B1, 1, 1); PG8_SCHED; PG8_LDA(At, 1, 0); PG8_STAGE_A2(0, 1, a2);
            PG8_WAIT_V(8); PG8_WAIT_L(0); PG8_BAR; PG8_MMA(0, 0, At, B0); PG8_MMA(0, 1, At, B1); PG8_BAR; PG8_SCHED;
            PG8_LDA(At, 1, 1); PG8_STAGE(PG8_SB(1, 0), b3, voffB); PG8_STAGE(PG8_SB(1, 1), b3 + hstepB, voffB); PG8_STAGE_A2(1, 0, a3);
            PG8_WAIT_V(8); PG8_WAIT_L(0); PG8_BAR; PG8_MMA(1, 0, At, B0); PG8_MMA(1, 1, At, B1); PG8_BAR; PG8_SCHED;
            t += 2;
        } while (t < nt);
        if constexpr (ALIGN_EPI) { if (wr == 0) PG8_BAR; }
        E(acc, cur, wr, wc, fr, fq);
        if (!has_next) break;
#pragma unroll
        for (int a = 0; a < 2; ++a)
#pragma unroll
            for (int b = 0; b < 2; ++b)
#pragma unroll
                for (int m = 0; m < 4; ++m)
#pragma unroll
                    for (int n = 0; n < 2; ++n) acc[a][b][m][n] = (f32x4){0.f, 0.f, 0.f, 0.f};
        cur = nxt; cA = nA; cB = nB; ++ui;
        if constexpr (GATHER) ropar ^= 1; else uf_ = 1;
        if constexpr (ALIGN_EPI) { if (wr == 1) PG8_BAR; }
    }
    PG8_WAIT_V(0); __builtin_amdgcn_s_waitcnt(0x0F70);
    if constexpr (!ALIGN_EPI) { if (wr == 0) PG8_BAR; }
    PG8_BAR;
#undef PG8_SA
#undef PG8_SB
#undef PG8_STAGE
#undef PG8_STAGE_A
#undef PG8_STAGE_A2
#undef PG8_LOADRO
#undef PG8_ROS
#undef PG8_STAGE_
#undef PG8_LDA
#undef PG8_LDB
#undef PG8_MMA
#undef PG8_WAIT_V
#undef PG8_WAIT_VR
#undef PG8_WAIT_L
#undef PG8_BAR
#undef PG8_SCHED
}

template <int MODE> struct EpiBf16 {
    static constexpr bool PERM = true, HAS_MID = false; static constexpr int MID0 = -1, MID1 = -1, NST = 16;
    bf16_t* O; int ldc; const float* rs; bf16_t* O2; int ldc2;
    __device__ __forceinline__ void operator()(const Acc& acc, const Unit& u, int wr, int wc, int fr, int fq) const {
        asm volatile("" : "+v"(fr), "+v"(fq));
        const int row0 = u.pm * BM + wr * 64 + fr;
        float sv[2][4];
#pragma unroll
        for (int ai = 0; ai < 2; ++ai)
#pragma unroll
            for (int m = 0; m < 4; ++m) sv[ai][m] = rs ? rs[row0 + ai * HALF + m * 16] : 1.0f;
        if (rs) asm volatile("s_waitcnt vmcnt(0)" : "+v"(sv[0][0]), "+v"(sv[0][1]), "+v"(sv[0][2]), "+v"(sv[0][3]), "+v"(sv[1][0]), "+v"(sv[1][1]), "+v"(sv[1][2]), "+v"(sv[1][3]) :: "memory");
#pragma unroll
        for (int ai = 0; ai < 2; ++ai)
#pragma unroll
            for (int m = 0; m < 4; ++m) { const int row = row0 + ai * HALF + m * 16; const float s = sv[ai][m];
#pragma unroll
                for (int bj = 0; bj < 2; ++bj) { const int col = u.pn * BM + bj * HALF + wc * 32 + 8 * fq;
                    const f32x4 v0 = acc[ai][bj][m][0] * s, v1 = acc[ai][bj][m][1] * s;
                    u32x4 w; w.x = cvt_pk_bf16(v0[0], v0[1]); w.y = cvt_pk_bf16(v0[2], v0[3]); w.z = cvt_pk_bf16(v1[0], v1[1]); w.w = cvt_pk_bf16(v1[2], v1[3]);
                    bf16_t* dst;
                    if (MODE == 0) dst = O + (size_t)row * ldc + col;
                    else { const int head = u.pn * 2 + bj; dst = (wc < 2) ? O + (size_t)row * 768 + head * 96 + wc * 32 + 8 * fq : O2 + (size_t)row * 512 + head * 64 + (wc - 2) * 32 + 8 * fq; }
                    *(u32x4*)dst = w; } }
    }
};
struct EpiGU {
    static constexpr bool PERM = true, HAS_MID = false; static constexpr int MID0 = -1, MID1 = -1, NST = 8;
    bf16_t* O;
    __device__ __forceinline__ void operator()(const Acc& acc, const Unit& u, int wr, int wc, int fr, int fq) const {
        asm volatile("" : "+v"(fr), "+v"(fq));
        const int row0 = u.pm * BM + wr * 64 + fr; const int col = u.pn * 128 + wc * 32 + 8 * fq;
#pragma unroll
        for (int ai = 0; ai < 2; ++ai)
#pragma unroll
            for (int m = 0; m < 4; ++m) { const int row = row0 + ai * HALF + m * 16;
                float h[8];
#pragma unroll
                for (int n = 0; n < 2; ++n)
#pragma unroll
                    for (int j = 0; j < 4; ++j) { const float gv = acc[ai][0][m][n][j], uv = acc[ai][1][m][n][j]; h[n * 4 + j] = siluf_(gv) * uv; }
                u32x4 w; w.x = cvt_pk_bf16(h[0], h[1]); w.y = cvt_pk_bf16(h[2], h[3]); w.z = cvt_pk_bf16(h[4], h[5]); w.w = cvt_pk_bf16(h[6], h[7]);
                *(u32x4*)(O + (size_t)row * EFF + col) = w; }
    }
};
struct EpiMerge {
    static constexpr float GLZ = 43.28085f;
    static constexpr bool PERM = true, HAS_MID = true; static constexpr int MID0 = 8, MID1 = 16, NST = 16;
    const bf16_t* Z; bf16_t* O;
    __device__ __forceinline__ void mid(Acc& acc, const Unit& u, int t, int wr, int wc, int fr, int fq) const {
        asm volatile("" : "+v"(fr), "+v"(fq));
        const int gi = (t == 8) ? 0 : 1; const int row0 = u.pm * BM + wr * 64 + fr;
#pragma unroll
        for (int ai = 0; ai < 2; ++ai) {
            u32x4 ga[4][2], gb[4][2];
#pragma unroll
            for (int m = 0; m < 4; ++m)
#pragma unroll
                for (int bj = 0; bj < 2; ++bj) { const int row = row0 + ai * HALF + m * 16, col = u.pn * BM + bj * HALF + wc * 32 + 8 * fq;
                    const bf16_t* p = Z + (size_t)row * ZLD + ZC_GL + gi * 1024 + col; ga[m][bj] = *(const u32x4*)p; gb[m][bj] = *(const u32x4*)(p + 1024); }
#pragma unroll
            for (int m = 0; m < 4; ++m)
#pragma unroll
                for (int bj = 0; bj < 2; ++bj) { float r[8];
#pragma unroll
                    for (int j = 0; j < 4; ++j) { const unsigned wa = ga[m][bj][j], wb = gb[m][bj][j];
                        const float a0 = __builtin_amdgcn_fmed3f(bflo(wa), -GLZ, GLZ), a1 = __builtin_amdgcn_fmed3f(bfhi(wa), -GLZ, GLZ), b0 = __builtin_amdgcn_fmed3f(bflo(wb), -GLZ, GLZ), b1 = __builtin_amdgcn_fmed3f(bfhi(wb), -GLZ, GLZ);
                        r[2 * j] = (1.0f + __builtin_amdgcn_exp2f(b0)) * __builtin_amdgcn_rcpf(1.0f + __builtin_amdgcn_exp2f(a0)); r[2 * j + 1] = (1.0f + __builtin_amdgcn_exp2f(b1)) * __builtin_amdgcn_rcpf(1.0f + __builtin_amdgcn_exp2f(a1)); }
                    acc[ai][bj][m][0] = acc[ai][bj][m][0] * (f32x4){r[0], r[1], r[2], r[3]}; acc[ai][bj][m][1] = acc[ai][bj][m][1] * (f32x4){r[4], r[5], r[6], r[7]}; }
            asm volatile("" : "+v"(acc[ai][0][0][0]), "+v"(acc[ai][1][3][1]) :: "memory");
        }
    }
    __device__ __forceinline__ void operator()(const Acc& acc, const Unit& u, int wr, int wc, int fr, int fq) const {
        asm volatile("" : "+v"(fr), "+v"(fq));
        const int row0 = u.pm * BM + wr * 64 + fr;
#pragma unroll
        for (int ai = 0; ai < 2; ++ai) { u32x4 gcv[4][2];
#pragma unroll
            for (int m = 0; m < 4; ++m)
#pragma unroll
                for (int bj = 0; bj < 2; ++bj) gcv[m][bj] = *(const u32x4*)(Z + (size_t)(row0 + ai * HALF + m * 16) * ZLD + ZC_GL + 2048 + u.pn * BM + bj * HALF + wc * 32 + 8 * fq);
            asm volatile("s_waitcnt vmcnt(0)" : "+v"(gcv[0][0]), "+v"(gcv[0][1]), "+v"(gcv[1][0]), "+v"(gcv[1][1]), "+v"(gcv[2][0]), "+v"(gcv[2][1]), "+v"(gcv[3][0]), "+v"(gcv[3][1]) :: "memory");
#pragma unroll
            for (int m = 0; m < 4; ++m) { const int row = row0 + ai * HALF + m * 16;
#pragma unroll
                for (int bj = 0; bj < 2; ++bj) { const int col = u.pn * BM + bj * HALF + wc * 32 + 8 * fq;
                    const u32x4 gc = gcv[m][bj];
                    float r[8];
#pragma unroll
                    for (int j = 0; j < 4; ++j) { const unsigned w = gc[j]; r[2 * j] = __builtin_amdgcn_rcpf(1.0f + __builtin_amdgcn_exp2f(__builtin_amdgcn_fmed3f(bflo(w), -GLZ, GLZ))); r[2 * j + 1] = __builtin_amdgcn_rcpf(1.0f + __builtin_amdgcn_exp2f(__builtin_amdgcn_fmed3f(bfhi(w), -GLZ, GLZ))); }
                    const f32x4 v0 = acc[ai][bj][m][0] * (f32x4){r[0], r[1], r[2], r[3]}, v1 = acc[ai][bj][m][1] * (f32x4){r[4], r[5], r[6], r[7]};
                    u32x4 w; w.x = cvt_pk_bf16(v0[0], v0[1]); w.y = cvt_pk_bf16(v0[2], v0[3]); w.z = cvt_pk_bf16(v1[0], v1[1]); w.w = cvt_pk_bf16(v1[2], v1[3]);
                    *(u32x4*)(O + (size_t)row * DM + col) = w; } } }
    }
};
struct EpiResid {
    static constexpr bool PERM = true, HAS_MID = false; static constexpr int MID0 = -1, MID1 = -1, NST = 16;
    const float* xold32; const bf16_t* xold16; bf16_t* xnew; const float* gate;
    template <bool F32> __device__ __forceinline__ void run(const Acc& acc, const Unit& u, int wr, int wc, int fr, int fq) const {
        const int row0 = u.pm * BM + wr * 64 + fr; const float* gt = gate + (size_t)((u.pm * BM) / SEQ) * 6144;
#pragma unroll
        for (int bj = 0; bj < 2; ++bj) { const int col = u.pn * BM + bj * HALF + wc * 32 + 8 * fq; const f32x4 g0 = *(const f32x4*)(gt + col), g1 = *(const f32x4*)(gt + col + 4);
            if constexpr (F32) {
#pragma unroll
                for (int ai = 0; ai < 2; ++ai) { f32x4 x0[4], x1[4];
#pragma unroll
                    for (int m = 0; m < 4; ++m) { const size_t off = (size_t)(row0 + ai * HALF + m * 16) * DM + col; x0[m] = *(const f32x4*)(xold32 + off); x1[m] = *(const f32x4*)(xold32 + off + 4); }
                    asm volatile("s_waitcnt vmcnt(0)" : "+v"(x0[0]), "+v"(x1[0]), "+v"(x0[1]), "+v"(x1[1]), "+v"(x0[2]), "+v"(x1[2]), "+v"(x0[3]), "+v"(x1[3]) :: "memory");
#pragma unroll
                    for (int m = 0; m < 4; ++m) { const size_t off = (size_t)(row0 + ai * HALF + m * 16) * DM + col;
                        const f32x4 y0 = x0[m] + g0 * acc[ai][bj][m][0], y1 = x1[m] + g1 * acc[ai][bj][m][1];
                        u32x4 w; w.x = cvt_pk_bf16(y0[0], y0[1]); w.y = cvt_pk_bf16(y0[2], y0[3]); w.z = cvt_pk_bf16(y1[0], y1[1]); w.w = cvt_pk_bf16(y1[2], y1[3]);
                        *(u32x4*)(xnew + off) = w; } }
            } else { u32x4 r[2][4];
#pragma unroll
                for (int ai = 0; ai < 2; ++ai)
#pragma unroll
                    for (int m = 0; m < 4; ++m) r[ai][m] = *(const u32x4*)(xold16 + (size_t)(row0 + ai * HALF + m * 16) * DM + col);
                asm volatile("s_waitcnt vmcnt(0)" : "+v"(r[0][0]), "+v"(r[0][1]), "+v"(r[0][2]), "+v"(r[0][3]), "+v"(r[1][0]), "+v"(r[1][1]), "+v"(r[1][2]), "+v"(r[1][3]) :: "memory");
#pragma unroll
                for (int ai = 0; ai < 2; ++ai)
#pragma unroll
                    for (int m = 0; m < 4; ++m) { const size_t off = (size_t)(row0 + ai * HALF + m * 16) * DM + col; const u32x4 q = r[ai][m];
                        const f32x4 x0 = (f32x4){bflo(q.x), bfhi(q.x), bflo(q.y), bfhi(q.y)}, x1 = (f32x4){bflo(q.z), bfhi(q.z), bflo(q.w), bfhi(q.w)};
                        const f32x4 y0 = x0 + g0 * acc[ai][bj][m][0], y1 = x1 + g1 * acc[ai][bj][m][1];
                        u32x4 w; w.x = cvt_pk_bf16(y0[0], y0[1]); w.y = cvt_pk_bf16(y0[2], y0[3]); w.z = cvt_pk_bf16(y1[0], y1[1]); w.w = cvt_pk_bf16(y1[2], y1[3]);
                        *(u32x4*)(xnew + off) = w; } } }
    }
    __device__ __forceinline__ void operator()(const Acc& acc, const Unit& u, int wr, int wc, int fr, int fq) const {
        asm volatile("" : "+v"(fr), "+v"(fq));
        if (xold32) run<true>(acc, u, wr, wc, fr, fq); else run<false>(acc, u, wr, wc, fr, fq);
    }
};
}

#define XB_TMO      128
#define XB_XCNT(j)  (256  + 64 * (j))
#define XB_XSUB(j)  (1280 + 64 * (j))
#define XB_XGEN(j)  (2304 + 64 * (j))
#define XB_TOP      3328
#define XB_TOPGEN   3392
#define XCD_BAR_WORDS 3456
#define XB_SPIN_CAP (1u << 22)

__device__ __forceinline__ unsigned xb_ld(unsigned* p)              { return __hip_atomic_load(p, __ATOMIC_RELAXED, __HIP_MEMORY_SCOPE_AGENT); }
__device__ __forceinline__ unsigned xb_add(unsigned* p, unsigned v) { return __hip_atomic_fetch_add(p, v, __ATOMIC_RELAXED, __HIP_MEMORY_SCOPE_AGENT); }
__device__ __forceinline__ unsigned xb_xcc_id() { return (unsigned)__builtin_amdgcn_s_getreg((3 << 11) | 20) & 0xFu; }
#define XB_SPIN(cond, bar) do { unsigned _sp = 0; while (cond) { __builtin_amdgcn_s_sleep(1); \
    if ((++_sp & 255u) == 0u) { if (xb_ld(&(bar)[XB_TMO])) break; if (_sp > XB_SPIN_CAP) { atomicAdd(&(bar)[XB_TMO], 1u); break; } } } } while (0)

struct XcdBarrier { unsigned* bar; unsigned x; volatile LAS unsigned* st; };

__device__ __forceinline__ XcdBarrier xcd_barrier_post(unsigned* bar, volatile LAS unsigned* st) {
    XcdBarrier b; b.bar = bar; b.x = xb_xcc_id(); b.st = st;
    if (threadIdx.x == 0) (void)xb_add(&bar[XB_XCNT(b.x)], 1u);
    return b;
}
__device__ __forceinline__ void xcd_barrier_complete(unsigned* bar, unsigned x, unsigned& nloc, unsigned& nx) {
    const unsigned G = gridDim.x * gridDim.y * gridDim.z;
    unsigned sum, cnt, mine, sp = 0u;
    for (;;) {
        sum = 0u; cnt = 0u; mine = 0u;
#pragma unroll
        for (unsigned j = 0; j < 16; ++j) { const unsigned c = xb_ld(&bar[XB_XCNT(j)]); sum += c; cnt += (c > 0u) ? 1u : 0u; mine = (j == x) ? c : mine; }
        if (sum == G) break;
        __builtin_amdgcn_s_sleep(1);
        if ((++sp & 255u) == 0u) { if (xb_ld(&bar[XB_TMO])) break; if (sp > XB_SPIN_CAP) { atomicAdd(&bar[XB_TMO], 1u); break; } }
    }
    nloc = mine > 0u ? mine : 1u; nx = cnt > 0u ? cnt : 1u;
}
__device__ __forceinline__ void xcd_barrier(const XcdBarrier& b) {
    asm volatile("s_waitcnt vmcnt(0)" ::: "memory");
    __syncthreads();
    if (threadIdx.x == 0) {
        unsigned* bar = b.bar;
        __builtin_amdgcn_s_waitcnt(0);
        unsigned nloc = b.st[0], nx = b.st[1];
        if (nloc == 0u) { xcd_barrier_complete(bar, b.x, nloc, nx); b.st[0] = nloc; b.st[1] = nx; }
        const unsigned old = xb_add(&bar[XB_XSUB(b.x)], 1u);
        const unsigned gen = old / nloc;
        if (old + 1u == (gen + 1u) * nloc) {
            __builtin_amdgcn_fence(__ATOMIC_RELEASE, "agent");
            asm volatile("s_waitcnt vmcnt(0)" ::: "memory");
            const unsigned og = xb_add(&bar[XB_TOP], 1u);
            const unsigned tg = og / nx;
            if (og + 1u == (tg + 1u) * nx) xb_add(&bar[XB_TOPGEN], 1u);
            else XB_SPIN(xb_ld(&bar[XB_TOPGEN]) == tg, bar);
            __builtin_amdgcn_fence(__ATOMIC_ACQUIRE, "agent");
            xb_add(&bar[XB_XGEN(b.x)], 1u);
            asm volatile("s_waitcnt vmcnt(0)" ::: "memory");
        } else {
            XB_SPIN(xb_ld(&bar[XB_XGEN(b.x)]) == gen, bar);
            __builtin_amdgcn_fence(__ATOMIC_ACQUIRE, "agent");
            asm volatile("s_waitcnt vmcnt(0)" ::: "memory");
        }
    }
    __syncthreads();
}

namespace att {
constexpr int KSL = 12288, VSL = 8192, KS0 = 0, VS0 = 3 * KSL, WSF = VS0 + 3 * VSL, OST = WSF + 2048, LDS_NEED = OST + 8 * 4096;
constexpr float QSCALE = 0.10206207261596575f * 1.4426950408889634f;
__device__ __forceinline__ int crow(int r, int hi) { return (r & 3) + 8 * (r >> 2) + 4 * hi; }
#define MFMA32(a, b, c) __builtin_amdgcn_mfma_f32_32x32x16_bf16((a), (b), (c), 0, 0, 0)

__device__ __forceinline__ void pv(f32x16* o, int vb, bf16x8 pa0, bf16x8 pa1, bf16x8 pa2, bf16x8 pa3) {
    { const bf16x8 ones = {0x3F80, 0x3F80, 0x3F80, 0x3F80, 0x3F80, 0x3F80, 0x3F80, 0x3F80};
      o[2] = MFMA32(pa0, ones, o[2]); o[2] = MFMA32(pa1, ones, o[2]); o[2] = MFMA32(pa2, ones, o[2]); o[2] = MFMA32(pa3, ones, o[2]); }
#pragma unroll
    for (int d0 = 0; d0 < 2; ++d0) { s16x4 lo[4], hi[4];
#pragma unroll
        for (int ks = 0; ks < 4; ++ks) {
            asm volatile("ds_read_b64_tr_b16 %0,%1 offset:%c2" : "=&v"(lo[ks]) : "v"(vb), "i"(d0 * 4096 + ks * 1024) : "memory");
            asm volatile("ds_read_b64_tr_b16 %0,%1 offset:%c2" : "=&v"(hi[ks]) : "v"(vb), "i"(d0 * 4096 + ks * 1024 + 512) : "memory"); }
        asm volatile("s_waitcnt lgkmcnt(0)" ::: "memory"); __builtin_amdgcn_sched_barrier(0);
#define PK(k) (bf16x8){lo[k][0], lo[k][1], lo[k][2], lo[k][3], hi[k][0], hi[k][1], hi[k][2], hi[k][3]}
        o[d0] = MFMA32(pa0, PK(0), o[d0]); o[d0] = MFMA32(pa1, PK(1), o[d0]); o[d0] = MFMA32(pa2, PK(2), o[d0]); o[d0] = MFMA32(pa3, PK(3), o[d0]);
#undef PK
    }
}

template <int THR> __device__ __forceinline__ void attn_unit(int bl, int h, int qb, const bf16_t* Q, const bf16_t* __restrict__ K, const bf16_t* __restrict__ KR, const bf16_t* __restrict__ V, bf16_t* O,
                                          const float* cosM, const float* sinM, int tokbase, LAS char* shm) {
    int tid_ = threadIdx.x; asm volatile("" : "+v"(tid_));
    const int tid = tid_, lane = tid & 63, r32 = lane & 31, hi = lane >> 5; const int wid = __builtin_amdgcn_readfirstlane(tid >> 6);
    const long rowbase = (long)bl * SEQ; const int q0 = qb * 256;
    const unsigned lds0 = (unsigned)(uintptr_t)shm;
    const unsigned shmS = (unsigned)__builtin_amdgcn_readfirstlane((int)lds0);
    LAS float* wsf = (LAS float*)(shm + WSF) + wid * 64;
    const long qrow = rowbase + q0 + wid * 32 + r32;
    const bf16_t* qp = Q + qrow * 768 + h * 96;
    bf16x8 qr[6];
#pragma unroll
    for (int d0 = 0; d0 < 4; ++d0) { const u32x4 raw = *(const u32x4*)(qp + d0 * 16 + hi * 8); u32x4 w;
#pragma unroll
        for (int j = 0; j < 4; ++j) w[j] = cvt_pk_bf16(bflo(raw[j]) * QSCALE, bfhi(raw[j]) * QSCALE);
        qr[d0] = __builtin_bit_cast(bf16x8, w); }
    { const u32x4 r1 = *(const u32x4*)(qp + 64 + hi * 8), r2 = *(const u32x4*)(qp + 80 + hi * 8);
      const float* cp = cosM + (size_t)(tokbase + qrow) * 16 + hi * 8; const float* sp = sinM + (size_t)(tokbase + qrow) * 16 + hi * 8;
      const f32x4 c0 = *(const f32x4*)cp, c1 = *(const f32x4*)(cp + 4), s0 = *(const f32x4*)sp, s1 = *(const f32x4*)(sp + 4);
      float cs[8] = {c0[0], c0[1], c0[2], c0[3], c1[0], c1[1], c1[2], c1[3]}, sn[8] = {s0[0], s0[1], s0[2], s0[3], s1[0], s1[1], s1[2], s1[3]};
      u32x4 w1, w2;
#pragma unroll
      for (int j = 0; j < 4; ++j) { const float a0 = bflo(r1[j]), a1 = bfhi(r1[j]), b0 = bflo(r2[j]), b1 = bfhi(r2[j]);
          w1[j] = cvt_pk_bf16((a0 * cs[2 * j] - b0 * sn[2 * j]) * QSCALE, (a1 * cs[2 * j + 1] - b1 * sn[2 * j + 1]) * QSCALE);
          w2[j] = cvt_pk_bf16((a0 * sn[2 * j] + b0 * cs[2 * j]) * QSCALE, (a1 * sn[2 * j + 1] + b1 * cs[2 * j + 1]) * QSCALE); }
      qr[4] = __builtin_bit_cast(bf16x8, w1); qr[5] = __builtin_bit_cast(bf16x8, w2); }
    const bf16_t* Kh = K + rowbase * 768 + h * 96; const bf16_t* Vh = V + rowbase * 512 + h * 64;
    const bf16_t* ksrcA = Kh + (long)lane * 768 + wid * 8;
    const bf16_t* ksrcB = KR + (rowbase + lane) * 32 + wid * 8;
    const bf16_t* vsrc = Vh + (long)(16 * (wid & 3) + (lane >> 2)) * 512 + (wid >> 2) * 32 + (lane & 3) * 8;
    const int NT = q0 / 64 + 4, tq = q0 / 64 + (wid >> 1);
#define ATT_DMA_K(t, kb_) do { __builtin_amdgcn_global_load_lds((const unsigned*)(ksrcA + (long)(t) * 64 * 768), (LAS unsigned*)(uintptr_t)(shmS + (unsigned)(kb_) + (unsigned)wid * 1024u), 16, 0, 0); \
        if (wid < 4) __builtin_amdgcn_global_load_lds((const unsigned*)(ksrcB + (long)(t) * 64 * 32), (LAS unsigned*)(uintptr_t)(shmS + (unsigned)(kb_) + (8u + (unsigned)wid) * 1024u), 16, 0, 0); } while (0)
#define ATT_DMA_V(t, vb_) __builtin_amdgcn_global_load_lds((const unsigned*)(vsrc + (long)(t) * 64 * 512), (LAS unsigned*)(uintptr_t)(shmS + (unsigned)(vb_) + (unsigned)wid * 1024u), 16, 0, 0)
#define ATT_QK(P0, P1, kb_, C) do { const LAS char* kbp = shm + (kb_) + hi * 1024 + r32 * 16; bf16x8 kf_[12]; \
        _Pragma("unroll") for (int d0 = 0; d0 < 6; ++d0) { kf_[2 * d0] = *(const LAS bf16x8*)(kbp + d0 * 2048); kf_[2 * d0 + 1] = *(const LAS bf16x8*)(kbp + d0 * 2048 + 512); } \
        __builtin_amdgcn_sched_barrier(0); \
        P0 = MFMA32(kf_[0], qr[0], C); P1 = MFMA32(kf_[1], qr[0], C); \
        _Pragma("unroll") for (int d0 = 1; d0 < 6; ++d0) { P0 = MFMA32(kf_[2 * d0], qr[d0], P0); P1 = MFMA32(kf_[2 * d0 + 1], qr[d0], P1); } } while (0)
#define ATT_VRD(lo, hi, vb, d0) do { _Pragma("unroll") for (int ks = 0; ks < 4; ++ks) { \
        asm volatile("ds_read_b64_tr_b16 %0,%1 offset:%c2" : "=&v"(lo[ks]) : "v"(vb), "i"((d0) * 4096 + ks * 1024) : "memory"); \
        asm volatile("ds_read_b64_tr_b16 %0,%1 offset:%c2" : "=&v"(hi[ks]) : "v"(vb), "i"((d0) * 4096 + ks * 1024 + 512) : "memory"); } } while (0)
#define ATT_PK(lo, hi, k) (bf16x8){lo[k][0], lo[k][1], lo[k][2], lo[k][3], hi[k][0], hi[k][1], hi[k][2], hi[k][3]}
#define ATT_MX3(a, b, c) vmax3_((a), (b), (c))
#define ATT_ROWMAX(P0, P1, out) do { float ma_ = ATT_MX3(P0[0], P0[1], P1[0]), mb_ = ATT_MX3(P0[2], P0[3], P1[1]); ma_ = ATT_MX3(ma_, P1[2], P1[3]); \
        _Pragma("unroll") for (int r = 4; r < 16; r += 4) { ma_ = ATT_MX3(ma_, P0[r], P0[r + 1]); mb_ = ATT_MX3(mb_, P0[r + 2], P0[r + 3]); ma_ = ATT_MX3(ma_, P1[r], P1[r + 1]); mb_ = ATT_MX3(mb_, P1[r + 2], P1[r + 3]); } \
        float mt_ = vmax2_(ma_, mb_); \
        auto rr_ = __builtin_amdgcn_permlane32_swap(__float_as_uint(mt_), __float_as_uint(mt_), false, false); out = vmax2_(__uint_as_float(rr_[0]), __uint_as_float(rr_[1])); } while (0)
    ATT_DMA_K(0, KS0); ATT_DMA_V(0, VS0); ATT_DMA_K(1, KS0 + KSL); ATT_DMA_K(2, KS0 + 2 * KSL); ATT_DMA_V(1, VS0 + VSL);
    __syncthreads();
    float mhat = 0.f; f32x16 o[3], negm; float ls[4] = {0.f, 0.f, 0.f, 0.f};
#pragma unroll
    for (int r = 0; r < 16; ++r) { o[0][r] = 0.f; o[1][r] = 0.f; o[2][r] = 0.f; negm[r] = 0.f; }
    const int vbl = (int)lds0 + ((lane >> 4) & 1) * 32 + (lane & 3) * 8 + (4 * hi + ((lane & 15) >> 2)) * 64;
    f32x16 sA0, sA1, sB0, sB1;
    ATT_QK(sA0, sA1, KS0, negm);
    { float rm; ATT_ROWMAX(sA0, sA1, rm); mhat = rm;
#pragma unroll
      for (int r = 0; r < 16; ++r) { sA0[r] -= rm; sA1[r] -= rm; negm[r] = -rm; } }
    __syncthreads();
    int k0 = KS0, k1 = KS0 + KSL, k2 = KS0 + 2 * KSL, v0 = VS0, v1 = VS0 + VSL, v2 = VS0 + 2 * VSL;
#define ATT_WAITBAR(n) asm volatile("s_waitcnt vmcnt(" #n ") lgkmcnt(0)\n\ts_barrier" ::: "memory")
#define ATT_EXPCVT(C0, C1, lo_, hi_) do { _Pragma("unroll") for (int e = (lo_); e < (hi_); e += 2) { \
            if (e < 16) { const float x0_ = __builtin_amdgcn_exp2f(C0[e & 15]), x1_ = __builtin_amdgcn_exp2f(C0[(e + 1) & 15]); C0[e & 15] = x0_; C0[(e + 1) & 15] = x1_; pw[e >> 3][(e & 7) >> 1] = cvt_pk_bf16(x0_, x1_); } \
            else { const float x0_ = __builtin_amdgcn_exp2f(C1[e & 15]), x1_ = __builtin_amdgcn_exp2f(C1[(e + 1) & 15]); C1[e & 15] = x0_; C1[(e + 1) & 15] = x1_; pw[e >> 3][(e & 7) >> 1] = cvt_pk_bf16(x0_, x1_); } } } while (0)
#define ATT_EXPV(x) ({ float r_; asm volatile("v_exp_f32 %0, %1" : "=v"(r_) : "v"(x)); r_; })
#define ATT_EXPCVTV(C0, C1, lo_, hi_) do { _Pragma("unroll") for (int e = (lo_); e < (hi_); e += 2) { \
            if (e < 16) { const float x0_ = ATT_EXPV(C0[e & 15]), x1_ = ATT_EXPV(C0[(e + 1) & 15]); pw[e >> 3][(e & 7) >> 1] = cvt_pk_bf16(x0_, x1_); ls[e & 2] += x0_; ls[(e & 2) + 1] += x1_; } \
            else { const float x0_ = ATT_EXPV(C1[e & 15]), x1_ = ATT_EXPV(C1[(e + 1) & 15]); pw[e >> 3][(e & 7) >> 1] = cvt_pk_bf16(x0_, x1_); ls[e & 2] += x0_; ls[(e & 2) + 1] += x1_; } } } while (0)
#define ATT_KRD(fa, fb, d0) do { asm volatile("ds_read_b128 %0, %1 offset:%c2" : "=&v"(fa) : "v"(kbp), "i"((d0) * 2048) : "memory"); asm volatile("ds_read_b128 %0, %1 offset:%c2" : "=&v"(fb) : "v"(kbp), "i"((d0) * 2048 + 512) : "memory"); } while (0)
#define ATT_LW(n, fa, fb) do { asm volatile("s_waitcnt lgkmcnt(" #n ")" : "+v"(fa), "+v"(fb) :: "memory"); __builtin_amdgcn_sched_barrier(0); } while (0)
#define ATT_STEP(t, CUR0, CUR1, NXT0, NXT1) do { \
        const bool dk_ = (t) + 3 < NT, dv_ = (t) + 2 < NT; \
        if (dk_) ATT_DMA_K((t) + 3, k0); \
        if (dv_) ATT_DMA_V((t) + 2, v2); \
        if ((t) <= tq) { \
            const LAS char* kbp = shm + k1 + hi * 1024 + r32 * 16; bf16x8 ka0, kb0, ka1, kb1, ka2, kb2; \
            const int vb_ = vbl + v0; s16x4 vl0[4], vh0[4], vl1[4], vh1[4]; \
            float rm; ATT_ROWMAX(CUR0, CUR1, rm); \
            if (__any(rm > (float)THR)) { const float dl = fmaxf(rm, 0.f); mhat += dl; const float f = __builtin_amdgcn_exp2f(-dl); \
                _Pragma("unroll") for (int r = 0; r < 16; ++r) { CUR0[r] -= dl; CUR1[r] -= dl; negm[r] = -mhat; }        \
                if (hi == 0) wsf[r32] = f; \
                _Pragma("unroll") for (int r = 0; r < 16; ++r) { const float a = wsf[crow(r, hi)]; o[0][r] *= a; o[1][r] *= a; } ls[0] *= f; ls[1] *= f; ls[2] *= f; ls[3] *= f; \
                asm volatile("s_waitcnt lgkmcnt(0)" ::: "memory"); } \
            u32x4 pw[4]; \
            {                                                      \
                ATT_KRD(ka0, kb0, 0); ATT_KRD(ka1, kb1, 1); ATT_KRD(ka2, kb2, 2); ATT_LW(4, ka0, kb0); \
                NXT0 = MFMA32(ka0, qr[0], negm); NXT1 = MFMA32(kb0, qr[0], negm); ATT_EXPCVTV(CUR0, CUR1, 0, 6); __builtin_amdgcn_sched_barrier(0); \
                ATT_KRD(ka0, kb0, 3); ATT_LW(4, ka1, kb1); \
                NXT0 = MFMA32(ka1, qr[1], NXT0); NXT1 = MFMA32(kb1, qr[1], NXT1); ATT_EXPCVTV(CUR0, CUR1, 6, 12); __builtin_amdgcn_sched_barrier(0); \
                ATT_KRD(ka1, kb1, 4); ATT_LW(4, ka2, kb2); \
                NXT0 = MFMA32(ka2, qr[2], NXT0); NXT1 = MFMA32(kb2, qr[2], NXT1); ATT_EXPCVTV(CUR0, CUR1, 12, 18); __builtin_amdgcn_sched_barrier(0); \
                ATT_KRD(ka2, kb2, 5); ATT_LW(4, ka0, kb0); \
                NXT0 = MFMA32(ka0, qr[3], NXT0); NXT1 = MFMA32(kb0, qr[3], NXT1); ATT_EXPCVTV(CUR0, CUR1, 18, 24); __builtin_amdgcn_sched_barrier(0); \
                ATT_VRD(vl0, vh0, vb_, 0); ATT_LW(10, ka1, kb1); \
                NXT0 = MFMA32(ka1, qr[4], NXT0); NXT1 = MFMA32(kb1, qr[4], NXT1); ATT_EXPCVTV(CUR0, CUR1, 24, 28); __builtin_amdgcn_sched_barrier(0); \
                ATT_LW(8, ka2, kb2); \
                NXT0 = MFMA32(ka2, qr[5], NXT0); NXT1 = MFMA32(kb2, qr[5], NXT1); ATT_EXPCVTV(CUR0, CUR1, 28, 32); __builtin_amdgcn_sched_barrier(0); \
            } \
            { const bf16x8 pa0 = __builtin_bit_cast(bf16x8, pw[0]), pa1 = __builtin_bit_cast(bf16x8, pw[1]), pa2 = __builtin_bit_cast(bf16x8, pw[2]), pa3 = __builtin_bit_cast(bf16x8, pw[3]); \
              ATT_VRD(vl1, vh1, vb_, 1); \
              asm volatile("s_waitcnt lgkmcnt(8)" : "+v"(vl0[0]), "+v"(vh0[0]), "+v"(vl0[1]), "+v"(vh0[1]), "+v"(vl0[2]), "+v"(vh0[2]), "+v"(vl0[3]), "+v"(vh0[3]) :: "memory"); __builtin_amdgcn_sched_barrier(0); \
              o[0] = MFMA32(pa0, ATT_PK(vl0, vh0, 0), o[0]); o[0] = MFMA32(pa1, ATT_PK(vl0, vh0, 1), o[0]); o[0] = MFMA32(pa2, ATT_PK(vl0, vh0, 2), o[0]); o[0] = MFMA32(pa3, ATT_PK(vl0, vh0, 3), o[0]); \
              asm volatile("s_waitcnt lgkmcnt(0)" : "+v"(vl1[0]), "+v"(vh1[0]), "+v"(vl1[1]), "+v"(vh1[1]), "+v"(vl1[2]), "+v"(vh1[2]), "+v"(vl1[3]), "+v"(vh1[3]) :: "memory"); __builtin_amdgcn_sched_barrier(0); \
              o[1] = MFMA32(pa0, ATT_PK(vl1, vh1, 0), o[1]); o[1] = MFMA32(pa1, ATT_PK(vl1, vh1, 1), o[1]); o[1] = MFMA32(pa2, ATT_PK(vl1, vh1, 2), o[1]); o[1] = MFMA32(pa3, ATT_PK(vl1, vh1, 3), o[1]); } } \
        if (dk_) { if (wid < 4) ATT_WAITBAR(3); else ATT_WAITBAR(2); } else ATT_WAITBAR(0); \
        { const int tk_ = k0; k0 = k1; k1 = k2; k2 = tk_; const int tv_ = v0; v0 = v1; v1 = v2; v2 = tv_; } } while (0)
#pragma unroll
    for (int r = 0; r < 16; ++r) { sB0[r] = 0.f; sB1[r] = 0.f; }
    for (int t = 0; t < NT; t += 2) {
        ATT_STEP(t, sA0, sA1, sB0, sB1);
        ATT_STEP(t + 1, sB0, sB1, sA0, sA1);
    }
#undef ATT_WAITBAR
#undef ATT_STEP
#undef ATT_EXPCVT
#undef ATT_EXPCVTV
#undef ATT_EXPV
#undef ATT_KRD
#undef ATT_LW
#undef ATT_DMA_K
#undef ATT_DMA_V
#undef ATT_QK
#undef ATT_ROWMAX
    float rli[16];
    { float lt = (ls[0] + ls[1]) + (ls[2] + ls[3]); auto rr_ = __builtin_amdgcn_permlane32_swap(__float_as_uint(lt), __float_as_uint(lt), false, false); lt = __uint_as_float(rr_[0]) + __uint_as_float(rr_[1]);
      if (hi == 0) wsf[r32] = __builtin_amdgcn_rcpf(lt); asm volatile("s_waitcnt lgkmcnt(0)" ::: "memory"); }
#pragma unroll
    for (int r = 0; r < 16; ++r) rli[r] = wsf[crow(r, hi)];
    bf16_t* Ow = O + (rowbase + q0 + wid * 32) * ACLD + h * 64;
    { LAS bf16_t* stg = (LAS bf16_t*)(shm + OST) + wid * 2048;
#pragma unroll
      for (int r = 0; r < 16; ++r) { const int orow = crow(r, hi);
#pragma unroll
          for (int d0 = 0; d0 < 2; ++d0) stg[orow * 64 + d0 * 32 + r32] = (bf16_t)f2bf(o[d0][r] * rli[r]); }
#pragma unroll
      for (int i = 0; i < 4; ++i) { const int row = i * 8 + (lane >> 3), ch = lane & 7; const u32x4 v = *(const LAS u32x4*)(stg + row * 64 + ch * 8); *(u32x4*)(Ow + (long)row * ACLD + ch * 8) = v; } }
    __syncthreads();
    __builtin_amdgcn_s_waitcnt(0x0F70);
}
}

namespace ret {
typedef short v4i16_t __attribute__((ext_vector_type(4)));
#define MFMA16(a, b, c) __builtin_amdgcn_mfma_f32_16x16x32_bf16((a), (b), (c), 0, 0, 0)
__device__ __forceinline__ bf16x8 tr16(const LAS char* base, int rs, int k0, int x0, int lane) {
    const int g = lane >> 4, i = lane & 15, q = i >> 2, p = i & 3;
    const LAS char* a = base + (k0 + 8 * g + q) * rs + (x0 + 4 * p) * 2;
    const s16x4 lo = __builtin_bit_cast(s16x4, __builtin_amdgcn_ds_read_tr16_b64_v4i16((LAS v4i16_t*)a));
    const s16x4 hi = __builtin_bit_cast(s16x4, __builtin_amdgcn_ds_read_tr16_b64_v4i16((LAS v4i16_t*)(a + 4 * rs)));
    return (bf16x8){lo[0], lo[1], lo[2], lo[3], hi[0], hi[1], hi[2], hi[3]};
}
constexpr int QI = 0, KI = 17408, VI = 34816, PI = 68608, O32 = 81920;
__device__ __forceinline__ float lg2gamma(int h) { return __builtin_amdgcn_logf(1.0f - __builtin_amdgcn_exp2f(-5.0f - (float)h)); }

constexpr int KVO = 69632;
__device__ __forceinline__ void kvloc_phase(int first, int stride, const bf16_t* Z, bf16_t* RS, LAS char* lds) {
    int tid_ = threadIdx.x; asm volatile("" : "+v"(tid_));
    const int tid = tid_, lane = tid & 63, wid = __builtin_amdgcn_readfirstlane(tid >> 6), g = lane >> 4, i16 = lane & 15;
    if (first >= 1024) return;
    u32x4 kr[2], vr[4];
#define KVL_LOAD(it_) do { const int u_ = (it_) >> 7, n_ = (it_) & 127, bl_ = u_ >> 2, h_ = u_ & 3; const long r0_ = (long)bl_ * SEQ + (long)n_ * 64; \
        _Pragma("unroll") for (int i = 0; i < 2; ++i) { const int p = tid + 512 * i, row = p >> 4, ch = p & 15; kr[i] = *(const u32x4*)(Z + (size_t)(r0_ + row) * ZLD + ZC_RK + h_ * 128 + ch * 8); } \
        _Pragma("unroll") for (int i = 0; i < 4; ++i) { const int p = tid + 512 * i, row = p >> 5, ch = p & 31; vr[i] = *(const u32x4*)(Z + (size_t)(r0_ + row) * ZLD + ZC_RV + h_ * 256 + ch * 8); } } while (0)
    KVL_LOAD(first);
    for (int it = first; it < 1024; it += stride) {
        const int u = it >> 7, n = it & 127, h = u & 3; const float lg = lg2gamma(h);
#pragma unroll
        for (int i = 0; i < 2; ++i) { const int p = tid + 512 * i, row = p >> 4, ch = p & 15; const float sc = __builtin_amdgcn_exp2f(lg * (float)(63 - row)); u32x4 w;
#pragma unroll
            for (int j = 0; j < 4; ++j) w[j] = cvt_pk_bf16(bflo(kr[i][j]) * sc, bfhi(kr[i][j]) * sc);
            *(LAS u32x4*)(lds + KI + row * 272 + ch * 16) = w; }
#pragma unroll
        for (int i = 0; i < 4; ++i) { const int p = tid + 512 * i, row = p >> 5, ch = p & 31; *(LAS u32x4*)(lds + VI + row * 528 + ch * 16) = vr[i]; }
        __syncthreads();
        if (it + stride < 1024) KVL_LOAD(it + stride);
        bf16x8 bfr[2][2];
#pragma unroll
        for (int n2 = 0; n2 < 2; ++n2)
#pragma unroll
            for (int ks = 0; ks < 2; ++ks) bfr[n2][ks] = tr16(lds + VI, 528, 32 * ks, 32 * wid + 16 * n2, lane);
#pragma unroll 2
        for (int mi = 0; mi < 8; ++mi) { const bf16x8 a0 = tr16(lds + KI, 272, 0, 16 * mi, lane), a1 = tr16(lds + KI, 272, 32, 16 * mi, lane);
#pragma unroll
            for (int n2 = 0; n2 < 2; ++n2) { f32x4 acc = {0.f, 0.f, 0.f, 0.f}; acc = MFMA16(a0, bfr[n2][0], acc); acc = MFMA16(a1, bfr[n2][1], acc);
                const int c = 32 * wid + 16 * n2 + i16, d = 16 * mi + 4 * g; u32x2 w; w.x = cvt_pk_bf16(acc[0], acc[1]); w.y = cvt_pk_bf16(acc[2], acc[3]);
                *(LAS u32x2*)(lds + KVO + c * 272 + d * 2) = w; } }
        __syncthreads();
        u32x4* dst = (u32x4*)(RS + (size_t)(u * 128 + n) * 32768);
#pragma unroll
        for (int i = 0; i < 8; ++i) { const int p = tid + 512 * i, row = p >> 4, ch = p & 15; dst[p] = *(const LAS u32x4*)(lds + KVO + row * 272 + ch * 16); }
    }
    __syncthreads();
#undef KVL_LOAD
}

__device__ __forceinline__ void scan_all(bf16_t* RS, int gtid, int gthreads) {
    for (int idx = gtid; idx < 8 * 16384; idx += gthreads) {
        const int u = idx >> 14, e2 = idx & 16383, h = u & 3; const float cd = __builtin_amdgcn_exp2f(lg2gamma(h) * 64.0f);
        unsigned* p = (unsigned*)(RS + (size_t)u * 128 * 32768) + e2;
        float s0 = 0.f, s1 = 0.f; unsigned v[8], vn[8];
#pragma unroll
        for (int k = 0; k < 8; ++k) vn[k] = p[(size_t)k * 16384];
        for (int n = 0; n < 128; n += 8) {
#pragma unroll
            for (int k = 0; k < 8; ++k) v[k] = vn[k];
            if (n + 8 < 128) {
#pragma unroll
                for (int k = 0; k < 8; ++k) vn[k] = p[(size_t)(n + 8 + k) * 16384]; }
#pragma unroll
            for (int k = 0; k < 8; ++k) { const unsigned w = cvt_pk_bf16(s0, s1); s0 = s0 * cd + bflo(v[k]); s1 = s1 * cd + bfhi(v[k]); p[(size_t)(n + k) * 16384] = w; } }
    }
}

__device__ __forceinline__ void out_phase(int first, int stride, const bf16_t* Z, const bf16_t* RS, bf16_t* AC, LAS char* lds) {
    int tid_ = threadIdx.x; asm volatile("" : "+v"(tid_));
    const int tid = tid_, lane = tid & 63, wid = __builtin_amdgcn_readfirstlane(tid >> 6), g = lane >> 4, i16 = lane & 15;
    if (first >= 1024) return;
    u32x4 qr_[2], kr_[2], vr_[4]; bf16x8 sfr[2][4];
#define RO_LOAD_S(it_) do { const int u_ = (it_) >> 7, n_ = (it_) & 127; const bf16_t* sp = RS + (size_t)(u_ * 128 + n_) * 32768; \
        _Pragma("unroll") for (int n2 = 0; n2 < 2; ++n2) _Pragma("unroll") for (int ks = 0; ks < 4; ++ks) sfr[n2][ks] = *(const bf16x8*)(sp + (32 * wid + 16 * n2 + i16) * 128 + 32 * ks + 8 * g); } while (0)
#define RO_LOAD(it_) do { const int u_ = (it_) >> 7, n_ = (it_) & 127, bl_ = u_ >> 2, h_ = u_ & 3; const long r0_ = (long)bl_ * SEQ + (long)n_ * 64; \
        _Pragma("unroll") for (int i = 0; i < 2; ++i) { const int p = tid + 512 * i, row = p >> 4, ch = p & 15; const bf16_t* zr = Z + (size_t)(r0_ + row) * ZLD + h_ * 128 + ch * 8; \
            qr_[i] = *(const u32x4*)(zr + ZC_RQ); kr_[i] = *(const u32x4*)(zr + ZC_RK); } \
        _Pragma("unroll") for (int i = 0; i < 4; ++i) { const int p = tid + 512 * i, row = p >> 5, ch = p & 31; vr_[i] = *(const u32x4*)(Z + (size_t)(r0_ + row) * ZLD + ZC_RV + h_ * 256 + ch * 8); } } while (0)
    RO_LOAD_S(first);
    RO_LOAD(first);
    for (int it = first; it < 1024; it += stride) {
        const int u = it >> 7, n = it & 127, bl = u >> 2, h = u & 3; const long row0 = (long)bl * SEQ + (long)n * 64; const float lg = lg2gamma(h);
        u32x2 gr[8];
#pragma unroll
        for (int i = 0; i < 2; ++i) { const int p = tid + 512 * i, row = p >> 4, ch = p & 15;
            *(LAS u32x4*)(lds + QI + row * 272 + ch * 16) = qr_[i]; *(LAS u32x4*)(lds + KI + row * 272 + ch * 16) = kr_[i]; }
#pragma unroll
        for (int i = 0; i < 4; ++i) { const int p = tid + 512 * i, row = p >> 5, ch = p & 31; *(LAS u32x4*)(lds + VI + row * 528 + ch * 16) = vr_[i]; }
        __syncthreads();
#pragma unroll
        for (int rr = 0; rr < 8; ++rr) gr[rr] = *(const u32x2*)(Z + (size_t)(row0 + 8 * wid + rr) * ZLD + ZC_RG + h * 256 + 4 * lane);
        if (it + stride < 1024) RO_LOAD(it + stride);
#pragma unroll
        for (int t2 = 0; t2 < 2; ++t2) { const int id = 2 * wid + t2, mi = id >> 2, nj = id & 3; f32x4 acc = {0.f, 0.f, 0.f, 0.f};
#pragma unroll
            for (int ks = 0; ks < 4; ++ks) { const bf16x8 a = *(const LAS bf16x8*)(lds + QI + (16 * mi + i16) * 272 + (32 * ks + 8 * g) * 2), b = *(const LAS bf16x8*)(lds + KI + (16 * nj + i16) * 272 + (32 * ks + 8 * g) * 2);
                acc = MFMA16(a, b, acc); }
#pragma unroll
            for (int jj = 0; jj < 4; ++jj) { const int ii = 16 * mi + 4 * g + jj, jc = 16 * nj + i16; const int dd = ii > jc ? ii - jc : jc - ii;
                *(LAS bf16_t*)(lds + PI + ii * 144 + jc * 2) = (bf16_t)f2bf(acc[jj] * __builtin_amdgcn_exp2f(lg * (float)dd)); } }
        __syncthreads();
        f32x4 acc1[4][2], acc2[4][2];
#pragma unroll
        for (int mi = 0; mi < 4; ++mi)
#pragma unroll
            for (int n2 = 0; n2 < 2; ++n2) { acc1[mi][n2] = (f32x4){0.f, 0.f, 0.f, 0.f}; acc2[mi][n2] = (f32x4){0.f, 0.f, 0.f, 0.f}; }
#pragma unroll
        for (int ks = 0; ks < 2; ++ks) { bf16x8 b[2]; b[0] = tr16(lds + VI, 528, 32 * ks, 32 * wid, lane); b[1] = tr16(lds + VI, 528, 32 * ks, 32 * wid + 16, lane);
#pragma unroll
            for (int mi = 0; mi < 4; ++mi) { const bf16x8 a = *(const LAS bf16x8*)(lds + PI + (16 * mi + i16) * 144 + (32 * ks + 8 * g) * 2);
                acc1[mi][0] = MFMA16(a, b[0], acc1[mi][0]); acc1[mi][1] = MFMA16(a, b[1], acc1[mi][1]); } }
#pragma unroll
        for (int ks = 0; ks < 4; ++ks)
#pragma unroll
            for (int mi = 0; mi < 4; ++mi) { const bf16x8 a = *(const LAS bf16x8*)(lds + QI + (16 * mi + i16) * 272 + (32 * ks + 8 * g) * 2);
                acc2[mi][0] = MFMA16(a, sfr[0][ks], acc2[mi][0]); acc2[mi][1] = MFMA16(a, sfr[1][ks], acc2[mi][1]); }
        if (it + stride < 1024) RO_LOAD_S(it + stride);
#pragma unroll
        for (int mi = 0; mi < 4; ++mi)
#pragma unroll
            for (int jj = 0; jj < 4; ++jj) { const int row = 16 * mi + 4 * g + jj; const float qd = __builtin_amdgcn_exp2f(lg * (float)(row + 1));
#pragma unroll
                for (int n2 = 0; n2 < 2; ++n2) *(LAS float*)(lds + O32 + (row * 260 + 32 * wid + 16 * n2 + i16) * 4) = acc1[mi][n2][jj] + qd * acc2[mi][n2][jj]; }
        __syncthreads();
#pragma unroll
        for (int rr = 0; rr < 8; ++rr) { const int row = 8 * wid + rr; const f32x4 v = *(const LAS f32x4*)(lds + O32 + (row * 260 + 4 * lane) * 4);
            const float ss = wave_sum(v[0] * v[0] + v[1] * v[1] + v[2] * v[2] + v[3] * v[3]); const float rstd = rsqrtf(ss * (1.0f / 256.0f) + EPS);
            u32x2 w; w.x = cvt_pk_bf16(siluf_(bflo(gr[rr].x)) * v[0] * rstd, siluf_(bfhi(gr[rr].x)) * v[1] * rstd); w.y = cvt_pk_bf16(siluf_(bflo(gr[rr].y)) * v[2] * rstd, siluf_(bfhi(gr[rr].y)) * v[3] * rstd);
            *(u32x2*)(AC + (size_t)(row0 + row) * ACLD + 1024 + h * 256 + 4 * lane) = w; }
    }
    __syncthreads();
#undef RO_LOAD
#undef RO_LOAD_S
}
}

__device__ __forceinline__ float rs36_xor_dpp(float v, int which) {
    const int x = __builtin_bit_cast(int, v); int r;
    if (which == 8) r = __builtin_amdgcn_update_dpp(x, x, 0x128, 0xF, 0xF, false);
    else if (which == 2) r = __builtin_amdgcn_update_dpp(x, x, 0x4E, 0xF, 0xF, false);
    else r = __builtin_amdgcn_update_dpp(x, x, 0xB1, 0xF, 0xF, false);
    return __builtin_bit_cast(float, r);
}
__device__ __forceinline__ float reduce_scatter36(const float (&v)[36], int lane) {
    float a[18], b[9], c[5], d[3], e[2];
#pragma unroll
    for (int i = 0; i < 18; ++i) { auto rr = __builtin_amdgcn_permlane32_swap(__float_as_uint(v[i]), __float_as_uint(v[i + 18]), false, false); a[i] = __uint_as_float(rr[0]) + __uint_as_float(rr[1]); }
#pragma unroll
    for (int i = 0; i < 9; ++i) { auto rr = __builtin_amdgcn_permlane16_swap(__float_as_uint(a[i]), __float_as_uint(a[i + 9]), false, false); b[i] = __uint_as_float(rr[0]) + __uint_as_float(rr[1]); }
    const bool b3 = (lane & 8) != 0, b2 = (lane & 4) != 0, b1 = (lane & 2) != 0, b0 = (lane & 1) != 0;
#pragma unroll
    for (int i = 0; i < 5; ++i) { const float x = b[i], y = (i + 5 < 9) ? b[i + 5] : 0.f; c[i] = (b3 ? y : x) + rs36_xor_dpp(b3 ? x : y, 8); }
#pragma unroll
    for (int i = 0; i < 3; ++i) { const float x = c[i], y = (i + 3 < 5) ? c[i + 3] : 0.f; const float snd = b2 ? x : y;
        d[i] = (b2 ? y : x) + __builtin_bit_cast(float, __builtin_amdgcn_ds_swizzle(__builtin_bit_cast(int, snd), 0x101F)); }
#pragma unroll
    for (int i = 0; i < 2; ++i) { const float x = d[i], y = (i + 2 < 3) ? d[i + 2] : 0.f; e[i] = (b1 ? y : x) + rs36_xor_dpp(b1 ? x : y, 2); }
    return (b0 ? e[1] : e[0]) + rs36_xor_dpp(b0 ? e[0] : e[1], 1);
}
__device__ __forceinline__ int rs36_index(int lane) { return (lane & 1) + 2 * ((lane >> 1) & 1) + 3 * ((lane >> 2) & 1) + 5 * ((lane >> 3) & 1) + 9 * ((lane >> 4) & 1) + 18 * ((lane >> 5) & 1); }
__device__ __forceinline__ bool rs36_valid(int lane) { const int r = (lane & 1) + 2 * ((lane >> 1) & 1), q = r + 3 * ((lane >> 2) & 1), pp = q + 5 * ((lane >> 3) & 1); return r < 3 && q < 5 && pp < 9; }

struct Args {
    const float* in[25]; float* out; unsigned char* ws;
    float invR[64]; float invM[16];
};
constexpr int NW = 8;

__device__ __forceinline__ void tr_item(const float* W, int N, int k0, int n0, bf16_t* WT, int ldk, int drow0, int dk0, const float* kscale, LAS float* scr, int lane, float cs = 1.0f) {
    f32x4 v[8]; const int rsub = lane >> 3, c4 = (lane & 7) * 4;
#pragma unroll
    for (int i = 0; i < 8; ++i) v[i] = *(const f32x4*)(W + (size_t)(k0 + 8 * i + rsub) * N + n0 + c4);
    if (kscale) {
#pragma unroll
        for (int i = 0; i < 8; ++i) v[i] = v[i] * kscale[k0 + 8 * i + rsub]; }
    if (cs != 1.0f) {
#pragma unroll
        for (int i = 0; i < 8; ++i) v[i] = v[i] * cs; }
#pragma unroll
    for (int i = 0; i < 8; ++i) { LAS float* d = scr + (8 * i + rsub) * 33 + c4; d[0] = v[i][0]; d[1] = v[i][1]; d[2] = v[i][2]; d[3] = v[i][3]; }
    asm volatile("s_waitcnt lgkmcnt(0)" ::: "memory");
    const int c = lane & 7;
#pragma unroll
    for (int j = 0; j < 4; ++j) { const int n = (lane >> 3) + 8 * j; const LAS float* s = scr + (8 * c) * 33 + n;
        u32x4 o; o.x = pk2(s[0 * 33], s[1 * 33]); o.y = pk2(s[2 * 33], s[3 * 33]); o.z = pk2(s[4 * 33], s[5 * 33]); o.w = pk2(s[6 * 33], s[7 * 33]);
        *(u32x4*)(WT + (size_t)(drow0 + n) * ldk + dk0 + 8 * c) = o; }
    asm volatile("s_waitcnt lgkmcnt(0)" ::: "memory");
}

constexpr int MI_IN = 16 * 261, MI_UQ = 6 * 24, MI_UKV = 4 * 32, MI_OM = 8 * 32, MI_OC = 8 * 32, MI_OR = 16 * 32, MI_MX = 16 * 32, MI_PAD = 96;
constexpr int MI_TOTAL = MI_IN + MI_UQ + MI_UKV + MI_OM + MI_OC + MI_OR + MI_MX + MI_PAD;
#define PTP(i) ((const float*)(const GAS float*)PT[i])
__device__ __forceinline__ void mixer_weight_item(volatile LAS unsigned long long* PT, int l, int it, unsigned char* wl, LAS float* scr, int lane) {
    bf16_t* WinT = (bf16_t*)(wl + WM_IN); bf16_t* WuqT = (bf16_t*)(wl + WM_UQ); bf16_t* WukvT = (bf16_t*)(wl + WM_UKV); bf16_t* WcatT = (bf16_t*)(wl + WM_CAT); bf16_t* WmixT = (bf16_t*)(wl + WM_MIX);
    int r = it;
    if (r < MI_IN) { const int kb = r / 261, nb = r % 261; tr_item(PTP(7) + (size_t)l * 1024 * IN_TOTAL, IN_TOTAL, 64 * kb, 32 * nb, WinT, 1024, 32 * nb, 64 * kb, nullptr, scr, lane, (32 * nb >= ZC_GL) ? -1.4426950408889634f : 1.0f); return; } r -= MI_IN;
    if (r < MI_UQ) { const int kb = r / 24, nb = r % 24; tr_item(PTP(10) + (size_t)l * 384 * 768, 768, 64 * kb, 32 * nb, WuqT, 384, 32 * nb, 64 * kb, PTP(8) + l * 384, scr, lane); return; } r -= MI_UQ;
    if (r < MI_UKV) { const int kb = r / 32, nb = r % 32; tr_item(PTP(11) + (size_t)l * 256 * 1024, 1024, 64 * kb, 32 * nb, WukvT, 256, 32 * nb, 64 * kb, PTP(9) + l * 256, scr, lane); return; } r -= MI_UKV;
    if (r < MI_OM) { const int kb = r / 32, nb = r % 32; tr_item(PTP(12) + (size_t)l * 512 * 1024, 1024, 64 * kb, 32 * nb, WcatT, ACLD, 32 * nb, 64 * kb, nullptr, scr, lane); return; } r -= MI_OM;
    if (r < MI_OC) { const int kb = r / 32, nb = r % 32; tr_item(PTP(14) + (size_t)l * 512 * 1024, 1024, 64 * kb, 32 * nb, WcatT, ACLD, 32 * nb, 512 + 64 * kb, nullptr, scr, lane); return; } r -= MI_OC;
    if (r < MI_OR) { const int kb = r / 32, nb = r % 32; tr_item(PTP(15) + (size_t)l * 1024 * 1024, 1024, 64 * kb, 32 * nb, WcatT, ACLD, 32 * nb, 1024 + 64 * kb, nullptr, scr, lane); return; } r -= MI_OR;
    if (r < MI_MX) { const int kb = r / 32, nb = r % 32; tr_item(PTP(16) + (size_t)l * 1024 * 1024, 1024, 64 * kb, 32 * nb, WmixT, 1024, 32 * nb, 64 * kb, nullptr, scr, lane); return; } r -= MI_MX;
    { u32x4* p = (u32x4*)(WinT + (size_t)(IN_TOTAL + r) * 1024); unsigned zz = 0u; asm volatile("" : "+v"(zz)); const u32x4 z4 = {zz, zz, zz, zz}; p[lane] = z4; p[lane + 64] = z4; }
}
constexpr int EI_G = 16 * 16, EI_D = 8 * 32, EI_GU_TOTAL = NEXP * 2 * EI_G, EI_D_TOTAL = NEXP * EI_D;
__device__ __forceinline__ void expert_gu_item(volatile LAS unsigned long long* PT, int l, int it, unsigned char* wexp, LAS float* scr, int lane) {
    const int e = it / (2 * EI_G); int r = it % (2 * EI_G);
    bf16_t* Wgu = (bf16_t*)(wexp + WE_GU) + (size_t)e * 1024 * 1024;
    const size_t eo = ((size_t)l * NEXP + e) * 1024 * 512;
    if (r < EI_G) { const int kb = r / 16, nb = r % 16, n0 = 32 * nb; tr_item(PTP(21) + eo, 512, 64 * kb, n0, Wgu, 1024, (n0 >> 7) * 256 + (n0 & 127), 64 * kb, nullptr, scr, lane); return; } r -= EI_G;
    { const int kb = r / 16, nb = r % 16, n0 = 32 * nb; tr_item(PTP(22) + eo, 512, 64 * kb, n0, Wgu, 1024, (n0 >> 7) * 256 + 128 + (n0 & 127), 64 * kb, nullptr, scr, lane); }
}
__device__ __forceinline__ void expert_d_item(volatile LAS unsigned long long* PT, int l, int it, unsigned char* wexp, LAS float* scr, int lane) {
    const int e = it / EI_D, r = it % EI_D;
    bf16_t* Wd = (bf16_t*)(wexp + WE_D) + (size_t)e * 1024 * 512;
    const size_t eo = ((size_t)l * NEXP + e) * 1024 * 512;
    { const int kb = r / 32, nb = r % 32; tr_item(PTP(23) + eo, 1024, 64 * kb, 32 * nb, Wd, 512, 32 * nb, 64 * kb, nullptr, scr, lane); }
}

__device__ __forceinline__ void sincos_acc(float angf, float& s, float& c) {
    const double a = (double)angf; const double k = rint(a * 0.15915494309189535); double r = a - k * 6.283185307179586;
    double sgn = 1.0; if (r > 1.5707963267948966) { r = 3.141592653589793 - r; sgn = -1.0; } else if (r < -1.5707963267948966) { r = -3.141592653589793 - r; sgn = -1.0; }
    const double x2 = r * r;
    double ps = -1.0 / 1307674368000.0; ps = ps * x2 + 1.0 / 6227020800.0; ps = ps * x2 - 1.0 / 39916800.0; ps = ps * x2 + 1.0 / 362880.0; ps = ps * x2 - 1.0 / 5040.0; ps = ps * x2 + 1.0 / 120.0; ps = ps * x2 - 1.0 / 6.0; ps = ps * x2 + 1.0;
    double pc = 1.0 / 20922789888000.0; pc = pc * x2 - 1.0 / 87178291200.0; pc = pc * x2 + 1.0 / 479001600.0; pc = pc * x2 - 1.0 / 3628800.0; pc = pc * x2 + 1.0 / 40320.0; pc = pc * x2 - 1.0 / 720.0; pc = pc * x2 + 1.0 / 24.0; pc = pc * x2 - 0.5; pc = pc * x2 + 1.0;
    s = (float)(r * ps); c = (float)(sgn * pc);
}

__device__ __forceinline__ void norm_row(const float* xrow, bf16_t* orow, const float* g, const float* mod, int which, int lane, f32x4* hout) {
    const f32x4* xr = (const f32x4*)xrow + lane;
    f32x4 v[4]; float ss = 0.f;
#pragma unroll
    for (int j = 0; j < 4; ++j) { v[j] = xr[64 * j]; ss += (v[j][0] * v[j][0] + v[j][1] * v[j][1]) + (v[j][2] * v[j][2] + v[j][3] * v[j][3]); }
    const float rstd = rsqrtf(wave_sum(ss) * (1.0f / DM) + EPS);
    const f32x4* g4 = (const f32x4*)g + lane; const f32x4* sh4 = (const f32x4*)(mod + which * 3072) + lane; const f32x4* sc4 = (const f32x4*)(mod + which * 3072 + 1024) + lane;
    u32x2* o8 = (u32x2*)orow + lane;
#pragma unroll
    for (int j = 0; j < 4; ++j) { const f32x4 hv = v[j] * rstd * g4[64 * j] * (sc4[64 * j] + 1.0f) + sh4[64 * j]; if (hout) hout[j] = hv;
        u32x2 w; w.x = cvt_pk_bf16(hv[0], hv[1]); w.y = cvt_pk_bf16(hv[2], hv[3]); o8[64 * j] = w; }
}

__device__ __forceinline__ float sumsq8(u32x4 v) { float s = 0.f;
#pragma unroll
    for (int j = 0; j < 4; ++j) { const float a = bflo(v[j]), b = bfhi(v[j]); s += a * a + b * b; } return s; }

__device__ __forceinline__ void prep_rows2(int r0, int tg0, bf16_t* Z, bf16_t* KR, bf16_t* AC, float* rstdq, float* rstdkv,
                                           const float* cosR, const float* sinR, const float* cosM, const float* sinM, const f32x4 (&cw)[3][2], int lane) {
    bf16_t* zr = Z + (size_t)r0 * ZLD;
    const int s0 = tg0 & (SEQ - 1); const int ch = lane * 8;
    u32x4 ql[2], kvl[2];
#pragma unroll
    for (int i = 0; i < 2; ++i) { ql[i] = (lane < 48) ? *(const u32x4*)(zr + i * ZLD + ZC_QLAT + lane * 8) : (u32x4){0u, 0u, 0u, 0u}; kvl[i] = (lane < 32) ? *(const u32x4*)(zr + i * ZLD + ZC_KVLAT + lane * 8) : (u32x4){0u, 0u, 0u, 0u}; }
    u32x4 cc[4], cx[4], cb[2];
#pragma unroll
    for (int i = 0; i < 4; ++i) { const int back = 2 - i; if (s0 >= back) { const bf16_t* zz = zr - (long)back * ZLD; cc[i] = *(const u32x4*)(zz + ZC_CC + ch); cx[i] = *(const u32x4*)(zz + ZC_CX + ch); } else { cc[i] = (u32x4){0u, 0u, 0u, 0u}; cx[i] = cc[i]; } }
    cb[0] = *(const u32x4*)(zr + ZC_CB + ch); cb[1] = *(const u32x4*)(zr + ZLD + ZC_CB + ch);
    const int hl = lane >> 5, hh = (lane & 31) >> 3, i0 = (lane & 7) * 8;
    u32x4 ra[2], rb[2]; f32x4 rc[2], rs[2];
#pragma unroll
    for (int q = 0; q < 2; ++q) { rc[q] = *(const f32x4*)(cosR + (size_t)(tg0 + hl) * 64 + i0 + 4 * q); rs[q] = *(const f32x4*)(sinR + (size_t)(tg0 + hl) * 64 + i0 + 4 * q); }
#pragma unroll
    for (int tsel = 0; tsel < 2; ++tsel) { const bf16_t* base = zr + hl * ZLD + (tsel ? ZC_RK : ZC_RQ) + hh * 128 + i0; ra[tsel] = *(const u32x4*)base; rb[tsel] = *(const u32x4*)(base + 64); }
    const int prow = (lane >> 4) & 1, pi = lane & 15;
    float kx1 = 0.f, kx2 = 0.f, kc = 0.f, ks = 0.f;
    if (lane < 32) { kx1 = bf1(zr[prow * ZLD + ZC_KROPE + pi]); kx2 = bf1(zr[prow * ZLD + ZC_KROPE + 16 + pi]); kc = cosM[(size_t)(tg0 + prow) * 16 + pi]; ks = sinM[(size_t)(tg0 + prow) * 16 + pi]; }
#pragma unroll
    for (int i = 0; i < 2; ++i) { const float sq = wave_sum(sumsq8(ql[i])), skv = wave_sum(sumsq8(kvl[i]));
        if (lane == 0) { rstdq[r0 + i] = rsqrtf(sq * (1.0f / 384.0f) + EPS); rstdkv[r0 + i] = rsqrtf(skv * (1.0f / 256.0f) + EPS); } }
    if (lane < 32) { const bf16_t o1 = (bf16_t)f2bf(kx1 * kc - kx2 * ks), o2 = (bf16_t)f2bf(kx1 * ks + kx2 * kc); bf16_t* kr = KR + (size_t)(r0 + prow) * 32 + pi; kr[0] = o1; kr[16] = o2; }
    { float u[4][8];
#pragma unroll
      for (int i = 0; i < 4; ++i)
#pragma unroll
          for (int j = 0; j < 4; ++j) { u[i][2 * j] = bflo(cc[i][j]) * bflo(cx[i][j]); u[i][2 * j + 1] = bfhi(cc[i][j]) * bfhi(cx[i][j]); }
#pragma unroll
      for (int i = 0; i < 2; ++i) { float y[8];
#pragma unroll
          for (int j = 0; j < 8; ++j) y[j] = cw[0][j >> 2][j & 3] * u[i][j] + cw[1][j >> 2][j & 3] * u[i + 1][j] + cw[2][j >> 2][j & 3] * u[i + 2][j];
          u32x4 w;
#pragma unroll
          for (int j = 0; j < 4; ++j) w[j] = cvt_pk_bf16(bflo(cb[i][j]) * y[2 * j], bfhi(cb[i][j]) * y[2 * j + 1]);
          *(u32x4*)(AC + (size_t)(r0 + i) * ACLD + 512 + ch) = w; } }
#pragma unroll
    for (int tsel = 0; tsel < 2; ++tsel) { bf16_t* base = zr + hl * ZLD + (tsel ? ZC_RK : ZC_RQ) + hh * 128 + i0; const float scl = tsel ? 0.08838834764831845f : 1.0f;
        const u32x4 a = ra[tsel], b = rb[tsel]; u32x4 wa, wb;
#pragma unroll
        for (int j = 0; j < 4; ++j) { const float xa0 = bflo(a[j]), xa1 = bfhi(a[j]), xb0 = bflo(b[j]), xb1 = bfhi(b[j]);
            const float c0 = rc[j >> 1][(2 * j) & 3], c1 = rc[j >> 1][(2 * j + 1) & 3], s0 = rs[j >> 1][(2 * j) & 3], s1 = rs[j >> 1][(2 * j + 1) & 3];
            wa[j] = cvt_pk_bf16((xa0 * c0 - xb0 * s0) * scl, (xa1 * c1 - xb1 * s1) * scl); wb[j] = cvt_pk_bf16((xa0 * s0 + xb0 * c0) * scl, (xa1 * s1 + xb1 * c1) * scl); }
        *(u32x4*)base = wa; *(u32x4*)(base + 64) = wb; }
}
#ifndef PH_MASK
#define PH_MASK 0xFFFFFFFFu
#endif
#define PH(n) ((PH_MASK >> (n)) & 1u)
#ifndef DUP_MASK
#define DUP_MASK 0u
#endif
#define DUPN(n) (1 + (int)((DUP_MASK >> (n)) & 1u))
#define WSP() ((unsigned char*)INP(25))
#define OUTP() ((float*)INP(26))
#define GRIDBAR() do { XcdBarrier _b; _b.bar = (unsigned*)(WSP() + WS_CTL) + CW_BAR; _b.x = xb_xcc_id(); _b.st = MISC + 8; xcd_barrier(_b); __builtin_amdgcn_s_waitcnt(0x0F70);   } while (0)
#define LDSP(off) ({ LAS unsigned char* _b = (LAS unsigned char*)lds_raw; asm volatile("" : "+v"(_b)); _b + (off); })
#define INP(i) ({ const unsigned long long _v = *(volatile LAS unsigned long long*)LDSP(MISC_OFF + 512 + 8 * (i)); (const float*)(const GAS float*)(((unsigned long long)(unsigned)__builtin_amdgcn_readfirstlane((int)(_v >> 32)) << 32) | (unsigned long long)(unsigned)__builtin_amdgcn_readfirstlane((int)_v)); })
#ifndef TPROBE_MASK
#define TPROBE_MASK 0u
#endif
#define TPROBE_AMP 4ull
#ifndef TPROBE2_MASK
#define TPROBE2_MASK 0u
#endif
#define TSEGB(k) do { if (TPROBE2_MASK != 0u && blockIdx.x == 0 && threadIdx.x == 0) { volatile LAS unsigned long long* tp_ = (volatile LAS unsigned long long*)LDSP(MISC_OFF + 64); \
    const unsigned long long now_ = __builtin_amdgcn_s_memrealtime(); if ((TPROBE2_MASK >> (k)) & 1u) tp_[1] += now_ - tp_[0]; } } while (0)
#define TSEG(k) do { if ((TPROBE_MASK | TPROBE2_MASK) != 0u && blockIdx.x == 0 && threadIdx.x == 0) { volatile LAS unsigned long long* tp_ = (volatile LAS unsigned long long*)LDSP(MISC_OFF + 64); \
    const unsigned long long now_ = __builtin_amdgcn_s_memrealtime(); if ((TPROBE_MASK >> (k)) & 1u) tp_[1] += now_ - tp_[0]; tp_[0] = now_; } } while (0)
#define PHASE_BEGIN unsigned char* w_ = WSP(); LAS unsigned char* lds = LDSP(0); LAS int* TP = (LAS int*)(lds + MISC_OFF + 256); \
    volatile LAS unsigned long long* PT = (volatile LAS unsigned long long*)(lds + MISC_OFF + 512); (void)TP; (void)PT; \
    int bx = blockIdx.x; asm volatile("" : "+s"(bx)); int tid = tid0; asm volatile("" : "+v"(tid)); \
    const int lane = tid & 63, wave = __builtin_amdgcn_readfirstlane(tid >> 6), gw = bx * NW + wave, NGW = G * NW; (void)lane; (void)gw; (void)NGW; \
    float* const xres = OUTP(); (void)xres;
__global__ void __launch_bounds__(NW * 64, 2) fwd_kernel(Args args) {
    extern __shared__ __attribute__((aligned(16))) unsigned char lds_raw[];
#define MISC ((volatile LAS unsigned*)LDSP(MISC_OFF))
#define TPTR ((LAS int*)LDSP(MISC_OFF + 256))
#define PTAB ((volatile LAS unsigned long long*)LDSP(MISC_OFF + 512))
    const int tid0 = threadIdx.x;
#define G ((int)gridDim.x)

    { LAS unsigned char* lds = LDSP(0); for (int u = tid0; u < 128; u += NW * 64) ((LAS unsigned*)(lds + MISC_OFF))[u] = 0u; }
    { volatile LAS unsigned long long* PT = PTAB;
#pragma unroll
    for (int i = 0; i < 25; ++i) if (tid0 == i) PT[i] = (unsigned long long)args.in[i];
    if (tid0 == 25) PT[25] = (unsigned long long)args.ws;
    if (tid0 == 26) PT[26] = (unsigned long long)args.out; }
    __syncthreads();
    (void)xcd_barrier_post((unsigned*)(WSP() + WS_CTL) + CW_BAR, MISC + 8);
    if ((TPROBE_MASK | TPROBE2_MASK) != 0u && blockIdx.x == 0 && threadIdx.x == 0) { volatile LAS unsigned long long* tp_ = (volatile LAS unsigned long long*)LDSP(MISC_OFF + 64); tp_[0] = __builtin_amdgcn_s_memrealtime(); tp_[1] = 0ull; }

    if (PH(0)) for (int rep_ = 0; rep_ < DUPN(0); ++rep_) {
        PHASE_BEGIN
        float* MODT = (float*)(w_ + WS_MODT);
        LAS float* sc = (LAS float*)lds;
        LAS float* red = (LAS float*)(lds + 16384);
        { const float* cin = INP(1); for (int i = tid; i < 4096; i += NW * 64) sc[i] = siluf_(cin[i]); }
        __syncthreads();
        { const float* wada = INP(3); const float* bada = INP(4);
        for (int it = bx; it < 2 * 192; it += G) {
            const int l = it / 192, c0 = (it % 192) * 32, kp = tid >> 5, col = tid & 31;
            const float* w = wada + (size_t)l * 1024 * 6144 + (size_t)(kp * 64) * 6144 + c0 + col;
            float a0 = 0.f, a1 = 0.f, a2 = 0.f, a3 = 0.f;
#pragma unroll 16
            for (int k = 0; k < 64; ++k) { const float wv = w[(size_t)k * 6144]; const int kk = kp * 64 + k; a0 += sc[kk] * wv; a1 += sc[1024 + kk] * wv; a2 += sc[2048 + kk] * wv; a3 += sc[3072 + kk] * wv; }
            red[(kp * 4 + 0) * 32 + col] = a0; red[(kp * 4 + 1) * 32 + col] = a1; red[(kp * 4 + 2) * 32 + col] = a2; red[(kp * 4 + 3) * 32 + col] = a3;
            __syncthreads();
            if (tid < 128) { const int b = tid >> 5; float s = bada[l * 6144 + c0 + col];
#pragma unroll
                for (int p = 0; p < 16; ++p) s += red[(p * 4 + b) * 32 + col];
                MODT[(size_t)(l * 4 + b) * 6144 + c0 + col] = s; }
            __syncthreads();
        } }
        { const int* pos = (const int*)INP(2);
          float* COSR = (float*)(w_ + WS_COSR); float* SINR = (float*)(w_ + WS_SINR); float* COSM = (float*)(w_ + WS_COSM); float* SINM = (float*)(w_ + WS_SINM);
          for (int i = bx * NW * 64 + tid; i < T * 64; i += G * NW * 64) { const int tg = i >> 6, f = i & 63; float s, c; sincos_acc((float)pos[tg] * args.invR[f], s, c); COSR[i] = c; SINR[i] = s; }
          for (int i = bx * NW * 64 + tid; i < T * 16; i += G * NW * 64) { const int tg = i >> 4, f = i & 15; float s, c; sincos_acc((float)pos[tg] * args.invM[f], s, c); COSM[i] = c; SINM[i] = s; } }
        __syncthreads();
        LAS float* scr = (LAS float*)(lds + wave * 16384);
        for (int it = gw; it < MI_TOTAL; it += NGW) mixer_weight_item(PT, 0, it, w_ + WS_WMIX, scr, lane);
    }
    TSEGB(0); GRIDBAR(); TSEG(0);

    for (int l = 0; l < DEPTH; ++l) {
        for (int half = 0; half < 2; ++half) {
            const int tok0 = half * TH;
            if (l == 0 && half == 0) {
            if (PH(1)) for (int rep_ = 0; rep_ < DUPN(1); ++rep_) { PHASE_BEGIN bf16_t* XN = (bf16_t*)(w_ + WS_ARENA + AR_XN); bf16_t* XNB = (bf16_t*)(w_ + WS_ARENA + AR_XNB); const float* MODT = (const float*)(w_ + WS_MODT);
                const float* xcur = INP(0); const float* gmix = INP(5);
                for (int tg = gw * 2; tg < T; tg += NGW * 2) { const int b = tg / SEQ; const float* mod = MODT + (size_t)(l * 4 + b) * 6144;
                    const f32x4* xa = (const f32x4*)(xcur + (size_t)tg * DM) + lane; const f32x4* xb = xa + DM / 4;
                    f32x4 h0[4], h1[4]; float s0 = 0.f, s1 = 0.f;
#pragma unroll
                    for (int j = 0; j < 4; ++j) { h0[j] = xa[64 * j]; h1[j] = xb[64 * j]; }
#pragma unroll
                    for (int j = 0; j < 4; ++j) { s0 += (h0[j][0] * h0[j][0] + h0[j][1] * h0[j][1]) + (h0[j][2] * h0[j][2] + h0[j][3] * h0[j][3]); s1 += (h1[j][0] * h1[j][0] + h1[j][1] * h1[j][1]) + (h1[j][2] * h1[j][2] + h1[j][3] * h1[j][3]); }
                    const float r0 = rsqrtf(wave_sum(s0) * (1.0f / DM) + EPS), r1 = rsqrtf(wave_sum(s1) * (1.0f / DM) + EPS);
                    const f32x4* g4 = (const f32x4*)gmix + lane; const f32x4* sh4 = (const f32x4*)mod + lane; const f32x4* sc4 = (const f32x4*)(mod + 1024) + lane;
                    u32x2* oa = (u32x2*)((tg < TH ? XN + (size_t)tg * DM : XNB + (size_t)(tg - TH) * DM)) + lane; u32x2* ob = oa + DM / 4;
#pragma unroll
                    for (int j = 0; j < 4; ++j) { const f32x4 a = g4[64 * j] * (sc4[64 * j] + 1.0f), sh = sh4[64 * j]; const f32x4 y0 = h0[j] * r0 * a + sh, y1 = h1[j] * r1 * a + sh;
                        u32x2 w; w.x = cvt_pk_bf16(y0[0], y0[1]); w.y = cvt_pk_bf16(y0[2], y0[3]); oa[64 * j] = w;
                        w.x = cvt_pk_bf16(y1[0], y1[1]); w.y = cvt_pk_bf16(y1[2], y1[3]); ob[64 * j] = w; } } }
            TSEGB(1); GRIDBAR(); TSEG(1);
            }
            if (PH(2)) for (int rep_ = 0; rep_ < DUPN(2); ++rep_) { PHASE_BEGIN
              pg8::Gemm g{(const bf16_t*)(w_ + WS_ARENA + (half ? AR_XNB : AR_XN)), (const bf16_t*)(w_ + WS_WMIX + (size_t)l * WMIX_LAYER + WM_IN), DM, DM, DM, 0u}; pg8::StaticOrder S; S.init(TH, 8192, G, bx);
              pg8::EpiBf16<0> E{(bf16_t*)(w_ + WS_ARENA + AR_Z), ZLD, nullptr, nullptr, 0};
              pg8::gemm_phase<pg8::EpiBf16<0>, pg8::StaticOrder, true>(lds, g, S, E); }
            TSEGB(2); GRIDBAR(); TSEG(2);
            if (PH(3)) for (int rep_ = 0; rep_ < DUPN(3); ++rep_) { PHASE_BEGIN const float* convw = INP(13) + l * 3 * 512;
                { pg8::Gemm g{(const bf16_t*)(w_ + WS_ARENA + (half ? AR_XNB : AR_XN)), (const bf16_t*)(w_ + WS_WMIX + (size_t)l * WMIX_LAYER + WM_IN) + (size_t)8192 * DM, DM, DM, DM, 0u}; pg8::StaticOrder S; S.init(TH, 256, G, bx);
                  pg8::EpiBf16<0> E{(bf16_t*)(w_ + WS_ARENA + AR_Z) + 8192, ZLD, nullptr, nullptr, 0};
                  pg8::gemm_phase<pg8::EpiBf16<0>, pg8::StaticOrder, true>(lds, g, S, E); }
                f32x4 cw[3][2];
#pragma unroll
                for (int k = 0; k < 3; ++k) { cw[k][0] = *(const f32x4*)(convw + k * 512 + lane * 8); cw[k][1] = *(const f32x4*)(convw + k * 512 + lane * 8 + 4); }
                const int nlead = (G > 64) ? 64 : 0;
                const int R1 = nlead ? 9216 : 0;
                for (int pass = 0; pass < 2; ++pass) { const int rlo = pass ? R1 : 0, rhi = pass ? TH : R1;
                  const int vw = pass ? gw : (bx < nlead ? -1 : (bx - nlead) * NW + wave), nvw = pass ? NGW : (G - nlead) * NW;
                  if (vw >= 0) for (int r = rlo + vw * 2; r < rhi; r += nvw * 2)
                    prep_rows2(r, tok0 + r, (bf16_t*)(w_ + WS_ARENA + AR_Z), (bf16_t*)(w_ + WS_ARENA + AR_KROPE), (bf16_t*)(w_ + WS_ARENA + AR_AC), (float*)(w_ + WS_RSTDQ), (float*)(w_ + WS_RSTDKV),
                             (const float*)(w_ + WS_COSR), (const float*)(w_ + WS_SINR), (const float*)(w_ + WS_COSM), (const float*)(w_ + WS_SINM), cw, lane); } }
            TSEGB(3); GRIDBAR(); TSEG(3);
            if (PH(4)) for (int rep_ = 0; rep_ < DUPN(4); ++rep_) { PHASE_BEGIN
              pg8::Gemm g{(const bf16_t*)(w_ + WS_ARENA + AR_Z) + ZC_QLAT, (const bf16_t*)(w_ + WS_WMIX + (size_t)l * WMIX_LAYER + WM_UQ), ZLD, 384, 384, 0u}; pg8::StaticOrder S; S.init(TH, 768, G, bx);
              pg8::EpiBf16<0> E{(bf16_t*)(w_ + WS_ARENA + AR_QB), 768, (const float*)(w_ + WS_RSTDQ), nullptr, 0};
              pg8::gemm_phase<pg8::EpiBf16<0>, pg8::StaticOrder, true>(lds, g, S, E); }
            if (PH(5)) for (int rep_ = 0; rep_ < DUPN(5); ++rep_) { PHASE_BEGIN
              pg8::Gemm g{(const bf16_t*)(w_ + WS_ARENA + AR_Z) + ZC_KVLAT, (const bf16_t*)(w_ + WS_WMIX + (size_t)l * WMIX_LAYER + WM_UKV), ZLD, 256, 256, 0u}; pg8::StaticOrder S; S.init(TH, 1024, G, bx);
              pg8::EpiBf16<1> E{(bf16_t*)(w_ + WS_ARENA + AR_KB), 768, (const float*)(w_ + WS_RSTDKV), (bf16_t*)(w_ + WS_ARENA + AR_VB), 512};
              pg8::gemm_phase<pg8::EpiBf16<1>, pg8::StaticOrder, true>(lds, g, S, E); }
            if (PH(6)) for (int rep_ = 0; rep_ < DUPN(6); ++rep_) { PHASE_BEGIN
              ret::kvloc_phase(bx, G, (const bf16_t*)(w_ + WS_ARENA + AR_Z), (bf16_t*)(w_ + WS_ARENA + AR_RS), (LAS char*)lds); }
            TSEGB(4); GRIDBAR(); TSEG(4);
            if (PH(7)) for (int rep_ = 0; rep_ < DUPN(7); ++rep_) { PHASE_BEGIN
              for (int p = bx; p < 256; p += G) { const int bh = p >> 4, s = p & 15;
#pragma unroll 1
                for (int k = 0; k < 2; ++k)
                  att::attn_unit<8>(bh >> 3, bh & 7, k ? s : 31 - s, (const bf16_t*)(w_ + WS_ARENA + AR_QB), (const bf16_t*)(w_ + WS_ARENA + AR_KB), (const bf16_t*)(w_ + WS_ARENA + AR_KROPE), (const bf16_t*)(w_ + WS_ARENA + AR_VB), (bf16_t*)(w_ + WS_ARENA + AR_AC),
                                 (const float*)(w_ + WS_COSM), (const float*)(w_ + WS_SINM), tok0, (LAS char*)lds); } }
            if (PH(8)) for (int rep_ = 0; rep_ < DUPN(8); ++rep_) { PHASE_BEGIN ret::scan_all((bf16_t*)(w_ + WS_ARENA + AR_RS), bx * NW * 64 + tid, G * NW * 64); }
            TSEGB(5); GRIDBAR(); TSEG(5);
            if (PH(9)) for (int rep_ = 0; rep_ < DUPN(9); ++rep_) { PHASE_BEGIN
              ret::out_phase(bx, G, (const bf16_t*)(w_ + WS_ARENA + AR_Z), (const bf16_t*)(w_ + WS_ARENA + AR_RS), (bf16_t*)(w_ + WS_ARENA + AR_AC), (LAS char*)lds); }
            TSEGB(6); GRIDBAR(); TSEG(6);
            if (PH(10)) for (int rep_ = 0; rep_ < DUPN(10); ++rep_) { PHASE_BEGIN
              pg8::Gemm g{(const bf16_t*)(w_ + WS_ARENA + AR_AC), (const bf16_t*)(w_ + WS_WMIX + (size_t)l * WMIX_LAYER + WM_CAT), ACLD, ACLD, 2048, 0u}; pg8::StaticOrder S; S.init(TH, DM, G, bx);
              pg8::EpiMerge E{(const bf16_t*)(w_ + WS_ARENA + AR_Z), (bf16_t*)(w_ + WS_ARENA + AR_XN)};
              pg8::gemm_phase<pg8::EpiMerge, pg8::StaticOrder, true>(lds, g, S, E); }
            TSEGB(7); GRIDBAR(); TSEG(7);
            if (PH(11)) for (int rep_ = 0; rep_ < DUPN(11); ++rep_) { PHASE_BEGIN bf16_t* XR = (bf16_t*)(w_ + WS_ARENA + AR_XR) + (size_t)tok0 * DM;
              pg8::Gemm g{(const bf16_t*)(w_ + WS_ARENA + AR_XN), (const bf16_t*)(w_ + WS_WMIX + (size_t)l * WMIX_LAYER + WM_MIX), DM, DM, DM, 0u}; pg8::StaticOrder S; S.init(TH, DM, G, bx);
              pg8::EpiResid E{(l == 0) ? INP(0) + (size_t)tok0 * DM : nullptr, (l == 0) ? nullptr : (const bf16_t*)XR, XR, (const float*)(w_ + WS_MODT) + (size_t)(l * 4 + half * 2) * 6144 + 2048};
              pg8::gemm_phase<pg8::EpiResid, pg8::StaticOrder, true>(lds, g, S, E); }
            TSEGB(8); GRIDBAR(); TSEG(8);
        }
        if (PH(12)) for (int rep_ = 0; rep_ < DUPN(12); ++rep_) {
            PHASE_BEGIN
            constexpr int WPITCH = 2064;
            LAS unsigned char* WAH = lds; LAS unsigned char* WAL = lds + 36 * WPITCH;
            LAS float* SHW = (LAS float*)(lds + 72 * WPITCH);
            LAS float* RSTD = SHW + 48;
            LAS float* LG = (LAS float*)(lds + 72 * WPITCH + 704);
            LAS unsigned* LCNT = (LAS unsigned*)(lds + 72 * WPITCH + 704 + 9472); LAS unsigned* LBASE = LCNT + 32; LAS unsigned* LTOK = LCNT + 64;
            static_assert(72 * WPITCH + 704 + 9472 + 256 + 128 * 24 <= MISC_OFF, "routing LDS map");
            const float* gffn = INP(6) + l * DM; const float* MODT = (const float*)(w_ + WS_MODT);
            bf16_t* H2 = (bf16_t*)(w_ + WS_ARENA + AR_H2); const bf16_t* XR = (const bf16_t*)(w_ + WS_ARENA + AR_XR); unsigned* ROUTE = (unsigned*)(w_ + WS_ROUTE); unsigned* cnt = (unsigned*)(w_ + WS_CTL) + CW_CNT + l * 32 * 16;
            float* AFS = (float*)(w_ + WS_AFS) + (size_t)bx * DM;
            const float* wrg = INP(17) + (size_t)l * 1024 * 4; const float* wre = INP(19) + (size_t)l * 1024 * 32; const float* brg = INP(18) + l * 4; const float* bre = INP(20) + l * 32;
            if (tid < 32) LCNT[tid] = 0u;
            for (int chunk = bx; chunk < T / 128; chunk += G) {
              const int b = (chunk * 128) / SEQ; const float* mod = MODT + (size_t)(l * 4 + b) * 6144;
              { float part[36];
#pragma unroll
                for (int j = 0; j < 36; ++j) part[j] = 0.f;
                for (int k = tid; k < 1024; k += NW * 64) { const float ak = gffn[k] * (mod[4096 + k] + 1.0f), shk = mod[3072 + k]; AFS[k] = ak;
                    float wv[36]; { const f32x4 a = *(const f32x4*)(wrg + k * 4); wv[0] = a[0]; wv[1] = a[1]; wv[2] = a[2]; wv[3] = a[3]; }
#pragma unroll
                    for (int q = 0; q < 8; ++q) { const f32x4 e4 = *(const f32x4*)(wre + k * 32 + q * 4); wv[4 + 4 * q] = e4[0]; wv[5 + 4 * q] = e4[1]; wv[6 + 4 * q] = e4[2]; wv[7 + 4 * q] = e4[3]; }
#pragma unroll
                    for (int j = 0; j < 36; ++j) { const float wa = wv[j] * ak; const unsigned hi = f2bf(wa); const float rem = wa - __builtin_bit_cast(float, hi << 16);
                        *(LAS bf16_t*)(WAH + j * WPITCH + k * 2) = (bf16_t)hi; *(LAS bf16_t*)(WAL + j * WPITCH + k * 2) = (bf16_t)f2bf(rem); part[j] += shk * wv[j]; } }
                const float tot = reduce_scatter36(part, lane);
                if (rs36_valid(lane)) LG[wave * 36 + rs36_index(lane)] = tot; }
              __syncthreads();
              if (tid < 36) { float sacc = (tid < 4) ? brg[tid] : bre[tid - 4];
#pragma unroll
                  for (int w8 = 0; w8 < 8; ++w8) sacc += LG[w8 * 36 + tid];
                  SHW[tid] = sacc; }
              __syncthreads();
              const int i16 = lane & 15, g4 = lane >> 4; const int tok = chunk * 128 + wave * 16 + i16;
              const bf16_t* xrow = XR + (size_t)tok * DM + 8 * g4;
              float ss = 0.f; f32x4 acc[3];
#pragma unroll
              for (int nt = 0; nt < 3; ++nt) acc[nt] = (f32x4){0.f, 0.f, 0.f, 0.f};
#pragma unroll 1
              for (int kh = 0; kh < 2; ++kh) {
                  bf16x8 af[16];
#pragma unroll
                  for (int ks = 0; ks < 16; ++ks) af[ks] = *(const bf16x8*)(xrow + 512 * kh + 32 * ks);
#pragma unroll
                  for (int ks = 0; ks < 16; ++ks) { const u32x4 r = __builtin_bit_cast(u32x4, af[ks]);
#pragma unroll
                      for (int e = 0; e < 4; ++e) { const float x0 = bflo(r[e]), x1 = bfhi(r[e]); ss += x0 * x0 + x1 * x1; } }
                  const int r2 = (32 + i16 < 36) ? 32 + i16 : 35;
                  const LAS unsigned char* wh = WAH + i16 * WPITCH + (512 * kh + 8 * g4) * 2; const LAS unsigned char* wl = WAL + i16 * WPITCH + (512 * kh + 8 * g4) * 2;
                  const int o2 = (r2 - i16) * WPITCH;
#pragma unroll
                  for (int ks = 0; ks < 16; ++ks)
#pragma unroll
                      for (int nt = 0; nt < 3; ++nt) { const int ro = (nt == 2) ? o2 : 16 * nt * WPITCH; const bf16x8 bh = *(const LAS bf16x8*)(wh + ro + 64 * ks), bl = *(const LAS bf16x8*)(wl + ro + 64 * ks);
                          acc[nt] = __builtin_amdgcn_mfma_f32_16x16x32_bf16(af[ks], bh, acc[nt], 0, 0, 0); acc[nt] = __builtin_amdgcn_mfma_f32_16x16x32_bf16(af[ks], bl, acc[nt], 0, 0, 0);
                          if (nt == 2 && (ks & 1)) __builtin_amdgcn_sched_barrier(0); }
              }
              { auto rr = __builtin_amdgcn_permlane16_swap(__float_as_uint(ss), __float_as_uint(ss), false, false); ss = __uint_as_float(rr[0]) + __uint_as_float(rr[1]); }
              { auto rr = __builtin_amdgcn_permlane32_swap(__float_as_uint(ss), __float_as_uint(ss), false, false); ss = __uint_as_float(rr[0]) + __uint_as_float(rr[1]); }
              const float rstd = rsqrtf(ss * (1.0f / DM) + EPS);
              if (g4 == 0) RSTD[wave * 16 + i16] = rstd;
              float lgv[3][4];
#pragma unroll
              for (int jj = 0; jj < 4; ++jj) { const float rt = RSTD[wave * 16 + 4 * g4 + jj];
#pragma unroll
                  for (int nt = 0; nt < 3; ++nt) lgv[nt][jj] = acc[nt][jj] * rt + ((16 * nt + i16 < 36) ? SHW[16 * nt + i16] : 0.f); }
              { bf16_t* hr = H2 + (size_t)tok * DM + 8 * g4; const float* ap = AFS + 8 * g4; const float* sp = mod + 3072 + 8 * g4;
#pragma unroll 4
                for (int ks = 0; ks < 32; ++ks) { const u32x4 r = *(const u32x4*)(xrow + 32 * ks); const f32x4 a0 = *(const f32x4*)(ap + 32 * ks), a1 = *(const f32x4*)(ap + 32 * ks + 4), s0 = *(const f32x4*)(sp + 32 * ks), s1 = *(const f32x4*)(sp + 32 * ks + 4);
                    u32x4 w; w.x = cvt_pk_bf16(bflo(r.x) * rstd * a0[0] + s0[0], bfhi(r.x) * rstd * a0[1] + s0[1]); w.y = cvt_pk_bf16(bflo(r.y) * rstd * a0[2] + s0[2], bfhi(r.y) * rstd * a0[3] + s0[3]);
                    w.z = cvt_pk_bf16(bflo(r.z) * rstd * a1[0] + s1[0], bfhi(r.z) * rstd * a1[1] + s1[1]); w.w = cvt_pk_bf16(bflo(r.w) * rstd * a1[2] + s1[2], bfhi(r.w) * rstd * a1[3] + s1[3]);
                    *(u32x4*)(hr + 32 * ks) = w; } }
#pragma unroll 1
              for (int batch = 0; batch < 2; ++batch) {
                if ((wave >> 2) == batch) {
#pragma unroll
                    for (int jj = 0; jj < 4; ++jj)
#pragma unroll
                        for (int nt = 0; nt < 3; ++nt) if (16 * nt + i16 < 36) LG[((wave & 3) * 16 + 4 * g4 + jj) * 37 + 16 * nt + i16] = lgv[nt][jj]; }
                __syncthreads();
                if (tid < 64) {
                    const int tg = chunk * 128 + batch * 64 + tid; const LAS float* lgp = LG + tid * 37;
                    float gl[4];
#pragma unroll
                    for (int q = 0; q < 4; ++q) gl[q] = lgp[q];
                    float gm = gl[0]; int gi = 0;
#pragma unroll
                    for (int q = 1; q < 4; ++q) if (gl[q] > gm) { gm = gl[q]; gi = q; }
                    float gs = 0.f;
#pragma unroll
                    for (int q = 0; q < 4; ++q) gs += __expf(gl[q] - gm);
                    const float gval = 1.0f / gs;
                    float el[8];
#pragma unroll
                    for (int k = 0; k < 8; ++k) el[k] = lgp[4 + gi * 8 + k];
                    float m1 = el[0]; int i1 = 0;
#pragma unroll
                    for (int k = 1; k < 8; ++k) if (el[k] > m1) { m1 = el[k]; i1 = k; }
                    float m2 = -3.0e38f; int i2 = 0;
#pragma unroll
                    for (int k = 0; k < 8; ++k) if (k != i1 && el[k] > m2) { m2 = el[k]; i2 = k; }
                    const float p2 = __expf(m2 - m1); const float w1 = gval / (1.0f + p2), w2 = gval * p2 / (1.0f + p2);
                    const int e1 = gi * 8 + i1, e2 = gi * 8 + i2;
                    const unsigned r1 = __hip_atomic_fetch_add(LCNT + e1, 1u, __ATOMIC_RELAXED, __HIP_MEMORY_SCOPE_WORKGROUP), r2 = __hip_atomic_fetch_add(LCNT + e2, 1u, __ATOMIC_RELAXED, __HIP_MEMORY_SCOPE_WORKGROUP);
                    LAS unsigned* te = LTOK + (batch * 64 + tid) * 6; te[0] = (unsigned)e1; te[1] = (unsigned)e2; te[2] = __float_as_uint(w1); te[3] = __float_as_uint(w2); te[4] = r1; te[5] = r2;
                }
                __syncthreads();
              }
              if (tid < 32) { const unsigned c = LCNT[tid]; LBASE[tid] = c ? atomicAdd(cnt + tid * 16, c) : 0u; }
              __syncthreads();
              if (tid < 128) { const LAS unsigned* te = LTOK + tid * 6; const int tg = chunk * 128 + tid;
                  u32x4 a; a.x = te[0]; a.y = te[1]; a.z = te[2]; a.w = te[3]; u32x2 rr; rr.x = te[4] + LBASE[te[0]]; rr.y = te[5] + LBASE[te[1]];
                  *(u32x4*)(ROUTE + (size_t)tg * 8) = a; *(u32x2*)(ROUTE + (size_t)tg * 8 + 4) = rr; }
              if (tid < 32) LCNT[tid] = 0u;
              __syncthreads();
            }
        }
        TSEGB(9); GRIDBAR(); TSEG(9);
        if (PH(13)) for (int rep_ = 0; rep_ < DUPN(13); ++rep_) {
            PHASE_BEGIN unsigned* cnt = (unsigned*)(w_ + WS_CTL) + CW_CNT + l * 32 * 16;
            LAS int* CN = (LAS int*)(lds + MISC_OFF + 128);
            if (tid < 32) CN[tid] = (int)__hip_atomic_load(cnt + tid * 16, RLX_AGENT);
            __syncthreads();
            if (tid == 0) { int acc = 0;
                for (int e = 0; e < 32; ++e) { TP[e] = acc; acc += (int)(((unsigned)CN[e] + 255u) >> 8); }
                TP[32] = acc; }
            __syncthreads();
            unsigned* ROUTE = (unsigned*)(w_ + WS_ROUTE); int* PERM = (int*)(w_ + WS_PERM);
            for (int tg = bx * NW * 64 + tid; tg < T; tg += G * NW * 64) {
                const u32x4 a = *(const u32x4*)(ROUTE + (size_t)tg * 8); const u32x2 rk = *(const u32x2*)(ROUTE + (size_t)tg * 8 + 4);
                u32x2 pp; pp.x = (unsigned)TP[a.x] * 256u + rk.x; pp.y = (unsigned)TP[a.y] * 256u + rk.y;
                PERM[pp.x] = tg; PERM[pp.y] = tg; *(u32x2*)(ROUTE + (size_t)tg * 8 + 6) = pp; }
            for (int idx = bx * NW * 64 + tid; idx < 32 * 256; idx += G * NW * 64) { const int e = idx >> 8, i = idx & 255, c = CN[e] & 255;
                if (c != 0 && i >= c) PERM[(TP[e + 1] - 1) * 256 + i] = 0; }
            LAS float* scr = (LAS float*)(lds + wave * 16384);
            for (int it = gw; it < EI_GU_TOTAL; it += NGW) expert_gu_item(PT, l, it, w_ + WS_ARENA + AR_WEXP, scr, lane);
        }
        TSEGB(10); GRIDBAR(); TSEG(10);
        if (PH(14)) for (int rep_ = 0; rep_ < DUPN(14); ++rep_) { PHASE_BEGIN
          pg8::Gemm g{(const bf16_t*)(w_ + WS_ARENA + AR_H2), (const bf16_t*)(w_ + WS_ARENA + AR_WEXP + WE_GU), DM, DM, DM, 1024u * 1024u * 2u, (const int*)(w_ + WS_PERM)}; pg8::ExpertOrder S{TP, G, (G % 8 == 0) ? (bx % 8) * (G / 8) + bx / 8 : bx};
          pg8::EpiGU E{(bf16_t*)(w_ + WS_ARENA + AR_HID)};
          pg8::gemm_phase<pg8::EpiGU, pg8::ExpertOrder, true, true>(lds, g, S, E);
          { const int units = __builtin_amdgcn_readfirstlane(TP[32]) * 4, rem = units % G, nidle = rem ? G - rem : G, ii = rem ? S.c - rem : S.c;
            if (ii >= 0) { LAS float* scr = (LAS float*)(lds + wave * 16384);
              for (int it = ii * NW + wave; it < EI_D_TOTAL; it += nidle * NW) expert_d_item(PT, l, it, w_ + WS_ARENA + AR_WEXP, scr, lane); } } }
        TSEGB(11); GRIDBAR(); TSEG(11);
        if (PH(15)) for (int rep_ = 0; rep_ < DUPN(15); ++rep_) { PHASE_BEGIN
          pg8::Gemm g{(const bf16_t*)(w_ + WS_ARENA + AR_HID), (const bf16_t*)(w_ + WS_ARENA + AR_WEXP + WE_D), EFF, EFF, EFF, 1024u * 512u * 2u}; pg8::ExpertOrder S{TP, G, (G % 8 == 0) ? (bx % 8) * (G / 8) + bx / 8 : bx};
          pg8::EpiBf16<0> E{(bf16_t*)(w_ + WS_ARENA + AR_YS), DM, nullptr, nullptr, 0};
          pg8::gemm_phase<pg8::EpiBf16<0>, pg8::ExpertOrder, true>(lds, g, S, E);
          if (l + 1 < DEPTH) { const int units = __builtin_amdgcn_readfirstlane(TP[32]) * 4, rem = units % G, nidle = rem ? G - rem : G, ii = rem ? S.c - rem : S.c;
            if (ii >= 0) { LAS float* scr = (LAS float*)(lds + wave * 16384);
              for (int it = ii * NW + wave; it < MI_TOTAL; it += nidle * NW) mixer_weight_item(PT, l + 1, it, w_ + WS_WMIX + (size_t)(l + 1) * WMIX_LAYER, scr, lane); } } }
        TSEGB(12); GRIDBAR(); TSEG(12);
        if (PH(16)) for (int rep_ = 0; rep_ < DUPN(16); ++rep_) { PHASE_BEGIN const unsigned* ROUTE = (const unsigned*)(w_ + WS_ROUTE); const bf16_t* YS = (const bf16_t*)(w_ + WS_ARENA + AR_YS); const float* MODT = (const float*)(w_ + WS_MODT);
          bf16_t* XR = (bf16_t*)(w_ + WS_ARENA + AR_XR); const float* fgp = INP(24); const float* gnext = INP(5) + (l + 1 < DEPTH ? (l + 1) * DM : 0); bf16_t* XN = (bf16_t*)(w_ + WS_ARENA + AR_XN); bf16_t* XNB = (bf16_t*)(w_ + WS_ARENA + AR_XNB);
          for (int t4 = gw * 4; t4 < T; t4 += NGW * 4) { const int b = t4 / SEQ;
            const f32x4* gt = (const f32x4*)(MODT + (size_t)(l * 4 + b) * 6144 + 5120) + lane;
            u32x4 a[4]; u32x2 pp[4];
#pragma unroll
            for (int i = 0; i < 4; ++i) { a[i] = *(const u32x4*)(ROUTE + (size_t)(t4 + i) * 8); pp[i] = *(const u32x2*)(ROUTE + (size_t)(t4 + i) * 8 + 6); }
            f32x4 xv[4][4]; u32x2 ya[4][4], yb[4][4];
#pragma unroll
            for (int i = 0; i < 4; ++i) { const u32x2* xr = (const u32x2*)(XR + (size_t)(t4 + i) * DM) + lane; const u32x2* y1 = (const u32x2*)(YS + (size_t)pp[i].x * DM) + lane; const u32x2* y2 = (const u32x2*)(YS + (size_t)pp[i].y * DM) + lane;
#pragma unroll
                for (int j = 0; j < 4; ++j) { const u32x2 rx = xr[64 * j]; xv[i][j] = (f32x4){bflo(rx.x), bfhi(rx.x), bflo(rx.y), bfhi(rx.y)}; ya[i][j] = y1[64 * j]; yb[i][j] = y2[64 * j]; } }
            f32x4 gv[4], na[4], nsh[4];
#pragma unroll
            for (int j = 0; j < 4; ++j) gv[j] = gt[64 * j];
            if (l + 1 < DEPTH) { const float* nmod = MODT + (size_t)((l + 1) * 4 + b) * 6144; const f32x4* g4 = (const f32x4*)gnext + lane; const f32x4* sh4 = (const f32x4*)nmod + lane; const f32x4* sc4 = (const f32x4*)(nmod + 1024) + lane;
#pragma unroll
                for (int j = 0; j < 4; ++j) { na[j] = g4[64 * j] * (sc4[64 * j] + 1.0f); nsh[j] = sh4[64 * j]; } }
            else {
#pragma unroll
                for (int j = 0; j < 4; ++j) { na[j] = (f32x4){0.f, 0.f, 0.f, 0.f}; nsh[j] = na[j]; } }
#pragma unroll
            for (int i = 0; i < 4; ++i) { const float w1 = __uint_as_float(a[i].z), w2 = __uint_as_float(a[i].w); f32x4* xr = (f32x4*)(xres + (size_t)(t4 + i) * DM) + lane; u32x2* xq = (u32x2*)(XR + (size_t)(t4 + i) * DM) + lane; float ss = 0.f;
#pragma unroll
                for (int j = 0; j < 4; ++j) { const f32x4 m = (f32x4){bflo(ya[i][j].x), bfhi(ya[i][j].x), bflo(ya[i][j].y), bfhi(ya[i][j].y)} * w1 + (f32x4){bflo(yb[i][j].x), bfhi(yb[i][j].x), bflo(yb[i][j].y), bfhi(yb[i][j].y)} * w2;
                    xv[i][j] = xv[i][j] + gv[j] * m; ss += (xv[i][j][0] * xv[i][j][0] + xv[i][j][1] * xv[i][j][1]) + (xv[i][j][2] * xv[i][j][2] + xv[i][j][3] * xv[i][j][3]); }
                if (l == DEPTH - 1) { const float rstd = rsqrtf(wave_sum(ss) * (1.0f / DM) + EPS); const f32x4* fg = (const f32x4*)fgp + lane;
#pragma unroll
                    for (int j = 0; j < 4; ++j) xr[64 * j] = xv[i][j] * rstd * fg[64 * j]; }
                else { const float rstd = rsqrtf(wave_sum(ss) * (1.0f / DM) + EPS); const int t_ = t4 + i;
                    u32x2* oh = (u32x2*)((t_ < TH ? XN + (size_t)t_ * DM : XNB + (size_t)(t_ - TH) * DM)) + lane;
#pragma unroll
                    for (int j = 0; j < 4; ++j) { { u32x2 wq; wq.x = cvt_pk_bf16(xv[i][j][0], xv[i][j][1]); wq.y = cvt_pk_bf16(xv[i][j][2], xv[i][j][3]); xq[64 * j] = wq; } const f32x4 y = xv[i][j] * rstd * na[j] + nsh[j]; u32x2 w; w.x = cvt_pk_bf16(y[0], y[1]); w.y = cvt_pk_bf16(y[2], y[3]); oh[64 * j] = w; } } }
          } }
        if (l + 1 < DEPTH) { TSEGB(13); GRIDBAR(); } TSEG(13);
    }
    if ((TPROBE_MASK | TPROBE2_MASK) != 0u && blockIdx.x == 0 && threadIdx.x == 0) { volatile LAS unsigned long long* tp_ = (volatile LAS unsigned long long*)LDSP(MISC_OFF + 64);
        const unsigned long long t0_ = __builtin_amdgcn_s_memrealtime(), w_ = TPROBE_AMP * tp_[1]; while (__builtin_amdgcn_s_memrealtime() - t0_ < w_) __builtin_amdgcn_s_sleep(8); }
}

#undef G
#undef MISC
extern "C" void kernel_launch(void* const* d_in, const int* in_sizes, int n_in, void* d_out, int out_size, void* d_ws, size_t ws_size, hipStream_t stream) {
    static int grid = 0;
    if (grid == 0) {
        if (n_in != 25 || out_size != T * DM || ws_size < WS_END) { fprintf(stderr, "kernel_launch: unexpected shapes (n_in %d, out %d, ws %zu < %zu)\n", n_in, out_size, ws_size, (size_t)WS_END); grid = -1; return; }
        int dev = 0, cus = 0;
        if (hipGetDevice(&dev) != hipSuccess || hipDeviceGetAttribute(&cus, hipDeviceAttributeMultiprocessorCount, dev) != hipSuccess) { grid = -1; return; }
        if (hipFuncSetAttribute((const void*)fwd_kernel, hipFuncAttributeMaxDynamicSharedMemorySize, LDS_BYTES) != hipSuccess) { fprintf(stderr, "kernel_launch: hipFuncSetAttribute failed\n"); grid = -1; return; }
        int per_cu = 0;
        if (hipOccupancyMaxActiveBlocksPerMultiprocessor(&per_cu, (const void*)fwd_kernel, NW * 64, LDS_BYTES) != hipSuccess || per_cu < 1) { fprintf(stderr, "kernel_launch: occupancy query says %d\n", per_cu); }
        (void)hipGetLastError();
        grid = cus;
    }
    if (grid < 0) return;
    (void)hipMemsetAsync((char*)d_ws + WS_CTL, 0, CTL_ZERO_BYTES, stream);
    Args a{};
    for (int i = 0; i < 25; ++i) a.in[i] = (const float*)d_in[i];
    a.out = (float*)d_out; a.ws = (unsigned char*)d_ws;
    for (int i = 0; i < 64; ++i) a.invR[i] = powf(10000.0f, -(float)(2 * i) / 128.0f);
    for (int i = 0; i < 16; ++i) a.invM[i] = powf(10000.0f, -(float)(2 * i) / 32.0f);
    hipLaunchKernelGGL(fwd_kernel, dim3(grid), dim3(NW * 64), LDS_BYTES, stream, a);
    const hipError_t le = hipPeekAtLastError();
    if (le != hipSuccess) fprintf(stderr, "kernel_launch: launch failed: %s\n", hipGetErrorName(le));
}
```

```cpp
#include <hip/hip_runtime.h>
#include <cstdio>
#include <cstdint>
#include <cmath>

#define LAS __attribute__((address_space(3)))
#define GAS __attribute__((address_space(1)))
typedef unsigned short bf16_t;
typedef short bf16x8 __attribute__((ext_vector_type(8)));
typedef short s16x4 __attribute__((ext_vector_type(4)));
typedef float f32x4 __attribute__((ext_vector_type(4)));
typedef float f32x2 __attribute__((ext_vector_type(2)));
typedef float f32x16 __attribute__((ext_vector_type(16)));
typedef unsigned u32x4 __attribute__((ext_vector_type(4)));
typedef unsigned u32x2 __attribute__((ext_vector_type(2)));

constexpr int DM = 1024, NBATCH = 4, SEQ = 8192, T = NBATCH * SEQ, TH = T / 2, DEPTH = 2;
constexpr int IN_TOTAL = 8352, ZLD = 8448;
constexpr int ZC_QLAT = 0, ZC_KVLAT = 384, ZC_KROPE = 640, ZC_CB = 672, ZC_CC = 1184, ZC_CX = 1696, ZC_RQ = 2208, ZC_RK = 2720, ZC_RV = 3232, ZC_RG = 4256, ZC_GL = 5280;
constexpr int NEXP = 32, EFF = 512;
constexpr int ACLD = 2112;
constexpr int XS_ROWS = 73728;
constexpr float EPS = 1e-6f;

constexpr size_t MiB = 1u << 20;
constexpr size_t WS_CTL = 0, CTL_ZERO_BYTES = 64 * 1024;
constexpr size_t WS_MODT = 1 * MiB;
constexpr size_t WS_RSTDQ = 1 * MiB + 256 * 1024, WS_RSTDKV = 1 * MiB + 512 * 1024;
constexpr size_t WS_PERM = 1 * MiB + 576 * 1024;
constexpr size_t WS_AFS = 23 * MiB;
constexpr size_t WS_ROUTE = 2 * MiB;
constexpr size_t WS_COSR = 3 * MiB, WS_SINR = 11 * MiB, WS_COSM = 19 * MiB, WS_SINM = 21 * MiB;
constexpr size_t WS_WMIX = 24 * MiB, WMIX_LAYER = 26 * MiB;
constexpr size_t WM_IN = 0, WM_UQ = 17 * MiB, WM_UKV = 18 * MiB, WM_CAT = 19 * MiB, WM_MIX = 24 * MiB;
constexpr size_t WS_ARENA = 76 * MiB;
constexpr size_t AR_XN = 0, AR_QB = 0, AR_Z = 32 * MiB, AR_KB = 296 * MiB, AR_VB = 320 * MiB, AR_AC = 336 * MiB, AR_KROPE = 402 * MiB  , AR_RS = 404 * MiB;
constexpr size_t AR_WEXP = 0, AR_H2 = 96 * MiB, AR_HID = 160 * MiB, AR_YS = 232 * MiB;
static_assert(WM_MIX + 2 * MiB <= WMIX_LAYER && WS_WMIX + 2 * WMIX_LAYER <= WS_ARENA && WM_CAT + (size_t)1024 * ACLD * 2 <= WM_MIX && AR_AC + (size_t)TH * ACLD * 2 <= AR_KROPE && AR_KROPE + (size_t)TH * 64 <= AR_RS && AR_RS + 64 * MiB <= 468 * MiB, "weight / arena map");
constexpr size_t AR_XNB = 468 * MiB;
constexpr size_t AR_XR = 500 * MiB;
constexpr size_t WS_END = WS_ARENA + 564 * MiB;
constexpr size_t WE_GU = 0, WE_D = (size_t)NEXP * 1024 * 1024 * 2;
constexpr int CW_TMO = 0, CW_CODE = 1, CW_BAR = 4096, CW_CNT = 8192;

constexpr int LDS_BYTES = 160 * 1024;
constexpr int MISC_OFF = LDS_BYTES - 1024;

#define RLX_AGENT __ATOMIC_RELAXED, __HIP_MEMORY_SCOPE_AGENT
__device__ __forceinline__ unsigned f2bf(float f) { unsigned u = __builtin_bit_cast(unsigned, f); return (u + 0x7fffu + ((u >> 16) & 1u)) >> 16; }
__device__ __forceinline__ unsigned pk2(float lo, float hi) { return f2bf(lo) | (f2bf(hi) << 16); }
typedef __bf16 bf16x2_t __attribute__((ext_vector_type(2)));
__device__ __forceinline__ unsigned cvt_pk_bf16(float lo, float hi) { f32x2 v = {lo, hi}; bf16x2_t b = __builtin_convertvector(v, bf16x2_t); return __builtin_bit_cast(unsigned, b); }
__device__ __forceinline__ float bflo(unsigned u) { return __builtin_bit_cast(float, u << 16); }
__device__ __forceinline__ float bfhi(unsigned u) { return __builtin_bit_cast(float, u & 0xffff0000u); }
__device__ __forceinline__ float bf1(bf16_t v) { return __builtin_bit_cast(float, (unsigned)v << 16); }
__device__ __forceinline__ float dpp_f(float v, int ctrl_sel) {
    const int x = __builtin_bit_cast(int, v); int r;
    if (ctrl_sel == 0) r = __builtin_amdgcn_update_dpp(x, x, 0xB1, 0xF, 0xF, false);
    else if (ctrl_sel == 1) r = __builtin_amdgcn_update_dpp(x, x, 0x4E, 0xF, 0xF, false);
    else if (ctrl_sel == 2) r = __builtin_amdgcn_update_dpp(x, x, 0x141, 0xF, 0xF, false);
    else r = __builtin_amdgcn_update_dpp(x, x, 0x140, 0xF, 0xF, false);
    return __builtin_bit_cast(float, r);
}
__device__ __forceinline__ float wave_sum(float v) {
    v += dpp_f(v, 0); v += dpp_f(v, 1); v += dpp_f(v, 2); v += dpp_f(v, 3);
    { auto rr = __builtin_amdgcn_permlane16_swap(__float_as_uint(v), __float_as_uint(v), false, false); v = __uint_as_float(rr[0]) + __uint_as_float(rr[1]); }
    { auto rr = __builtin_amdgcn_permlane32_swap(__float_as_uint(v), __float_as_uint(v), false, false); v = __uint_as_float(rr[0]) + __uint_as_float(rr[1]); }
    return v;
}
__device__ __forceinline__ float vmax3_(float a, float b, float c) { float r; asm("v_max3_f32 %0, %1, %2, %3" : "=v"(r) : "v"(a), "v"(b), "v"(c)); return r; }
__device__ __forceinline__ float vmax2_(float a, float b) { float r; asm("v_max_f32 %0, %1, %2" : "=v"(r) : "v"(a), "v"(b)); return r; }
__device__ __forceinline__ float sigmoidf_(float a) { return __builtin_amdgcn_rcpf(1.0f + __expf(-a)); }
__device__ __forceinline__ float siluf_(float a) { return a * __builtin_amdgcn_rcpf(1.0f + __expf(-a)); }

namespace pg8 {
constexpr int BM = 256, BK = 64, HALF = 128, HTB = HALF * BK * 2, STAGE_BYTES = 8 * HTB, NXCD = 8, WGM = 4;
__host__ __device__ __forceinline__ int lds_byte(int r, int c) { const int st = (r >> 4) * 2 + (c >> 5), rr = r & 15, cc = c & 31, ob = rr * 64 + cc * 2; return st * 1024 + (ob ^ (((ob >> 9) & 1) << 5)); }
__host__ __device__ __forceinline__ void stage_rc(int b, int& R, int& C) { const int st = b / 1024, sb = b % 1024, swz = sb ^ (((sb >> 9) & 1) << 5); R = (st >> 1) * 16 + swz / 64; C = (st & 1) * 32 + (swz % 64) / 2; }
__host__ __device__ __forceinline__ int perm32(int rho) { const int n = rho >> 4, i = rho & 15; return 8 * (i >> 2) + 4 * n + (i & 3); }

struct Unit { int pm, pn, e; };
struct Gemm { const bf16_t* A; const bf16_t* Bt; int lda, ldb, K; unsigned bes; const int* perm; };

struct StaticOrder {
    int nM, nN, nwg, G, c;
    __device__ void init(int M, int N, int G_, int c_) { nM = M / BM; nN = N / BM; nwg = nM * nN; G = G_; c = c_; }
    __device__ bool next(int i, Unit& u) const {
        const long L = (long)i * G + c; if (L >= nwg) return false;
        int wgid = (int)L; { const int q = nwg / NXCD, r = nwg % NXCD, xcd = wgid % NXCD, off = wgid / NXCD; wgid = (xcd < r ? xcd * (q + 1) : r * (q + 1) + (xcd - r) * q) + off; }
        const int nig = WGM * nN, gid = wgid / nig, fm = gid * WGM, gsz = (nM - fm) < WGM ? (nM - fm) : WGM;
        u.pm = fm + ((wgid % nig) % gsz); u.pn = (wgid % nig) / gsz; u.e = 0; return true;
    }
};
struct ExpertOrder {
    const LAS int* tp; int G, c;
    __device__ bool next(int i, Unit& u) const {
        const int L = i * G + c; const int nt = __builtin_amdgcn_readfirstlane(tp[32]);
        if (L >= nt * 4) return false;
        const int rt = L >> 2; u.pm = rt; u.pn = L & 3;
        int e = 0;
#pragma unroll
        for (int s = 16; s >= 1; s >>= 1) { const int v = __builtin_amdgcn_readfirstlane(tp[e + s]); if (v <= rt) e += s; }
        u.e = e; return true;
    }
};

typedef f32x4 Acc[2][2][4][2];

template <class Epi, class Sched, bool ALIGN_EPI, bool GATHER = false>
__device__ __forceinline__ void gemm_phase(LAS unsigned char* lds, const Gemm g, const Sched& S, const Epi& E) {
    int tid_ = threadIdx.x; asm volatile("" : "+v"(tid_));
    const int tid = tid_, wid = __builtin_amdgcn_readfirstlane(tid >> 6), lane = tid & 63, wr = wid >> 2, wc = wid & 3, fr = lane & 15, fq = lane >> 4;
    int K_ = g.K; asm volatile("" : "+s"(K_));
    const int nt = K_ / BK;
    unsigned voffA, voffB;
    { int R, C; stage_rc(tid * 16, R, C); const int Rb = Epi::PERM ? ((R & ~31) + perm32(R & 31)) : R;
        voffA = (unsigned)(R * g.lda + C) * 2u; voffB = (unsigned)(Rb * g.ldb + C) * 2u; }
    int ropar = 0; (void)ropar;
#define PG8_ROS(par) ((LAS u32x4*)(lds + STAGE_BYTES) + (par) * 512 + tid)
#define PG8_LOADRO(dst, pm_) do { int R_, C_; stage_rc(tid * 16, R_, C_); const int* pp_ = g.perm + (size_t)(pm_) * BM + R_; int t0_ = pp_[0], t1_ = pp_[64], t2_ = pp_[128], t3_ = pp_[192]; \
        asm volatile("s_waitcnt vmcnt(0)" : "+v"(t0_), "+v"(t1_), "+v"(t2_), "+v"(t3_) :: "memory"); const unsigned c2_ = (unsigned)C_ * 2u, ls_ = (unsigned)(g.lda * 2); \
        dst[0] = (unsigned)t0_ * ls_ + c2_; dst[1] = (unsigned)t1_ * ls_ + c2_; dst[2] = (unsigned)t2_ * ls_ + c2_; dst[3] = (unsigned)t3_ * ls_ + c2_; } while (0)
    constexpr unsigned kstep = BK * 2;
    const unsigned hstepA = (unsigned)(HALF * g.lda * 2), hstepB = (unsigned)(HALF * g.ldb * 2);
    const unsigned tstepA = 2 * hstepA, tstepB = 2 * hstepB, d64A = hstepA / 2, d64B = hstepB / 2;
    const unsigned ldsw = (unsigned)wid * 1024u;
    const unsigned ldsS = (unsigned)__builtin_amdgcn_readfirstlane((int)(unsigned)(uintptr_t)lds) + ldsw;
    const int aoff = lds_byte(wr * 64 + fr, fq * 8), boff = lds_byte(wc * 32 + fr, fq * 8);
#define PG8_SA(b, h) (((b) * 2 + (h)) * HTB)
#define PG8_SB(b, h) ((4 + (b) * 2 + (h)) * HTB)
#define PG8_STAGE_(bufoff, gbase, voff, d64) do { _Pragma("unroll") for (int _i = 0; _i < 2; ++_i) \
        __builtin_amdgcn_global_load_lds((const unsigned*)((const char*)(gbase) + (_i ? (d64) : 0u) + (voff)), (LAS unsigned*)(uintptr_t)(ldsS + (unsigned)(bufoff) + _i * 8192u), 16, 0, 0); } while (0)
#define PG8_STAGE(bufoff, gbase, voff) PG8_STAGE_(bufoff, gbase, voff, ((&(voff) == &voffA) ? d64A : d64B))
#define PG8_STAGE_A(b, h, kptr, RO) do { if constexpr (GATHER) { const u32x2 o2_ = *((const LAS u32x2*)PG8_ROS(RO) + (h)); _Pragma("unroll") for (int _i = 0; _i < 2; ++_i) \
        __builtin_amdgcn_global_load_lds((const unsigned*)((const char*)(kptr) + o2_[_i]), (LAS unsigned*)(uintptr_t)(ldsS + (unsigned)PG8_SA(b, h) + _i * 8192u), 16, 0, 0); } \
    else PG8_STAGE_(PG8_SA(b, h), (const char*)(kptr) + ((h) ? hstepA : 0u), voffA, d64A); } while (0)
#define PG8_STAGE_A2(b, h, kptr) PG8_STAGE_A(b, h, kptr, (last ? (ropar ^ 1) : ropar))
#define PG8_LDA(dst, b, h) do { _Pragma("unroll") for (int m = 0; m < 4; ++m) _Pragma("unroll") for (int k = 0; k < 2; ++k) dst[m][k] = *(const LAS bf16x8*)(lds + PG8_SA(b, h) + aoff + m * 2048 + k * 1024); } while (0)
#define PG8_LDB(dst, b, h) do { _Pragma("unroll") for (int n = 0; n < 2; ++n) _Pragma("unroll") for (int k = 0; k < 2; ++k) dst[n][k] = *(const LAS bf16x8*)(lds + PG8_SB(b, h) + boff + n * 2048 + k * 1024); } while (0)
#define PG8_MMA(ai, bj, At, Bt) do { __builtin_amdgcn_s_setprio(1); _Pragma("unroll") for (int m = 0; m < 4; ++m) _Pragma("unroll") for (int n = 0; n < 2; ++n) _Pragma("unroll") for (int k = 0; k < 2; ++k) \
        acc[ai][bj][m][n] = __builtin_amdgcn_mfma_f32_16x16x32_bf16(Bt[n][k], At[m][k], acc[ai][bj][m][n], 0, 0, 0); __builtin_amdgcn_s_setprio(0); } while (0)
#define PG8_WAIT_V(n) asm volatile("s_waitcnt vmcnt(" #n ")" ::: "memory")
#define PG8_WAIT_L(n) asm volatile("s_waitcnt lgkmcnt(" #n ")" ::: "memory")
#define PG8_BAR __builtin_amdgcn_s_barrier()
#define PG8_SCHED __builtin_amdgcn_sched_barrier(0)
#define PG8_WAIT_VR(rl) do { if constexpr (Epi::NST == 16) asm volatile("s_waitcnt vmcnt(24)\n\ts_cmp_lg_u32 %0, 0\n\ts_cbranch_scc1 1f\n\ts_waitcnt vmcnt(8)\n1:" :: "s"(rl) : "scc", "memory"); \
        else asm volatile("s_waitcnt vmcnt(16)\n\ts_cmp_lg_u32 %0, 0\n\ts_cbranch_scc1 1f\n\ts_waitcnt vmcnt(8)\n1:" :: "s"(rl) : "scc", "memory"); } while (0)
    int uf_ = 0;
    Unit cur, nxt; int ui = 0;
    if (!S.next(0, cur)) return;
    Acc acc;
#pragma unroll
    for (int a = 0; a < 2; ++a)
#pragma unroll
        for (int b = 0; b < 2; ++b)
#pragma unroll
            for (int m = 0; m < 4; ++m)
#pragma unroll
                for (int n = 0; n < 2; ++n) acc[a][b][m][n] = (f32x4){0.f, 0.f, 0.f, 0.f};
    bf16x8 At[4][2], B0[2][2], B1[2][2];
    if constexpr (GATHER) { unsigned t4_[4]; PG8_LOADRO(t4_, cur.pm); *PG8_ROS(0) = (u32x4){t4_[0], t4_[1], t4_[2], t4_[3]}; asm volatile("s_waitcnt lgkmcnt(0)" ::: "memory"); }
    const char* cA = (const char*)g.A + (GATHER ? (size_t)0 : (size_t)((unsigned)cur.pm * tstepA)); const char* cB = (const char*)g.Bt + (size_t)((unsigned)cur.e * g.bes + (unsigned)cur.pn * tstepB);
    PG8_STAGE(PG8_SB(0, 0), cB, voffB); PG8_STAGE(PG8_SB(0, 1), cB + hstepB, voffB); PG8_STAGE_A(0, 0, cA, ropar); PG8_STAGE_A(0, 1, cA, ropar);
    if (wr == 1) PG8_BAR;
    PG8_WAIT_V(2); PG8_BAR;
    PG8_STAGE(PG8_SB(1, 0), cB + kstep, voffB); PG8_STAGE_A(1, 0, cA + kstep, ropar); PG8_STAGE(PG8_SB(1, 1), cB + hstepB + kstep, voffB);
    PG8_WAIT_V(6); PG8_BAR;
    for (;;) {
        const bool has_next = S.next(ui + 1, nxt);
        if constexpr (GATHER) { u32x4 n4_ = *PG8_ROS(ropar); if (has_next) { unsigned t4_[4]; PG8_LOADRO(t4_, nxt.pm); n4_ = (u32x4){t4_[0], t4_[1], t4_[2], t4_[3]}; } *PG8_ROS(ropar ^ 1) = n4_; }
        const char* nA = (has_next && !GATHER) ? (const char*)g.A + (size_t)((unsigned)nxt.pm * tstepA) : (GATHER ? (const char*)g.A : cA); const char* nB = has_next ? (const char*)g.Bt + (size_t)((unsigned)nxt.e * g.bes + (unsigned)nxt.pn * tstepB) : cB;
        int t = 0;
        do {
            const bool last = (t == nt - 2);
            const char* a1 = cA + (unsigned)(t + 1) * kstep;
            const char* a2 = last ? nA : cA + (unsigned)(t + 2) * kstep; const char* b2 = last ? nB : cB + (unsigned)(t + 2) * kstep;
            const char* a3 = a2 + kstep; const char* b3 = b2 + kstep;
            if constexpr (Epi::HAS_MID) { if (t == Epi::MID0 || t == Epi::MID1) E.mid(acc, cur, t, wr, wc, fr, fq); }
            int rl = t; asm volatile("" : "+s"(rl)); rl = (rl == 0) & uf_;
            PG8_LDB(B0, 0, 0); PG8_LDB(B1, 0, 1); PG8_SCHED; PG8_LDA(At, 0, 0); PG8_STAGE_A(1, 1, a1, ropar);
            PG8_WAIT_VR(rl);
            PG8_WAIT_L(0); PG8_BAR; PG8_MMA(0, 0, At, B0); PG8_MMA(0, 1, At, B1); PG8_BAR; PG8_SCHED;
            PG8_LDA(At, 0, 1); PG8_STAGE(PG8_SB(0, 0), b2, voffB); PG8_STAGE(PG8_SB(0, 1), b2 + hstepB, voffB); PG8_STAGE_A2(0, 0, a2);
            PG8_WAIT_VR(rl);
            PG8_WAIT_L(0); PG8_BAR; PG8_MMA(1, 0, At, B0); PG8_MMA(1, 1, At, B1); PG8_BAR; PG8_SCHED;
            PG8_LDB(B0, 1, 0); PG8_LDB(B1, 1, 1); PG8_SCHED; PG8_LDA(At, 1, 0); PG8_STAGE_A2(0, 1, a2);
            PG8_WAIT_V(8); PG8_WAIT_L(0); PG8_BAR; PG8_MMA(0, 0, At, B0); PG8_MMA(0, 1, At, B1); PG8_BAR; PG8_SCHED;
            PG8_LDA(At, 1, 1); PG8_STAGE(PG8_SB(1, 0), b3, voffB); PG8_STAGE(PG8_SB(1, 1), b3 + hstepB, voffB); PG8_STAGE_A2(1, 0, a3);
            PG8_WAIT_V(8); PG8_WAIT_L(0); PG8_BAR; PG8_MMA(1, 0, At, B0); PG8_MMA(1, 1, At, B1); PG8_BAR; PG8_SCHED;
            t += 2;
        } while (t < nt);
        if constexpr (ALIGN_EPI) { if (wr == 0) PG8_BAR; }
        E(acc, cur, wr, wc, fr, fq);
        if (!has_next) break;
#pragma unroll
        for (int a = 0; a < 2; ++a)
#pragma unroll
            for (int b = 0; b < 2; ++b)
#pragma unroll
                for (int m = 0; m < 4; ++m)
#pragma unroll
                    for (int n = 0; n < 2; ++n) acc[a][b][m][n] = (f32x4){0.f, 0.f, 0.f, 0.f};
        cur = nxt; cA = nA; cB = nB; ++ui;
        if constexpr (GATHER) ropar ^= 1; else uf_ = 1;
        if constexpr (ALIGN_EPI) { if (wr == 1) PG8_BAR; }
    }
    PG8_WAIT_V(0); __builtin_amdgcn_s_waitcnt(0x0F70);
    if constexpr (!ALIGN_EPI) { if (wr == 0) PG8_BAR; }
    PG8_BAR;
#undef PG8_SA
#undef PG8_SB
#undef PG8_STAGE
#undef PG8_STAGE_A
#undef PG8_STAGE_A2
#undef PG8_LOADRO
#undef PG8_ROS
#undef PG8_STAGE_
#undef PG8_LDA
#undef PG8_LDB
#undef PG8_MMA
#undef PG8_WAIT_V
#undef PG8_WAIT_VR
#undef PG8_WAIT_L
#undef PG8_BAR
#undef PG8_SCHED
}

template <int MODE> struct EpiBf16 {
    static constexpr bool PERM = true, HAS_MID = false; static constexpr int MID0 = -1, MID1 = -1, NST = 16;
    bf16_t* O; int ldc; const float* rs; bf16_t* O2; int ldc2;
    __device__ __forceinline__ void operator()(const Acc& acc, const Unit& u, int wr, int wc, int fr, int fq) const {
        asm volatile("" : "+v"(fr), "+v"(fq));
        const int row0 = u.pm * BM + wr * 64 + fr;
        float sv[2][4];
#pragma unroll
        for (int ai = 0; ai < 2; ++ai)
#pragma unroll
            for (int m = 0; m < 4; ++m) sv[ai][m] = rs ? rs[row0 + ai * HALF + m * 16] : 1.0f;
        if (rs) asm volatile("s_waitcnt vmcnt(0)" : "+v"(sv[0][0]), "+v"(sv[0][1]), "+v"(sv[0][2]), "+v"(sv[0][3]), "+v"(sv[1][0]), "+v"(sv[1][1]), "+v"(sv[1][2]), "+v"(sv[1][3]) :: "memory");
#pragma unroll
        for (int ai = 0; ai < 2; ++ai)
#pragma unroll
            for (int m = 0; m < 4; ++m) { const int row = row0 + ai * HALF + m * 16; const float s = sv[ai][m];
#pragma unroll
                for (int bj = 0; bj < 2; ++bj) { const int col = u.pn * BM + bj * HALF + wc * 32 + 8 * fq;
                    const f32x4 v0 = acc[ai][bj][m][0] * s, v1 = acc[ai][bj][m][1] * s;
                    u32x4 w; w.x = cvt_pk_bf16(v0[0], v0[1]); w.y = cvt_pk_bf16(v0[2], v0[3]); w.z = cvt_pk_bf16(v1[0], v1[1]); w.w = cvt_pk_bf16(v1[2], v1[3]);
                    bf16_t* dst;
                    if (MODE == 0) dst = O + (size_t)row * ldc + col;
                    else { const int head = u.pn * 2 + bj; dst = (wc < 2) ? O + (size_t)row * 768 + head * 96 + wc * 32 + 8 * fq : O2 + (size_t)row * 512 + head * 64 + (wc - 2) * 32 + 8 * fq; }
                    *(u32x4*)dst = w; } }
    }
};
struct EpiGU {
    static constexpr bool PERM = true, HAS_MID = false; static constexpr int MID0 = -1, MID1 = -1, NST = 8;
    bf16_t* O;
    __device__ __forceinline__ void operator()(const Acc& acc, const Unit& u, int wr, int wc, int fr, int fq) const {
        asm volatile("" : "+v"(fr), "+v"(fq));
        const int row0 = u.pm * BM + wr * 64 + fr; const int col = u.pn * 128 + wc * 32 + 8 * fq;
#pragma unroll
        for (int ai = 0; ai < 2; ++ai)
#pragma unroll
            for (int m = 0; m < 4; ++m) { const int row = row0 + ai * HALF + m * 16;
                float h[8];
#pragma unroll
                for (int n = 0; n < 2; ++n)
#pragma unroll
                    for (int j = 0; j < 4; ++j) { const float gv = acc[ai][0][m][n][j], uv = acc[ai][1][m][n][j]; h[n * 4 + j] = siluf_(gv) * uv; }
                u32x4 w; w.x = cvt_pk_bf16(h[0], h[1]); w.y = cvt_pk_bf16(h[2], h[3]); w.z = cvt_pk_bf16(h[4], h[5]); w.w = cvt_pk_bf16(h[6], h[7]);
                *(u32x4*)(O + (size_t)row * EFF + col) = w; }
    }
};
struct EpiMerge {
    static constexpr float GLZ = 43.28085f;
    static constexpr bool PERM = true, HAS_MID = true; static constexpr int MID0 = 8, MID1 = 16, NST = 16;
    const bf16_t* Z; bf16_t* O;
    __device__ __forceinline__ void mid(Acc& acc, const Unit& u, int t, int wr, int wc, int fr, int fq) const {
        asm volatile("" : "+v"(fr), "+v"(fq));
        const int gi = (t == 8) ? 0 : 1; const int row0 = u.pm * BM + wr * 64 + fr;
#pragma unroll
        for (int ai = 0; ai < 2; ++ai) {
            u32x4 ga[4][2], gb[4][2];
#pragma unroll
            for (int m = 0; m < 4; ++m)
#pragma unroll
                for (int bj = 0; bj < 2; ++bj) { const int row = row0 + ai * HALF + m * 16, col = u.pn * BM + bj * HALF + wc * 32 + 8 * fq;
                    const bf16_t* p = Z + (size_t)row * ZLD + ZC_GL + gi * 1024 + col; ga[m][bj] = *(const u32x4*)p; gb[m][bj] = *(const u32x4*)(p + 1024); }
#pragma unroll
            for (int m = 0; m < 4; ++m)
#pragma unroll
                for (int bj = 0; bj < 2; ++bj) { float r[8];
#pragma unroll
                    for (int j = 0; j < 4; ++j) { const unsigned wa = ga[m][bj][j], wb = gb[m][bj][j];
                        const float a0 = __builtin_amdgcn_fmed3f(bflo(wa), -GLZ, GLZ), a1 = __builtin_amdgcn_fmed3f(bfhi(wa), -GLZ, GLZ), b0 = __builtin_amdgcn_fmed3f(bflo(wb), -GLZ, GLZ), b1 = __builtin_amdgcn_fmed3f(bfhi(wb), -GLZ, GLZ);
                        r[2 * j] = (1.0f + __builtin_amdgcn_exp2f(b0)) * __builtin_amdgcn_rcpf(1.0f + __builtin_amdgcn_exp2f(a0)); r[2 * j + 1] = (1.0f + __builtin_amdgcn_exp2f(b1)) * __builtin_amdgcn_rcpf(1.0f + __builtin_amdgcn_exp2f(a1)); }
                    acc[ai][bj][m][0] = acc[ai][bj][m][0] * (f32x4){r[0], r[1], r[2], r[3]}; acc[ai][bj][m][1] = acc[ai][bj][m][1] * (f32x4){r[4], r[5], r[6], r[7]}; }
            asm volatile("" : "+v"(acc[ai][0][0][0]), "+v"(acc[ai][1][3][1]) :: "memory");
        }
    }
    __device__ __forceinline__ void operator()(const Acc& acc, const Unit& u, int wr, int wc, int fr, int fq) const {
        asm volatile("" : "+v"(fr), "+v"(fq));
        const int row0 = u.pm * BM + wr * 64 + fr;
#pragma unroll
        for (int ai = 0; ai < 2; ++ai) { u32x4 gcv[4][2];
#pragma unroll
            for (int m = 0; m < 4; ++m)
#pragma unroll
                for (int bj = 0; bj < 2; ++bj) gcv[m][bj] = *(const u32x4*)(Z + (size_t)(row0 + ai * HALF + m * 16) * ZLD + ZC_GL + 2048 + u.pn * BM + bj * HALF + wc * 32 + 8 * fq);
            asm volatile("s_waitcnt vmcnt(0)" : "+v"(gcv[0][0]), "+v"(gcv[0][1]), "+v"(gcv[1][0]), "+v"(gcv[1][1]), "+v"(gcv[2][0]), "+v"(gcv[2][1]), "+v"(gcv[3][0]), "+v"(gcv[3][1]) :: "memory");
#pragma unroll
            for (int m = 0; m < 4; ++m) { const int row = row0 + ai * HALF + m * 16;
#pragma unroll
                for (int bj = 0; bj < 2; ++bj) { const int col = u.pn * BM + bj * HALF + wc * 32 + 8 * fq;
                    const u32x4 gc = gcv[m][bj];
                    float r[8];
#pragma unroll
                    for (int j = 0; j < 4; ++j) { const unsigned w = gc[j]; r[2 * j] = __builtin_amdgcn_rcpf(1.0f + __builtin_amdgcn_exp2f(__builtin_amdgcn_fmed3f(bflo(w), -GLZ, GLZ))); r[2 * j + 1] = __builtin_amdgcn_rcpf(1.0f + __builtin_amdgcn_exp2f(__builtin_amdgcn_fmed3f(bfhi(w), -GLZ, GLZ))); }
                    const f32x4 v0 = acc[ai][bj][m][0] * (f32x4){r[0], r[1], r[2], r[3]}, v1 = acc[ai][bj][m][1] * (f32x4){r[4], r[5], r[6], r[7]};
                    u32x4 w; w.x = cvt_pk_bf16(v0[0], v0[1]); w.y = cvt_pk_bf16(v0[2], v0[3]); w.z = cvt_pk_bf16(v1[0], v1[1]); w.w = cvt_pk_bf16(v1[2], v1[3]);
                    *(u32x4*)(O + (size_t)row * DM + col) = w; } } }
    }
};
struct EpiResid {
    static constexpr bool PERM = true, HAS_MID = false; static constexpr int MID0 = -1, MID1 = -1, NST = 16;
    const float* xold32; const bf16_t* xold16; bf16_t* xnew; const float* gate;
    template <bool F32> __device__ __forceinline__ void run(const Acc& acc, const Unit& u, int wr, int wc, int fr, int fq) const {
        const int row0 = u.pm * BM + wr * 64 + fr; const float* gt = gate + (size_t)((u.pm * BM) / SEQ) * 6144;
#pragma unroll
        for (int bj = 0; bj < 2; ++bj) { const int col = u.pn * BM + bj * HALF + wc * 32 + 8 * fq; const f32x4 g0 = *(const f32x4*)(gt + col), g1 = *(const f32x4*)(gt + col + 4);
            if constexpr (F32) {
#pragma unroll
                for (int ai = 0; ai < 2; ++ai) { f32x4 x0[4], x1[4];
#pragma unroll
                    for (int m = 0; m < 4; ++m) { const size_t off = (size_t)(row0 + ai * HALF + m * 16) * DM + col; x0[m] = *(const f32x4*)(xold32 + off); x1[m] = *(const f32x4*)(xold32 + off + 4); }
                    asm volatile("s_waitcnt vmcnt(0)" : "+v"(x0[0]), "+v"(x1[0]), "+v"(x0[1]), "+v"(x1[1]), "+v"(x0[2]), "+v"(x1[2]), "+v"(x0[3]), "+v"(x1[3]) :: "memory");
#pragma unroll
                    for (int m = 0; m < 4; ++m) { const size_t off = (size_t)(row0 + ai * HALF + m * 16) * DM + col;
                        const f32x4 y0 = x0[m] + g0 * acc[ai][bj][m][0], y1 = x1[m] + g1 * acc[ai][bj][m][1];
                        u32x4 w; w.x = cvt_pk_bf16(y0[0], y0[1]); w.y = cvt_pk_bf16(y0[2], y0[3]); w.z = cvt_pk_bf16(y1[0], y1[1]); w.w = cvt_pk_bf16(y1[2], y1[3]);
                        *(u32x4*)(xnew + off) = w; } }
            } else { u32x4 r[2][4];
#pragma unroll
                for (int ai = 0; ai < 2; ++ai)
#pragma unroll
                    for (int m = 0; m < 4; ++m) r[ai][m] = *(const u32x4*)(xold16 + (size_t)(row0 + ai * HALF + m * 16) * DM + col);
                asm volatile("s_waitcnt vmcnt(0)" : "+v"(r[0][0]), "+v"(r[0][1]), "+v"(r[0][2]), "+v"(r[0][3]), "+v"(r[1][0]), "+v"(r[1][1]), "+v"(r[1][2]), "+v"(r[1][3]) :: "memory");
#pragma unroll
                for (int ai = 0; ai < 2; ++ai)
#pragma unroll
                    for (int m = 0; m < 4; ++m) { const size_t off = (size_t)(row0 + ai * HALF + m * 16) * DM + col; const u32x4 q = r[ai][m];
                        const f32x4 x0 = (f32x4){bflo(q.x), bfhi(q.x), bflo(q.y), bfhi(q.y)}, x1 = (f32x4){bflo(q.z), bfhi(q.z), bflo(q.w), bfhi(q.w)};
                        const f32x4 y0 = x0 + g0 * acc[ai][bj][m][0], y1 = x1 + g1 * acc[ai][bj][m][1];
                        u32x4 w; w.x = cvt_pk_bf16(y0[0], y0[1]); w.y = cvt_pk_bf16(y0[2], y0[3]); w.z = cvt_pk_bf16(y1[0], y1[1]); w.w = cvt_pk_bf16(y1[2], y1[3]);
                        *(u32x4*)(xnew + off) = w; } } }
    }
    __device__ __forceinline__ void operator()(const Acc& acc, const Unit& u, int wr, int wc, int fr, int fq) const {
        asm volatile("" : "+v"(fr), "+v"(fq));
        if (xold32) run<true>(acc, u, wr, wc, fr, fq); else run<false>(acc, u, wr, wc, fr, fq);
    }
};
}

#define XB_TMO      128
#define XB_XCNT(j)  (256  + 64 * (j))
#define XB_XSUB(j)  (1280 + 64 * (j))
#define XB_XGEN(j)  (2304 + 64 * (j))
#define XB_TOP      3328
#define XB_TOPGEN   3392
#define XCD_BAR_WORDS 3456
#define XB_SPIN_CAP (1u << 22)

__device__ __forceinline__ unsigned xb_ld(unsigned* p)              { return __hip_atomic_load(p, __ATOMIC_RELAXED, __HIP_MEMORY_SCOPE_AGENT); }
__device__ __forceinline__ unsigned xb_add(unsigned* p, unsigned v) { return __hip_atomic_fetch_add(p, v, __ATOMIC_RELAXED, __HIP_MEMORY_SCOPE_AGENT); }
__device__ __forceinline__ unsigned xb_xcc_id() { return (unsigned)__builtin_amdgcn_s_getreg((3 << 11) | 20) & 0xFu; }
#define XB_SPIN(cond, bar) do { unsigned _sp = 0; while (cond) { __builtin_amdgcn_s_sleep(1); \
    if ((++_sp & 255u) == 0u) { if (xb_ld(&(bar)[XB_TMO])) break; if (_sp > XB_SPIN_CAP) { atomicAdd(&(bar)[XB_TMO], 1u); break; } } } } while (0)

struct XcdBarrier { unsigned* bar; unsigned x; volatile LAS unsigned* st; };

__device__ __forceinline__ XcdBarrier xcd_barrier_post(unsigned* bar, volatile LAS unsigned* st) {
    XcdBarrier b; b.bar = bar; b.x = xb_xcc_id(); b.st = st;
    if (threadIdx.x == 0) (void)xb_add(&bar[XB_XCNT(b.x)], 1u);
    return b;
}
__device__ __forceinline__ void xcd_barrier_complete(unsigned* bar, unsigned x, unsigned& nloc, unsigned& nx) {
    const unsigned G = gridDim.x * gridDim.y * gridDim.z;
    unsigned sum, cnt, mine, sp = 0u;
    for (;;) {
        sum = 0u; cnt = 0u; mine = 0u;
#pragma unroll
        for (unsigned j = 0; j < 16; ++j) { const unsigned c = xb_ld(&bar[XB_XCNT(j)]); sum += c; cnt += (c > 0u) ? 1u : 0u; mine = (j == x) ? c : mine; }
        if (sum == G) break;
        __builtin_amdgcn_s_sleep(1);
        if ((++sp & 255u) == 0u) { if (xb_ld(&bar[XB_TMO])) break; if (sp > XB_SPIN_CAP) { atomicAdd(&bar[XB_TMO], 1u); break; } }
    }
    nloc = mine > 0u ? mine : 1u; nx = cnt > 0u ? cnt : 1u;
}
__device__ __forceinline__ void xcd_barrier(const XcdBarrier& b) {
    asm volatile("s_waitcnt vmcnt(0)" ::: "memory");
    __syncthreads();
    if (threadIdx.x == 0) {
        unsigned* bar = b.bar;
        __builtin_amdgcn_s_waitcnt(0);
        unsigned nloc = b.st[0], nx = b.st[1];
        if (nloc == 0u) { xcd_barrier_complete(bar, b.x, nloc, nx); b.st[0] = nloc; b.st[1] = nx; }
        const unsigned old = xb_add(&bar[XB_XSUB(b.x)], 1u);
        const unsigned gen = old / nloc;
        if (old + 1u == (gen + 1u) * nloc) {
            __builtin_amdgcn_fence(__ATOMIC_RELEASE, "agent");
            asm volatile("s_waitcnt vmcnt(0)" ::: "memory");
            const unsigned og = xb_add(&bar[XB_TOP], 1u);
            const unsigned tg = og / nx;
            if (og + 1u == (tg + 1u) * nx) xb_add(&bar[XB_TOPGEN], 1u);
            else XB_SPIN(xb_ld(&bar[XB_TOPGEN]) == tg, bar);
            __builtin_amdgcn_fence(__ATOMIC_ACQUIRE, "agent");
            xb_add(&bar[XB_XGEN(b.x)], 1u);
            asm volatile("s_waitcnt vmcnt(0)" ::: "memory");
        } else {
            XB_SPIN(xb_ld(&bar[XB_XGEN(b.x)]) == gen, bar);
            __builtin_amdgcn_fence(__ATOMIC_ACQUIRE, "agent");
            asm volatile("s_waitcnt vmcnt(0)" ::: "memory");
        }
    }
    __syncthreads();
}

namespace att {
constexpr int KSL = 12288, VSL = 8192, KS0 = 0, VS0 = 3 * KSL, WSF = VS0 + 3 * VSL, OST = WSF + 2048, LDS_NEED = OST + 8 * 4096;
constexpr float QSCALE = 0.10206207261596575f * 1.4426950408889634f;
__device__ __forceinline__ int crow(int r, int hi) { return (r & 3) + 8 * (r >> 2) + 4 * hi; }
#define MFMA32(a, b, c) __builtin_amdgcn_mfma_f32_32x32x16_bf16((a), (b), (c), 0, 0, 0)

__device__ __forceinline__ void pv(f32x16* o, int vb, bf16x8 pa0, bf16x8 pa1, bf16x8 pa2, bf16x8 pa3) {
    { const bf16x8 ones = {0x3F80, 0x3F80, 0x3F80, 0x3F80, 0x3F80, 0x3F80, 0x3F80, 0x3F80};
      o[2] = MFMA32(pa0, ones, o[2]); o[2] = MFMA32(pa1, ones, o[2]); o[2] = MFMA32(pa2, ones, o[2]); o[2] = MFMA32(pa3, ones, o[2]); }
#pragma unroll
    for (int d0 = 0; d0 < 2; ++d0) { s16x4 lo[4], hi[4];
#pragma unroll
        for (int ks = 0; ks < 4; ++ks) {
            asm volatile("ds_read_b64_tr_b16 %0,%1 offset:%c2" : "=&v"(lo[ks]) : "v"(vb), "i"(d0 * 4096 + ks * 1024) : "memory");
            asm volatile("ds_read_b64_tr_b16 %0,%1 offset:%c2" : "=&v"(hi[ks]) : "v"(vb), "i"(d0 * 4096 + ks * 1024 + 512) : "memory"); }
        asm volatile("s_waitcnt lgkmcnt(0)" ::: "memory"); __builtin_amdgcn_sched_barrier(0);
#define PK(k) (bf16x8){lo[k][0], lo[k][1], lo[k][2], lo[k][3], hi[k][0], hi[k][1], hi[k][2], hi[k][3]}
        o[d0] = MFMA32(pa0, PK(0), o[d0]); o[d0] = MFMA32(pa1, PK(1), o[d0]); o[d0] = MFMA32(pa2, PK(2), o[d0]); o[d0] = MFMA32(pa3, PK(3), o[d0]);
#undef PK
    }
}

template <int THR> __device__ __forceinline__ void attn_unit(int bl, int h, int qb, const bf16_t* Q, const bf16_t* __restrict__ K, const bf16_t* __restrict__ KR, const bf16_t* __restrict__ V, bf16_t* O,
                                          const float* cosM, const float* sinM, int tokbase, LAS char* shm) {
    int tid_ = threadIdx.x; asm volatile("" : "+v"(tid_));
    const int tid = tid_, lane = tid & 63, r32 = lane & 31, hi = lane >> 5; const int wid = __builtin_amdgcn_readfirstlane(tid >> 6);
    const long rowbase = (long)bl * SEQ; const int q0 = qb * 256;
    const unsigned lds0 = (unsigned)(uintptr_t)shm;
    const unsigned shmS = (unsigned)__builtin_amdgcn_readfirstlane((int)lds0);
    LAS float* wsf = (LAS float*)(shm + WSF) + wid * 64;
    const long qrow = rowbase + q0 + wid * 32 + r32;
    const bf16_t* qp = Q + qrow * 768 + h * 96;
    bf16x8 qr[6];
#pragma unroll
    for (int d0 = 0; d0 < 4; ++d0) { const u32x4 raw = *(const u32x4*)(qp + d0 * 16 + hi * 8); u32x4 w;
#pragma unroll
        for (int j = 0; j < 4; ++j) w[j] = cvt_pk_bf16(bflo(raw[j]) * QSCALE, bfhi(raw[j]) * QSCALE);
        qr[d0] = __builtin_bit_cast(bf16x8, w); }
    { const u32x4 r1 = *(const u32x4*)(qp + 64 + hi * 8), r2 = *(const u32x4*)(qp + 80 + hi * 8);
      const float* cp = cosM + (size_t)(tokbase + qrow) * 16 + hi * 8; const float* sp = sinM + (size_t)(tokbase + qrow) * 16 + hi * 8;
      const f32x4 c0 = *(const f32x4*)cp, c1 = *(const f32x4*)(cp + 4), s0 = *(const f32x4*)sp, s1 = *(const f32x4*)(sp + 4);
      float cs[8] = {c0[0], c0[1], c0[2], c0[3], c1[0], c1[1], c1[2], c1[3]}, sn[8] = {s0[0], s0[1], s0[2], s0[3], s1[0], s1[1], s1[2], s1[3]};
      u32x4 w1, w2;
#pragma unroll
      for (int j = 0; j < 4; ++j) { const float a0 = bflo(r1[j]), a1 = bfhi(r1[j]), b0 = bflo(r2[j]), b1 = bfhi(r2[j]);
          w1[j] = cvt_pk_bf16((a0 * cs[2 * j] - b0 * sn[2 * j]) * QSCALE, (a1 * cs[2 * j + 1] - b1 * sn[2 * j + 1]) * QSCALE);
          w2[j] = cvt_pk_bf16((a0 * sn[2 * j] + b0 * cs[2 * j]) * QSCALE, (a1 * sn[2 * j + 1] + b1 * cs[2 * j + 1]) * QSCALE); }
      qr[4] = __builtin_bit_cast(bf16x8, w1); qr[5] = __builtin_bit_cast(bf16x8, w2); }
    const bf16_t* Kh = K + rowbase * 768 + h * 96; const bf16_t* Vh = V + rowbase * 512 + h * 64;
    const bf16_t* ksrcA = Kh + (long)lane * 768 + wid * 8;
    const bf16_t* ksrcB = KR + (rowbase + lane) * 32 + wid * 8;
    const bf16_t* vsrc = Vh + (long)(16 * (wid & 3) + (lane >> 2)) * 512 + (wid >> 2) * 32 + (lane & 3) * 8;
    const int NT = q0 / 64 + 4, tq = q0 / 64 + (wid >> 1);
#define ATT_DMA_K(t, kb_) do { __builtin_amdgcn_global_load_lds((const unsigned*)(ksrcA + (long)(t) * 64 * 768), (LAS unsigned*)(uintptr_t)(shmS + (unsigned)(kb_) + (unsigned)wid * 1024u), 16, 0, 0); \
        if (wid < 4) __builtin_amdgcn_global_load_lds((const unsigned*)(ksrcB + (long)(t) * 64 * 32), (LAS unsigned*)(uintptr_t)(shmS + (unsigned)(kb_) + (8u + (unsigned)wid) * 1024u), 16, 0, 0); } while (0)
#define ATT_DMA_V(t, vb_) __builtin_amdgcn_global_load_lds((const unsigned*)(vsrc + (long)(t) * 64 * 512), (LAS unsigned*)(uintptr_t)(shmS + (unsigned)(vb_) + (unsigned)wid * 1024u), 16, 0, 0)
#define ATT_QK(P0, P1, kb_, C) do { const LAS char* kbp = shm + (kb_) + hi * 1024 + r32 * 16; bf16x8 kf_[12]; \
        _Pragma("unroll") for (int d0 = 0; d0 < 6; ++d0) { kf_[2 * d0] = *(const LAS bf16x8*)(kbp + d0 * 2048); kf_[2 * d0 + 1] = *(const LAS bf16x8*)(kbp + d0 * 2048 + 512); } \
        __builtin_amdgcn_sched_barrier(0); \
        P0 = MFMA32(kf_[0], qr[0], C); P1 = MFMA32(kf_[1], qr[0], C); \
        _Pragma("unroll") for (int d0 = 1; d0 < 6; ++d0) { P0 = MFMA32(kf_[2 * d0], qr[d0], P0); P1 = MFMA32(kf_[2 * d0 + 1], qr[d0], P1); } } while (0)
#define ATT_VRD(lo, hi, vb, d0) do { _Pragma("unroll") for (int ks = 0; ks < 4; ++ks) { \
        asm volatile("ds_read_b64_tr_b16 %0,%1 offset:%c2" : "=&v"(lo[ks]) : "v"(vb), "i"((d0) * 4096 + ks * 1024) : "memory"); \
        asm volatile("ds_read_b64_tr_b16 %0,%1 offset:%c2" : "=&v"(hi[ks]) : "v"(vb), "i"((d0) * 4096 + ks * 1024 + 512) : "memory"); } } while (0)
#define ATT_PK(lo, hi, k) (bf16x8){lo[k][0], lo[k][1], lo[k][2], lo[k][3], hi[k][0], hi[k][1], hi[k][2], hi[k][3]}
#define ATT_MX3(a, b, c) vmax3_((a), (b), (c))
#define ATT_ROWMAX(P0, P1, out) do { float ma_ = ATT_MX3(P0[0], P0[1], P0[2]), mb_ = ATT_MX3(P0[8], P0[9], P0[10]), mc_ = ATT_MX3(P1[0], P1[1], P1[2]), md_ = ATT_MX3(P1[8], P1[9], P1[10]);        \
        ma_ = ATT_MX3(ma_, P0[3], P0[4]); mb_ = ATT_MX3(mb_, P0[11], P0[12]); mc_ = ATT_MX3(mc_, P1[3], P1[4]); md_ = ATT_MX3(md_, P1[11], P1[12]); \
        ma_ = ATT_MX3(ma_, P0[5], P0[6]); mb_ = ATT_MX3(mb_, P0[13], P0[14]); mc_ = ATT_MX3(mc_, P1[5], P1[6]); md_ = ATT_MX3(md_, P1[13], P1[14]); \
        ma_ = ATT_MX3(ma_, P0[7], mb_); mc_ = ATT_MX3(mc_, P1[7], md_); ma_ = ATT_MX3(ma_, P0[15], P1[15]); \
        float mt_ = vmax2_(ma_, mc_); \
        auto rr_ = __builtin_amdgcn_permlane32_swap(__float_as_uint(mt_), __float_as_uint(mt_), false, false); out = vmax2_(__uint_as_float(rr_[0]), __uint_as_float(rr_[1])); } while (0)
    ATT_DMA_K(0, KS0); ATT_DMA_V(0, VS0); ATT_DMA_K(1, KS0 + KSL); ATT_DMA_K(2, KS0 + 2 * KSL); ATT_DMA_V(1, VS0 + VSL);
    __syncthreads();
    float mhat = 0.f; f32x16 o[3], negm; float ls[4] = {0.f, 0.f, 0.f, 0.f};
#pragma unroll
    for (int r = 0; r < 16; ++r) { o[0][r] = 0.f; o[1][r] = 0.f; o[2][r] = 0.f; negm[r] = 0.f; }
    const int vbl = (int)lds0 + ((lane >> 4) & 1) * 32 + (lane & 3) * 8 + (4 * hi + ((lane & 15) >> 2)) * 64;
    f32x16 sA0, sA1, sB0, sB1;
    ATT_QK(sA0, sA1, KS0, negm);
    asm volatile("s_nop 15\n\ts_nop 3" : "+v"(sA0), "+v"(sA1));
    { float rm; ATT_ROWMAX(sA0, sA1, rm); mhat = rm;
#pragma unroll
      for (int r = 0; r < 16; ++r) { sA0[r] -= rm; sA1[r] -= rm; negm[r] = -rm; } }
    __syncthreads();
    int k0 = KS0, k1 = KS0 + KSL, k2 = KS0 + 2 * KSL, v0 = VS0, v1 = VS0 + VSL, v2 = VS0 + 2 * VSL;
#define ATT_WAITBAR(n) asm volatile("s_waitcnt vmcnt(" #n ") lgkmcnt(0)\n\ts_barrier" ::: "memory")
#define ATT_EXPCVT(C0, C1, lo_, hi_) do { _Pragma("unroll") for (int e = (lo_); e < (hi_); e += 2) { \
            if (e < 16) { const float x0_ = __builtin_amdgcn_exp2f(C0[e & 15]), x1_ = __builtin_amdgcn_exp2f(C0[(e + 1) & 15]); C0[e & 15] = x0_; C0[(e + 1) & 15] = x1_; pw[e >> 3][(e & 7) >> 1] = cvt_pk_bf16(x0_, x1_); } \
            else { const float x0_ = __builtin_amdgcn_exp2f(C1[e & 15]), x1_ = __builtin_amdgcn_exp2f(C1[(e + 1) & 15]); C1[e & 15] = x0_; C1[(e + 1) & 15] = x1_; pw[e >> 3][(e & 7) >> 1] = cvt_pk_bf16(x0_, x1_); } } } while (0)
#define ATT_EXPV(x) ({ float r_; asm volatile("v_exp_f32 %0, %1" : "=v"(r_) : "v"(x)); r_; })
#define ATT_EXPCVTV(C0, C1, lo_, hi_) do { _Pragma("unroll") for (int e = (lo_); e < (hi_); e += 2) { \
            if (e < 16) { const float x0_ = ATT_EXPV(C0[e & 15]), x1_ = ATT_EXPV(C0[(e + 1) & 15]); pw[e >> 3][(e & 7) >> 1] = cvt_pk_bf16(x0_, x1_); ls[e & 2] += x0_; ls[(e & 2) + 1] += x1_; } \
            else { const float x0_ = ATT_EXPV(C1[e & 15]), x1_ = ATT_EXPV(C1[(e + 1) & 15]); pw[e >> 3][(e & 7) >> 1] = cvt_pk_bf16(x0_, x1_); ls[e & 2] += x0_; ls[(e & 2) + 1] += x1_; } } } while (0)
#define ATT_KRD(fa, fb, d0) do { asm volatile("ds_read_b128 %0, %1 offset:%c2" : "=&v"(fa) : "v"(kbp), "i"((d0) * 2048) : "memory"); asm volatile("ds_read_b128 %0, %1 offset:%c2" : "=&v"(fb) : "v"(kbp), "i"((d0) * 2048 + 512) : "memory"); } while (0)
#define ATT_LW(n, fa, fb) do { asm volatile("s_waitcnt lgkmcnt(" #n ")" : "+v"(fa), "+v"(fb) :: "memory"); __builtin_amdgcn_sched_barrier(0); } while (0)
#define ATT_STEP(t, CUR0, CUR1, NXT0, NXT1) do { \
        const bool dk_ = (t) + 3 < NT, dv_ = (t) + 2 < NT; \
        if (dk_) ATT_DMA_K((t) + 3, k0); \
        if (dv_) ATT_DMA_V((t) + 2, v2); \
        if ((t) <= tq) { \
            const LAS char* kbp = shm + k1 + hi * 1024 + r32 * 16; bf16x8 ka0, kb0, ka1, kb1, ka2, kb2; \
            const int vb_ = vbl + v0; s16x4 vl0[4], vh0[4], vl1[4], vh1[4]; \
            float rm; ATT_ROWMAX(CUR0, CUR1, rm); \
            if (__any(rm > (float)THR)) { const float dl = fmaxf(rm, 0.f); mhat += dl; const float f = __builtin_amdgcn_exp2f(-dl); \
                _Pragma("unroll") for (int r = 0; r < 16; ++r) { CUR0[r] -= dl; CUR1[r] -= dl; negm[r] = -mhat; }        \
                if (hi == 0) wsf[r32] = f; \
                _Pragma("unroll") for (int r = 0; r < 16; ++r) { const float a = wsf[crow(r, hi)]; o[0][r] *= a; o[1][r] *= a; } ls[0] *= f; ls[1] *= f; ls[2] *= f; ls[3] *= f; \
                asm volatile("s_waitcnt lgkmcnt(0)" ::: "memory"); } \
            u32x4 pw[4]; \
            {                                                      \
                ATT_KRD(ka0, kb0, 0); ATT_KRD(ka1, kb1, 1); ATT_KRD(ka2, kb2, 2); ATT_LW(4, ka0, kb0); \
                NXT0 = MFMA32(ka0, qr[0], negm); NXT1 = MFMA32(kb0, qr[0], negm); ATT_EXPCVTV(CUR0, CUR1, 0, 6); __builtin_amdgcn_sched_barrier(0); \
                ATT_KRD(ka0, kb0, 3); ATT_LW(4, ka1, kb1); \
                NXT0 = MFMA32(ka1, qr[1], NXT0); NXT1 = MFMA32(kb1, qr[1], NXT1); ATT_EXPCVTV(CUR0, CUR1, 6, 12); __builtin_amdgcn_sched_barrier(0); \
                ATT_KRD(ka1, kb1, 4); ATT_LW(4, ka2, kb2); \
                NXT0 = MFMA32(ka2, qr[2], NXT0); NXT1 = MFMA32(kb2, qr[2], NXT1); ATT_EXPCVTV(CUR0, CUR1, 12, 18); __builtin_amdgcn_sched_barrier(0); \
                ATT_KRD(ka2, kb2, 5); ATT_LW(4, ka0, kb0); \
                NXT0 = MFMA32(ka0, qr[3], NXT0); NXT1 = MFMA32(kb0, qr[3], NXT1); ATT_EXPCVTV(CUR0, CUR1, 18, 24); __builtin_amdgcn_sched_barrier(0); \
                ATT_VRD(vl0, vh0, vb_, 0); ATT_LW(10, ka1, kb1); \
                NXT0 = MFMA32(ka1, qr[4], NXT0); NXT1 = MFMA32(kb1, qr[4], NXT1); ATT_EXPCVTV(CUR0, CUR1, 24, 28); __builtin_amdgcn_sched_barrier(0); \
                ATT_LW(8, ka2, kb2); \
                NXT0 = MFMA32(ka2, qr[5], NXT0); NXT1 = MFMA32(kb2, qr[5], NXT1); ATT_EXPCVTV(CUR0, CUR1, 28, 32); __builtin_amdgcn_sched_barrier(0); \
            } \
            { const bf16x8 pa0 = __builtin_bit_cast(bf16x8, pw[0]), pa1 = __builtin_bit_cast(bf16x8, pw[1]), pa2 = __builtin_bit_cast(bf16x8, pw[2]), pa3 = __builtin_bit_cast(bf16x8, pw[3]); \
              ATT_VRD(vl1, vh1, vb_, 1); \
              asm volatile("s_waitcnt lgkmcnt(8)" : "+v"(vl0[0]), "+v"(vh0[0]), "+v"(vl0[1]), "+v"(vh0[1]), "+v"(vl0[2]), "+v"(vh0[2]), "+v"(vl0[3]), "+v"(vh0[3]) :: "memory"); __builtin_amdgcn_sched_barrier(0); \
              o[0] = MFMA32(pa0, ATT_PK(vl0, vh0, 0), o[0]); o[0] = MFMA32(pa1, ATT_PK(vl0, vh0, 1), o[0]); o[0] = MFMA32(pa2, ATT_PK(vl0, vh0, 2), o[0]); o[0] = MFMA32(pa3, ATT_PK(vl0, vh0, 3), o[0]); \
              asm volatile("s_waitcnt lgkmcnt(0)" : "+v"(vl1[0]), "+v"(vh1[0]), "+v"(vl1[1]), "+v"(vh1[1]), "+v"(vl1[2]), "+v"(vh1[2]), "+v"(vl1[3]), "+v"(vh1[3]) :: "memory"); __builtin_amdgcn_sched_barrier(0); \
              o[1] = MFMA32(pa0, ATT_PK(vl1, vh1, 0), o[1]); o[1] = MFMA32(pa1, ATT_PK(vl1, vh1, 1), o[1]); o[1] = MFMA32(pa2, ATT_PK(vl1, vh1, 2), o[1]); o[1] = MFMA32(pa3, ATT_PK(vl1, vh1, 3), o[1]); } } \
        if (dk_) { if (wid < 4) ATT_WAITBAR(3); else ATT_WAITBAR(2); } else ATT_WAITBAR(0); \
        { const int tk_ = k0; k0 = k1; k1 = k2; k2 = tk_; const int tv_ = v0; v0 = v1; v1 = v2; v2 = tv_; } } while (0)
#pragma unroll
    for (int r = 0; r < 16; ++r) { sB0[r] = 0.f; sB1[r] = 0.f; }
    for (int t = 0; t < NT; t += 2) {
        ATT_STEP(t, sA0, sA1, sB0, sB1);
        ATT_STEP(t + 1, sB0, sB1, sA0, sA1);
    }
#undef ATT_WAITBAR
#undef ATT_STEP
#undef ATT_EXPCVT
#undef ATT_EXPCVTV
#undef ATT_EXPV
#undef ATT_KRD
#undef ATT_LW
#undef ATT_DMA_K
#undef ATT_DMA_V
#undef ATT_QK
#undef ATT_ROWMAX
    float rli[16];
    { float lt = (ls[0] + ls[1]) + (ls[2] + ls[3]); auto rr_ = __builtin_amdgcn_permlane32_swap(__float_as_uint(lt), __float_as_uint(lt), false, false); lt = __uint_as_float(rr_[0]) + __uint_as_float(rr_[1]);
      if (hi == 0) wsf[r32] = __builtin_amdgcn_rcpf(lt); asm volatile("s_waitcnt lgkmcnt(0)" ::: "memory"); }
#pragma unroll
    for (int r = 0; r < 16; ++r) rli[r] = wsf[crow(r, hi)];
    bf16_t* Ow = O + (rowbase + q0 + wid * 32) * ACLD + h * 64;
    { LAS bf16_t* stg = (LAS bf16_t*)(shm + OST) + wid * 2048;
#pragma unroll
      for (int r = 0; r < 16; ++r) { const int orow = crow(r, hi);
#pragma unroll
          for (int d0 = 0; d0 < 2; ++d0) stg[orow * 64 + d0 * 32 + r32] = (bf16_t)f2bf(o[d0][r] * rli[r]); }
#pragma unroll
      for (int i = 0; i < 4; ++i) { const int row = i * 8 + (lane >> 3), ch = lane & 7; const u32x4 v = *(const LAS u32x4*)(stg + row * 64 + ch * 8); *(u32x4*)(Ow + (long)row * ACLD + ch * 8) = v; } }
    __syncthreads();
    __builtin_amdgcn_s_waitcnt(0x0F70);
}
}

namespace ret {
typedef short v4i16_t __attribute__((ext_vector_type(4)));
#define MFMA16(a, b, c) __builtin_amdgcn_mfma_f32_16x16x32_bf16((a), (b), (c), 0, 0, 0)
__device__ __forceinline__ bf16x8 tr16(const LAS char* base, int rs, int k0, int x0, int lane) {
    const int g = lane >> 4, i = lane & 15, q = i >> 2, p = i & 3;
    const LAS char* a = base + (k0 + 8 * g + q) * rs + (x0 + 4 * p) * 2;
    const s16x4 lo = __builtin_bit_cast(s16x4, __builtin_amdgcn_ds_read_tr16_b64_v4i16((LAS v4i16_t*)a));
    const s16x4 hi = __builtin_bit_cast(s16x4, __builtin_amdgcn_ds_read_tr16_b64_v4i16((LAS v4i16_t*)(a + 4 * rs)));
    return (bf16x8){lo[0], lo[1], lo[2], lo[3], hi[0], hi[1], hi[2], hi[3]};
}
constexpr int QI = 0, KI = 17408, VI = 34816, PI = 68608, O32 = 81920;
__device__ __forceinline__ float lg2gamma(int h) { return __builtin_amdgcn_logf(1.0f - __builtin_amdgcn_exp2f(-5.0f - (float)h)); }

constexpr int KVO = 69632;
__device__ __forceinline__ void kvloc_phase(int first, int stride, const bf16_t* Z, bf16_t* RS, LAS char* lds) {
    int tid_ = threadIdx.x; asm volatile("" : "+v"(tid_));
    const int tid = tid_, lane = tid & 63, wid = __builtin_amdgcn_readfirstlane(tid >> 6), g = lane >> 4, i16 = lane & 15;
    if (first >= 1024) return;
    u32x4 kr[2], vr[4];
#define KVL_LOAD(it_) do { const int u_ = (it_) >> 7, n_ = (it_) & 127, bl_ = u_ >> 2, h_ = u_ & 3; const long r0_ = (long)bl_ * SEQ + (long)n_ * 64; \
        _Pragma("unroll") for (int i = 0; i < 2; ++i) { const int p = tid + 512 * i, row = p >> 4, ch = p & 15; kr[i] = *(const u32x4*)(Z + (size_t)(r0_ + row) * ZLD + ZC_RK + h_ * 128 + ch * 8); } \
        _Pragma("unroll") for (int i = 0; i < 4; ++i) { const int p = tid + 512 * i, row = p >> 5, ch = p & 31; vr[i] = *(const u32x4*)(Z + (size_t)(r0_ + row) * ZLD + ZC_RV + h_ * 256 + ch * 8); } } while (0)
    KVL_LOAD(first);
    for (int it = first; it < 1024; it += stride) {
        const int u = it >> 7, n = it & 127, h = u & 3; const float lg = lg2gamma(h);
#pragma unroll
        for (int i = 0; i < 2; ++i) { const int p = tid + 512 * i, row = p >> 4, ch = p & 15; const float sc = __builtin_amdgcn_exp2f(lg * (float)(63 - row)); u32x4 w;
#pragma unroll
            for (int j = 0; j < 4; ++j) w[j] = cvt_pk_bf16(bflo(kr[i][j]) * sc, bfhi(kr[i][j]) * sc);
            *(LAS u32x4*)(lds + KI + row * 272 + ch * 16) = w; }
#pragma unroll
        for (int i = 0; i < 4; ++i) { const int p = tid + 512 * i, row = p >> 5, ch = p & 31; *(LAS u32x4*)(lds + VI + row * 528 + ch * 16) = vr[i]; }
        __syncthreads();
        if (it + stride < 1024) KVL_LOAD(it + stride);
        bf16x8 bfr[2][2];
#pragma unroll
        for (int n2 = 0; n2 < 2; ++n2)
#pragma unroll
            for (int ks = 0; ks < 2; ++ks) bfr[n2][ks] = tr16(lds + VI, 528, 32 * ks, 32 * wid + 16 * n2, lane);
#pragma unroll 2
        for (int mi = 0; mi < 8; ++mi) { const bf16x8 a0 = tr16(lds + KI, 272, 0, 16 * mi, lane), a1 = tr16(lds + KI, 272, 32, 16 * mi, lane);
#pragma unroll
            for (int n2 = 0; n2 < 2; ++n2) { f32x4 acc = {0.f, 0.f, 0.f, 0.f}; acc = MFMA16(a0, bfr[n2][0], acc); acc = MFMA16(a1, bfr[n2][1], acc);
                const int c = 32 * wid + 16 * n2 + i16, d = 16 * mi + 4 * g; u32x2 w; w.x = cvt_pk_bf16(acc[0], acc[1]); w.y = cvt_pk_bf16(acc[2], acc[3]);
                *(LAS u32x2*)(lds + KVO + c * 272 + d * 2) = w; } }
        __syncthreads();
        u32x4* dst = (u32x4*)(RS + (size_t)(u * 128 + n) * 32768);
#pragma unroll
        for (int i = 0; i < 8; ++i) { const int p = tid + 512 * i, row = p >> 4, ch = p & 15; dst[p] = *(const LAS u32x4*)(lds + KVO + row * 272 + ch * 16); }
    }
    __syncthreads();
#undef KVL_LOAD
}

__device__ __forceinline__ void scan_all(bf16_t* RS, int gtid, int gthreads) {
    for (int idx = gtid; idx < 8 * 16384; idx += gthreads) {
        const int u = idx >> 14, e2 = idx & 16383, h = u & 3; const float cd = __builtin_amdgcn_exp2f(lg2gamma(h) * 64.0f);
        unsigned* p = (unsigned*)(RS + (size_t)u * 128 * 32768) + e2;
        float s0 = 0.f, s1 = 0.f; unsigned v[8], vn[8];
#pragma unroll
        for (int k = 0; k < 8; ++k) vn[k] = p[(size_t)k * 16384];
        for (int n = 0; n < 128; n += 8) {
#pragma unroll
            for (int k = 0; k < 8; ++k) v[k] = vn[k];
            if (n + 8 < 128) {
#pragma unroll
                for (int k = 0; k < 8; ++k) vn[k] = p[(size_t)(n + 8 + k) * 16384]; }
#pragma unroll
            for (int k = 0; k < 8; ++k) { const unsigned w = cvt_pk_bf16(s0, s1); s0 = s0 * cd + bflo(v[k]); s1 = s1 * cd + bfhi(v[k]); p[(size_t)(n + k) * 16384] = w; } }
    }
}

__device__ __forceinline__ void out_phase(int first, int stride, const bf16_t* Z, const bf16_t* RS, bf16_t* AC, LAS char* lds) {
    int tid_ = threadIdx.x; asm volatile("" : "+v"(tid_));
    const int tid = tid_, lane = tid & 63, wid = __builtin_amdgcn_readfirstlane(tid >> 6), g = lane >> 4, i16 = lane & 15;
    if (first >= 1024) return;
    u32x4 qr_[2], kr_[2], vr_[4]; bf16x8 sfr[2][4];
#define RO_LOAD_S(it_) do { const int u_ = (it_) >> 7, n_ = (it_) & 127; const bf16_t* sp = RS + (size_t)(u_ * 128 + n_) * 32768; \
        _Pragma("unroll") for (int n2 = 0; n2 < 2; ++n2) _Pragma("unroll") for (int ks = 0; ks < 4; ++ks) sfr[n2][ks] = *(const bf16x8*)(sp + (32 * wid + 16 * n2 + i16) * 128 + 32 * ks + 8 * g); } while (0)
#define RO_LOAD(it_) do { const int u_ = (it_) >> 7, n_ = (it_) & 127, bl_ = u_ >> 2, h_ = u_ & 3; const long r0_ = (long)bl_ * SEQ + (long)n_ * 64; \
        _Pragma("unroll") for (int i = 0; i < 2; ++i) { const int p = tid + 512 * i, row = p >> 4, ch = p & 15; const bf16_t* zr = Z + (size_t)(r0_ + row) * ZLD + h_ * 128 + ch * 8; \
            qr_[i] = *(const u32x4*)(zr + ZC_RQ); kr_[i] = *(const u32x4*)(zr + ZC_RK); } \
        _Pragma("unroll") for (int i = 0; i < 4; ++i) { const int p = tid + 512 * i, row = p >> 5, ch = p & 31; vr_[i] = *(const u32x4*)(Z + (size_t)(r0_ + row) * ZLD + ZC_RV + h_ * 256 + ch * 8); } } while (0)
    RO_LOAD_S(first);
    RO_LOAD(first);
    for (int it = first; it < 1024; it += stride) {
        const int u = it >> 7, n = it & 127, bl = u >> 2, h = u & 3; const long row0 = (long)bl * SEQ + (long)n * 64; const float lg = lg2gamma(h);
        u32x2 gr[8];
#pragma unroll
        for (int i = 0; i < 2; ++i) { const int p = tid + 512 * i, row = p >> 4, ch = p & 15;
            *(LAS u32x4*)(lds + QI + row * 272 + ch * 16) = qr_[i]; *(LAS u32x4*)(lds + KI + row * 272 + ch * 16) = kr_[i]; }
#pragma unroll
        for (int i = 0; i < 4; ++i) { const int p = tid + 512 * i, row = p >> 5, ch = p & 31; *(LAS u32x4*)(lds + VI + row * 528 + ch * 16) = vr_[i]; }
        __syncthreads();
#pragma unroll
        for (int rr = 0; rr < 8; ++rr) gr[rr] = *(const u32x2*)(Z + (size_t)(row0 + 8 * wid + rr) * ZLD + ZC_RG + h * 256 + 4 * lane);
        if (it + stride < 1024) RO_LOAD(it + stride);
#pragma unroll
        for (int t2 = 0; t2 < 2; ++t2) { const int id = 2 * wid + t2, mi = id >> 2, nj = id & 3; f32x4 acc = {0.f, 0.f, 0.f, 0.f};
#pragma unroll
            for (int ks = 0; ks < 4; ++ks) { const bf16x8 a = *(const LAS bf16x8*)(lds + QI + (16 * mi + i16) * 272 + (32 * ks + 8 * g) * 2), b = *(const LAS bf16x8*)(lds + KI + (16 * nj + i16) * 272 + (32 * ks + 8 * g) * 2);
                acc = MFMA16(a, b, acc); }
#pragma unroll
            for (int jj = 0; jj < 4; ++jj) { const int ii = 16 * mi + 4 * g + jj, jc = 16 * nj + i16; const int dd = ii > jc ? ii - jc : jc - ii;
                *(LAS bf16_t*)(lds + PI + ii * 144 + jc * 2) = (bf16_t)f2bf(acc[jj] * __builtin_amdgcn_exp2f(lg * (float)dd)); } }
        __syncthreads();
        f32x4 acc1[4][2], acc2[4][2];
#pragma unroll
        for (int mi = 0; mi < 4; ++mi)
#pragma unroll
            for (int n2 = 0; n2 < 2; ++n2) { acc1[mi][n2] = (f32x4){0.f, 0.f, 0.f, 0.f}; acc2[mi][n2] = (f32x4){0.f, 0.f, 0.f, 0.f}; }
#pragma unroll
        for (int ks = 0; ks < 2; ++ks) { bf16x8 b[2]; b[0] = tr16(lds + VI, 528, 32 * ks, 32 * wid, lane); b[1] = tr16(lds + VI, 528, 32 * ks, 32 * wid + 16, lane);
#pragma unroll
            for (int mi = 0; mi < 4; ++mi) { const bf16x8 a = *(const LAS bf16x8*)(lds + PI + (16 * mi + i16) * 144 + (32 * ks + 8 * g) * 2);
                acc1[mi][0] = MFMA16(a, b[0], acc1[mi][0]); acc1[mi][1] = MFMA16(a, b[1], acc1[mi][1]); } }
#pragma unroll
        for (int ks = 0; ks < 4; ++ks)
#pragma unroll
            for (int mi = 0; mi < 4; ++mi) { const bf16x8 a = *(const LAS bf16x8*)(lds + QI + (16 * mi + i16) * 272 + (32 * ks + 8 * g) * 2);
                acc2[mi][0] = MFMA16(a, sfr[0][ks], acc2[mi][0]); acc2[mi][1] = MFMA16(a, sfr[1][ks], acc2[mi][1]); }
        if (it + stride < 1024) RO_LOAD_S(it + stride);
#pragma unroll
        for (int mi = 0; mi < 4; ++mi)
#pragma unroll
            for (int jj = 0; jj < 4; ++jj) { const int row = 16 * mi + 4 * g + jj; const float qd = __builtin_amdgcn_exp2f(lg * (float)(row + 1));
#pragma unroll
                for (int n2 = 0; n2 < 2; ++n2) *(LAS float*)(lds + O32 + (row * 260 + 32 * wid + 16 * n2 + i16) * 4) = acc1[mi][n2][jj] + qd * acc2[mi][n2][jj]; }
        __syncthreads();
#pragma unroll
        for (int rr = 0; rr < 8; ++rr) { const int row = 8 * wid + rr; const f32x4 v = *(const LAS f32x4*)(lds + O32 + (row * 260 + 4 * lane) * 4);
            const float ss = wave_sum(v[0] * v[0] + v[1] * v[1] + v[2] * v[2] + v[3] * v[3]); const float rstd = rsqrtf(ss * (1.0f / 256.0f) + EPS);
            u32x2 w; w.x = cvt_pk_bf16(siluf_(bflo(gr[rr].x)) * v[0] * rstd, siluf_(bfhi(gr[rr].x)) * v[1] * rstd); w.y = cvt_pk_bf16(siluf_(bflo(gr[rr].y)) * v[2] * rstd, siluf_(bfhi(gr[rr].y)) * v[3] * rstd);
            *(u32x2*)(AC + (size_t)(row0 + row) * ACLD + 1024 + h * 256 + 4 * lane) = w; }
    }
    __syncthreads();
#undef RO_LOAD
#undef RO_LOAD_S
}
}

__device__ __forceinline__ float rs36_xor_dpp(float v, int which) {
    const int x = __builtin_bit_cast(int, v); int r;
    if (which == 8) r = __builtin_amdgcn_update_dpp(x, x, 0x128, 0xF, 0xF, false);
    else if (which == 2) r = __builtin_amdgcn_update_dpp(x, x, 0x4E, 0xF, 0xF, false);
    else r = __builtin_amdgcn_update_dpp(x, x, 0xB1, 0xF, 0xF, false);
    return __builtin_bit_cast(float, r);
}
__device__ __forceinline__ float reduce_scatter36(const float (&v)[36], int lane) {
    float a[18], b[9], c[5], d[3], e[2];
#pragma unroll
    for (int i = 0; i < 18; ++i) { auto rr = __builtin_amdgcn_permlane32_swap(__float_as_uint(v[i]), __float_as_uint(v[i + 18]), false, false); a[i] = __uint_as_float(rr[0]) + __uint_as_float(rr[1]); }
#pragma unroll
    for (int i = 0; i < 9; ++i) { auto rr = __builtin_amdgcn_permlane16_swap(__float_as_uint(a[i]), __float_as_uint(a[i + 9]), false, false); b[i] = __uint_as_float(rr[0]) + __uint_as_float(rr[1]); }
    const bool b3 = (lane & 8) != 0, b2 = (lane & 4) != 0, b1 = (lane & 2) != 0, b0 = (lane & 1) != 0;
#pragma unroll
    for (int i = 0; i < 5; ++i) { const float x = b[i], y = (i + 5 < 9) ? b[i + 5] : 0.f; c[i] = (b3 ? y : x) + rs36_xor_dpp(b3 ? x : y, 8); }
#pragma unroll
    for (int i = 0; i < 3; ++i) { const float x = c[i], y = (i + 3 < 5) ? c[i + 3] : 0.f; const float snd = b2 ? x : y;
        d[i] = (b2 ? y : x) + __builtin_bit_cast(float, __builtin_amdgcn_ds_swizzle(__builtin_bit_cast(int, snd), 0x101F)); }
#pragma unroll
    for (int i = 0; i < 2; ++i) { const float x = d[i], y = (i + 2 < 3) ? d[i + 2] : 0.f; e[i] = (b1 ? y : x) + rs36_xor_dpp(b1 ? x : y, 2); }
    return (b0 ? e[1] : e[0]) + rs36_xor_dpp(b0 ? e[0] : e[1], 1);
}
__device__ __forceinline__ int rs36_index(int lane) { return (lane & 1) + 2 * ((lane >> 1) & 1) + 3 * ((lane >> 2) & 1) + 5 * ((lane >> 3) & 1) + 9 * ((lane >> 4) & 1) + 18 * ((lane >> 5) & 1); }
__device__ __forceinline__ bool rs36_valid(int lane) { const int r = (lane & 1) + 2 * ((lane >> 1) & 1), q = r + 3 * ((lane >> 2) & 1), pp = q + 5 * ((lane >> 3) & 1); return r < 3 && q < 5 && pp < 9; }

struct Args {
    const float* in[25]; float* out; unsigned char* ws;
    float invR[64]; float invM[16];
};
constexpr int NW = 8;

__device__ __forceinline__ void tr_item(const float* W, int N, int k0, int n0, bf16_t* WT, int ldk, int drow0, int dk0, const float* kscale, LAS float* scr, int lane, float cs = 1.0f) {
    f32x4 v[8]; const int rsub = lane >> 3, c4 = (lane & 7) * 4;
#pragma unroll
    for (int i = 0; i < 8; ++i) v[i] = *(const f32x4*)(W + (size_t)(k0 + 8 * i + rsub) * N + n0 + c4);
    if (kscale) {
#pragma unroll
        for (int i = 0; i < 8; ++i) v[i] = v[i] * kscale[k0 + 8 * i + rsub]; }
    if (cs != 1.0f) {
#pragma unroll
        for (int i = 0; i < 8; ++i) v[i] = v[i] * cs; }
#pragma unroll
    for (int i = 0; i < 8; ++i) { LAS float* d = scr + (8 * i + rsub) * 33 + c4; d[0] = v[i][0]; d[1] = v[i][1]; d[2] = v[i][2]; d[3] = v[i][3]; }
    asm volatile("s_waitcnt lgkmcnt(0)" ::: "memory");
    const int c = lane & 7;
#pragma unroll
    for (int j = 0; j < 4; ++j) { const int n = (lane >> 3) + 8 * j; const LAS float* s = scr + (8 * c) * 33 + n;
        u32x4 o; o.x = pk2(s[0 * 33], s[1 * 33]); o.y = pk2(s[2 * 33], s[3 * 33]); o.z = pk2(s[4 * 33], s[5 * 33]); o.w = pk2(s[6 * 33], s[7 * 33]);
        *(u32x4*)(WT + (size_t)(drow0 + n) * ldk + dk0 + 8 * c) = o; }
    asm volatile("s_waitcnt lgkmcnt(0)" ::: "memory");
}

constexpr int MI_IN = 16 * 261, MI_UQ = 6 * 24, MI_UKV = 4 * 32, MI_OM = 8 * 32, MI_OC = 8 * 32, MI_OR = 16 * 32, MI_MX = 16 * 32, MI_PAD = 96;
constexpr int MI_TOTAL = MI_IN + MI_UQ + MI_UKV + MI_OM + MI_OC + MI_OR + MI_MX + MI_PAD;
#define PTP(i) ((const float*)(const GAS float*)PT[i])
__device__ __forceinline__ void mixer_weight_item(volatile LAS unsigned long long* PT, int l, int it, unsigned char* wl, LAS float* scr, int lane) {
    bf16_t* WinT = (bf16_t*)(wl + WM_IN); bf16_t* WuqT = (bf16_t*)(wl + WM_UQ); bf16_t* WukvT = (bf16_t*)(wl + WM_UKV); bf16_t* WcatT = (bf16_t*)(wl + WM_CAT); bf16_t* WmixT = (bf16_t*)(wl + WM_MIX);
    int r = it;
    if (r < MI_IN) { const int kb = r / 261, nb = r % 261; tr_item(PTP(7) + (size_t)l * 1024 * IN_TOTAL, IN_TOTAL, 64 * kb, 32 * nb, WinT, 1024, 32 * nb, 64 * kb, nullptr, scr, lane, (32 * nb >= ZC_GL) ? -1.4426950408889634f : 1.0f); return; } r -= MI_IN;
    if (r < MI_UQ) { const int kb = r / 24, nb = r % 24; tr_item(PTP(10) + (size_t)l * 384 * 768, 768, 64 * kb, 32 * nb, WuqT, 384, 32 * nb, 64 * kb, PTP(8) + l * 384, scr, lane); return; } r -= MI_UQ;
    if (r < MI_UKV) { const int kb = r / 32, nb = r % 32; tr_item(PTP(11) + (size_t)l * 256 * 1024, 1024, 64 * kb, 32 * nb, WukvT, 256, 32 * nb, 64 * kb, PTP(9) + l * 256, scr, lane); return; } r -= MI_UKV;
    if (r < MI_OM) { const int kb = r / 32, nb = r % 32; tr_item(PTP(12) + (size_t)l * 512 * 1024, 1024, 64 * kb, 32 * nb, WcatT, ACLD, 32 * nb, 64 * kb, nullptr, scr, lane); return; } r -= MI_OM;
    if (r < MI_OC) { const int kb = r / 32, nb = r % 32; tr_item(PTP(14) + (size_t)l * 512 * 1024, 1024, 64 * kb, 32 * nb, WcatT, ACLD, 32 * nb, 512 + 64 * kb, nullptr, scr, lane); return; } r -= MI_OC;
    if (r < MI_OR) { const int kb = r / 32, nb = r % 32; tr_item(PTP(15) + (size_t)l * 1024 * 1024, 1024, 64 * kb, 32 * nb, WcatT, ACLD, 32 * nb, 1024 + 64 * kb, nullptr, scr, lane); return; } r -= MI_OR;
    if (r < MI_MX) { const int kb = r / 32, nb = r % 32; tr_item(PTP(16) + (size_t)l * 1024 * 1024, 1024, 64 * kb, 32 * nb, WmixT, 1024, 32 * nb, 64 * kb, nullptr, scr, lane); return; } r -= MI_MX;
    { u32x4* p = (u32x4*)(WinT + (size_t)(IN_TOTAL + r) * 1024); unsigned zz = 0u; asm volatile("" : "+v"(zz)); const u32x4 z4 = {zz, zz, zz, zz}; p[lane] = z4; p[lane + 64] = z4; }
}
constexpr int EI_G = 16 * 16, EI_D = 8 * 32, EI_GU_TOTAL = NEXP * 2 * EI_G, EI_D_TOTAL = NEXP * EI_D;
__device__ __forceinline__ void expert_gu_item(volatile LAS unsigned long long* PT, int l, int it, unsigned char* wexp, LAS float* scr, int lane) {
    const int e = it / (2 * EI_G); int r = it % (2 * EI_G);
    bf16_t* Wgu = (bf16_t*)(wexp + WE_GU) + (size_t)e * 1024 * 1024;
    const size_t eo = ((size_t)l * NEXP + e) * 1024 * 512;
    if (r < EI_G) { const int kb = r / 16, nb = r % 16, n0 = 32 * nb; tr_item(PTP(21) + eo, 512, 64 * kb, n0, Wgu, 1024, (n0 >> 7) * 256 + (n0 & 127), 64 * kb, nullptr, scr, lane); return; } r -= EI_G;
    { const int kb = r / 16, nb = r % 16, n0 = 32 * nb; tr_item(PTP(22) + eo, 512, 64 * kb, n0, Wgu, 1024, (n0 >> 7) * 256 + 128 + (n0 & 127), 64 * kb, nullptr, scr, lane); }
}
__device__ __forceinline__ void expert_d_item(volatile LAS unsigned long long* PT, int l, int it, unsigned char* wexp, LAS float* scr, int lane) {
    const int e = it / EI_D, r = it % EI_D;
    bf16_t* Wd = (bf16_t*)(wexp + WE_D) + (size_t)e * 1024 * 512;
    const size_t eo = ((size_t)l * NEXP + e) * 1024 * 512;
    { const int kb = r / 32, nb = r % 32; tr_item(PTP(23) + eo, 1024, 64 * kb, 32 * nb, Wd, 512, 32 * nb, 64 * kb, nullptr, scr, lane); }
}

__device__ __forceinline__ void sincos_acc(float angf, float& s, float& c) {
    const double a = (double)angf; const double k = rint(a * 0.15915494309189535); double r = a - k * 6.283185307179586;
    double sgn = 1.0; if (r > 1.5707963267948966) { r = 3.141592653589793 - r; sgn = -1.0; } else if (r < -1.5707963267948966) { r = -3.141592653589793 - r; sgn = -1.0; }
    const double x2 = r * r;
    double ps = -1.0 / 1307674368000.0; ps = ps * x2 + 1.0 / 6227020800.0; ps = ps * x2 - 1.0 / 39916800.0; ps = ps * x2 + 1.0 / 362880.0; ps = ps * x2 - 1.0 / 5040.0; ps = ps * x2 + 1.0 / 120.0; ps = ps * x2 - 1.0 / 6.0; ps = ps * x2 + 1.0;
    double pc = 1.0 / 20922789888000.0; pc = pc * x2 - 1.0 / 87178291200.0; pc = pc * x2 + 1.0 / 479001600.0; pc = pc * x2 - 1.0 / 3628800.0; pc = pc * x2 + 1.0 / 40320.0; pc = pc * x2 - 1.0 / 720.0; pc = pc * x2 + 1.0 / 24.0; pc = pc * x2 - 0.5; pc = pc * x2 + 1.0;
    s = (float)(r * ps); c = (float)(sgn * pc);
}

__device__ __forceinline__ void norm_row(const float* xrow, bf16_t* orow, const float* g, const float* mod, int which, int lane, f32x4* hout) {
    const f32x4* xr = (const f32x4*)xrow + lane;
    f32x4 v[4]; float ss = 0.f;
#pragma unroll
    for (int j = 0; j < 4; ++j) { v[j] = xr[64 * j]; ss += (v[j][0] * v[j][0] + v[j][1] * v[j][1]) + (v[j][2] * v[j][2] + v[j][3] * v[j][3]); }
    const float rstd = rsqrtf(wave_sum(ss) * (1.0f / DM) + EPS);
    const f32x4* g4 = (const f32x4*)g + lane; const f32x4* sh4 = (const f32x4*)(mod + which * 3072) + lane; const f32x4* sc4 = (const f32x4*)(mod + which * 3072 + 1024) + lane;
    u32x2* o8 = (u32x2*)orow + lane;
#pragma unroll
    for (int j = 0; j < 4; ++j) { const f32x4 hv = v[j] * rstd * g4[64 * j] * (sc4[64 * j] + 1.0f) + sh4[64 * j]; if (hout) hout[j] = hv;
        u32x2 w; w.x = cvt_pk_bf16(hv[0], hv[1]); w.y = cvt_pk_bf16(hv[2], hv[3]); o8[64 * j] = w; }
}

__device__ __forceinline__ float sumsq8(u32x4 v) { float s = 0.f;
#pragma unroll
    for (int j = 0; j < 4; ++j) { const float a = bflo(v[j]), b = bfhi(v[j]); s += a * a + b * b; } return s; }

__device__ __forceinline__ void prep_rows2(int r0, int tg0, bf16_t* Z, bf16_t* KR, bf16_t* AC, float* rstdq, float* rstdkv,
                                           const float* cosR, const float* sinR, const float* cosM, const float* sinM, const f32x4 (&cw)[3][2], int lane) {
    bf16_t* zr = Z + (size_t)r0 * ZLD;
    const int s0 = tg0 & (SEQ - 1); const int ch = lane * 8;
    u32x4 ql[2], kvl[2];
#pragma unroll
    for (int i = 0; i < 2; ++i) { ql[i] = (lane < 48) ? *(const u32x4*)(zr + i * ZLD + ZC_QLAT + lane * 8) : (u32x4){0u, 0u, 0u, 0u}; kvl[i] = (lane < 32) ? *(const u32x4*)(zr + i * ZLD + ZC_KVLAT + lane * 8) : (u32x4){0u, 0u, 0u, 0u}; }
    u32x4 cc[4], cx[4], cb[2];
#pragma unroll
    for (int i = 0; i < 4; ++i) { const int back = 2 - i; if (s0 >= back) { const bf16_t* zz = zr - (long)back * ZLD; cc[i] = *(const u32x4*)(zz + ZC_CC + ch); cx[i] = *(const u32x4*)(zz + ZC_CX + ch); } else { cc[i] = (u32x4){0u, 0u, 0u, 0u}; cx[i] = cc[i]; } }
    cb[0] = *(const u32x4*)(zr + ZC_CB + ch); cb[1] = *(const u32x4*)(zr + ZLD + ZC_CB + ch);
    const int hl = lane >> 5, hh = (lane & 31) >> 3, i0 = (lane & 7) * 8;
    u32x4 ra[2], rb[2]; f32x4 rc[2], rs[2];
#pragma unroll
    for (int q = 0; q < 2; ++q) { rc[q] = *(const f32x4*)(cosR + (size_t)(tg0 + hl) * 64 + i0 + 4 * q); rs[q] = *(const f32x4*)(sinR + (size_t)(tg0 + hl) * 64 + i0 + 4 * q); }
#pragma unroll
    for (int tsel = 0; tsel < 2; ++tsel) { const bf16_t* base = zr + hl * ZLD + (tsel ? ZC_RK : ZC_RQ) + hh * 128 + i0; ra[tsel] = *(const u32x4*)base; rb[tsel] = *(const u32x4*)(base + 64); }
    const int prow = (lane >> 4) & 1, pi = lane & 15;
    float kx1 = 0.f, kx2 = 0.f, kc = 0.f, ks = 0.f;
    if (lane < 32) { kx1 = bf1(zr[prow * ZLD + ZC_KROPE + pi]); kx2 = bf1(zr[prow * ZLD + ZC_KROPE + 16 + pi]); kc = cosM[(size_t)(tg0 + prow) * 16 + pi]; ks = sinM[(size_t)(tg0 + prow) * 16 + pi]; }
#pragma unroll
    for (int i = 0; i < 2; ++i) { const float sq = wave_sum(sumsq8(ql[i])), skv = wave_sum(sumsq8(kvl[i]));
        if (lane == 0) { rstdq[r0 + i] = rsqrtf(sq * (1.0f / 384.0f) + EPS); rstdkv[r0 + i] = rsqrtf(skv * (1.0f / 256.0f) + EPS); } }
    if (lane < 32) { const bf16_t o1 = (bf16_t)f2bf(kx1 * kc - kx2 * ks), o2 = (bf16_t)f2bf(kx1 * ks + kx2 * kc); bf16_t* kr = KR + (size_t)(r0 + prow) * 32 + pi; kr[0] = o1; kr[16] = o2; }
    { float u[4][8];
#pragma unroll
      for (int i = 0; i < 4; ++i)
#pragma unroll
          for (int j = 0; j < 4; ++j) { u[i][2 * j] = bflo(cc[i][j]) * bflo(cx[i][j]); u[i][2 * j + 1] = bfhi(cc[i][j]) * bfhi(cx[i][j]); }
#pragma unroll
      for (int i = 0; i < 2; ++i) { float y[8];
#pragma unroll
          for (int j = 0; j < 8; ++j) y[j] = cw[0][j >> 2][j & 3] * u[i][j] + cw[1][j >> 2][j & 3] * u[i + 1][j] + cw[2][j >> 2][j & 3] * u[i + 2][j];
          u32x4 w;
#pragma unroll
          for (int j = 0; j < 4; ++j) w[j] = cvt_pk_bf16(bflo(cb[i][j]) * y[2 * j], bfhi(cb[i][j]) * y[2 * j + 1]);
          *(u32x4*)(AC + (size_t)(r0 + i) * ACLD + 512 + ch) = w; } }
#pragma unroll
    for (int tsel = 0; tsel < 2; ++tsel) { bf16_t* base = zr + hl * ZLD + (tsel ? ZC_RK : ZC_RQ) + hh * 128 + i0; const float scl = tsel ? 0.08838834764831845f : 1.0f;
        const u32x4 a = ra[tsel], b = rb[tsel]; u32x4 wa, wb;
#pragma unroll
        for (int j = 0; j < 4; ++j) { const float xa0 = bflo(a[j]), xa1 = bfhi(a[j]), xb0 = bflo(b[j]), xb1 = bfhi(b[j]);
            const float c0 = rc[j >> 1][(2 * j) & 3], c1 = rc[j >> 1][(2 * j + 1) & 3], s0 = rs[j >> 1][(2 * j) & 3], s1 = rs[j >> 1][(2 * j + 1) & 3];
            wa[j] = cvt_pk_bf16((xa0 * c0 - xb0 * s0) * scl, (xa1 * c1 - xb1 * s1) * scl); wb[j] = cvt_pk_bf16((xa0 * s0 + xb0 * c0) * scl, (xa1 * s1 + xb1 * c1) * scl); }
        *(u32x4*)base = wa; *(u32x4*)(base + 64) = wb; }
}
#ifndef PH_MASK
#define PH_MASK 0xFFFFFFFFu
#endif
#define PH(n) ((PH_MASK >> (n)) & 1u)
#ifndef DUP_MASK
#define DUP_MASK 0u
#endif
#define DUPN(n) (1 + (int)((DUP_MASK >> (n)) & 1u))
#define WSP() ((unsigned char*)INP(25))
#define OUTP() ((float*)INP(26))
#define GRIDBAR() do { XcdBarrier _b; _b.bar = (unsigned*)(WSP() + WS_CTL) + CW_BAR; _b.x = xb_xcc_id(); _b.st = MISC + 8; xcd_barrier(_b); __builtin_amdgcn_s_waitcnt(0x0F70);   } while (0)
#define LDSP(off) ({ LAS unsigned char* _b = (LAS unsigned char*)lds_raw; asm volatile("" : "+v"(_b)); _b + (off); })
#define INP(i) ({ const unsigned long long _v = *(volatile LAS unsigned long long*)LDSP(MISC_OFF + 512 + 8 * (i)); (const float*)(const GAS float*)(((unsigned long long)(unsigned)__builtin_amdgcn_readfirstlane((int)(_v >> 32)) << 32) | (unsigned long long)(unsigned)__builtin_amdgcn_readfirstlane((int)_v)); })
#ifndef TPROBE_MASK
#define TPROBE_MASK 0u
#endif
#define TPROBE_AMP 4ull
#ifndef TPROBE2_MASK
#define TPROBE2_MASK 0u
#endif
#define TSEGB(k) do { if (TPROBE2_MASK != 0u && blockIdx.x == 0 && threadIdx.x == 0) { volatile LAS unsigned long long* tp_ = (volatile LAS unsigned long long*)LDSP(MISC_OFF + 64); \
    const unsigned long long now_ = __builtin_amdgcn_s_memrealtime(); if ((TPROBE2_MASK >> (k)) & 1u) tp_[1] += now_ - tp_[0]; } } while (0)
#define TSEG(k) do { if ((TPROBE_MASK | TPROBE2_MASK) != 0u && blockIdx.x == 0 && threadIdx.x == 0) { volatile LAS unsigned long long* tp_ = (volatile LAS unsigned long long*)LDSP(MISC_OFF + 64); \
    const unsigned long long now_ = __builtin_amdgcn_s_memrealtime(); if ((TPROBE_MASK >> (k)) & 1u) tp_[1] += now_ - tp_[0]; tp_[0] = now_; } } while (0)
#define PHASE_BEGIN unsigned char* w_ = WSP(); LAS unsigned char* lds = LDSP(0); LAS int* TP = (LAS int*)(lds + MISC_OFF + 256); \
    volatile LAS unsigned long long* PT = (volatile LAS unsigned long long*)(lds + MISC_OFF + 512); (void)TP; (void)PT; \
    int bx = blockIdx.x; asm volatile("" : "+s"(bx)); int tid = tid0; asm volatile("" : "+v"(tid)); \
    const int lane = tid & 63, wave = __builtin_amdgcn_readfirstlane(tid >> 6), gw = bx * NW + wave, NGW = G * NW; (void)lane; (void)gw; (void)NGW; \
    float* const xres = OUTP(); (void)xres;
__global__ void __launch_bounds__(NW * 64, 2) fwd_kernel(Args args) {
    extern __shared__ __attribute__((aligned(16))) unsigned char lds_raw[];
#define MISC ((volatile LAS unsigned*)LDSP(MISC_OFF))
#define TPTR ((LAS int*)LDSP(MISC_OFF + 256))
#define PTAB ((volatile LAS unsigned long long*)LDSP(MISC_OFF + 512))
    const int tid0 = threadIdx.x;
#define G ((int)gridDim.x)

    { LAS unsigned char* lds = LDSP(0); for (int u = tid0; u < 128; u += NW * 64) ((LAS unsigned*)(lds + MISC_OFF))[u] = 0u; }
    { volatile LAS unsigned long long* PT = PTAB;
#pragma unroll
    for (int i = 0; i < 25; ++i) if (tid0 == i) PT[i] = (unsigned long long)args.in[i];
    if (tid0 == 25) PT[25] = (unsigned long long)args.ws;
    if (tid0 == 26) PT[26] = (unsigned long long)args.out; }
    __syncthreads();
    (void)xcd_barrier_post((unsigned*)(WSP() + WS_CTL) + CW_BAR, MISC + 8);
    if ((TPROBE_MASK | TPROBE2_MASK) != 0u && blockIdx.x == 0 && threadIdx.x == 0) { volatile LAS unsigned long long* tp_ = (volatile LAS unsigned long long*)LDSP(MISC_OFF + 64); tp_[0] = __builtin_amdgcn_s_memrealtime(); tp_[1] = 0ull; }

    if (PH(0)) for (int rep_ = 0; rep_ < DUPN(0); ++rep_) {
        PHASE_BEGIN
        float* MODT = (float*)(w_ + WS_MODT);
        LAS float* sc = (LAS float*)lds;
        LAS float* red = (LAS float*)(lds + 16384);
        { const float* cin = INP(1); for (int i = tid; i < 4096; i += NW * 64) sc[i] = siluf_(cin[i]); }
        __syncthreads();
        { const float* wada = INP(3); const float* bada = INP(4);
        for (int it = bx; it < 2 * 192; it += G) {
            const int l = it / 192, c0 = (it % 192) * 32, kp = tid >> 5, col = tid & 31;
            const float* w = wada + (size_t)l * 1024 * 6144 + (size_t)(kp * 64) * 6144 + c0 + col;
            float a0 = 0.f, a1 = 0.f, a2 = 0.f, a3 = 0.f;
#pragma unroll 16
            for (int k = 0; k < 64; ++k) { const float wv = w[(size_t)k * 6144]; const int kk = kp * 64 + k; a0 += sc[kk] * wv; a1 += sc[1024 + kk] * wv; a2 += sc[2048 + kk] * wv; a3 += sc[3072 + kk] * wv; }
            red[(kp * 4 + 0) * 32 + col] = a0; red[(kp * 4 + 1) * 32 + col] = a1; red[(kp * 4 + 2) * 32 + col] = a2; red[(kp * 4 + 3) * 32 + col] = a3;
            __syncthreads();
            if (tid < 128) { const int b = tid >> 5; float s = bada[l * 6144 + c0 + col];
#pragma unroll
                for (int p = 0; p < 16; ++p) s += red[(p * 4 + b) * 32 + col];
                MODT[(size_t)(l * 4 + b) * 6144 + c0 + col] = s; }
            __syncthreads();
        } }
        { const int* pos = (const int*)INP(2);
          float* COSR = (float*)(w_ + WS_COSR); float* SINR = (float*)(w_ + WS_SINR); float* COSM = (float*)(w_ + WS_COSM); float* SINM = (float*)(w_ + WS_SINM);
          for (int i = bx * NW * 64 + tid; i < T * 64; i += G * NW * 64) { const int tg = i >> 6, f = i & 63; float s, c; sincos_acc((float)pos[tg] * args.invR[f], s, c); COSR[i] = c; SINR[i] = s; }
          for (int i = bx * NW * 64 + tid; i < T * 16; i += G * NW * 64) { const int tg = i >> 4, f = i & 15; float s, c; sincos_acc((float)pos[tg] * args.invM[f], s, c); COSM[i] = c; SINM[i] = s; } }
        __syncthreads();
        LAS float* scr = (LAS float*)(lds + wave * 16384);
        for (int it = gw; it < MI_TOTAL; it += NGW) mixer_weight_item(PT, 0, it, w_ + WS_WMIX, scr, lane);
    }
    TSEGB(0); GRIDBAR(); TSEG(0);

    for (int l = 0; l < DEPTH; ++l) {
        for (int half = 0; half < 2; ++half) {
            const int tok0 = half * TH;
            if (l == 0 && half == 0) {
            if (PH(1)) for (int rep_ = 0; rep_ < DUPN(1); ++rep_) { PHASE_BEGIN bf16_t* XN = (bf16_t*)(w_ + WS_ARENA + AR_XN); bf16_t* XNB = (bf16_t*)(w_ + WS_ARENA + AR_XNB); const float* MODT = (const float*)(w_ + WS_MODT);
                const float* xcur = INP(0); const float* gmix = INP(5);
                for (int tg = gw * 2; tg < T; tg += NGW * 2) { const int b = tg / SEQ; const float* mod = MODT + (size_t)(l * 4 + b) * 6144;
                    const f32x4* xa = (const f32x4*)(xcur + (size_t)tg * DM) + lane; const f32x4* xb = xa + DM / 4;
                    f32x4 h0[4], h1[4]; float s0 = 0.f, s1 = 0.f;
#pragma unroll
                    for (int j = 0; j < 4; ++j) { h0[j] = xa[64 * j]; h1[j] = xb[64 * j]; }
#pragma unroll
                    for (int j = 0; j < 4; ++j) { s0 += (h0[j][0] * h0[j][0] + h0[j][1] * h0[j][1]) + (h0[j][2] * h0[j][2] + h0[j][3] * h0[j][3]); s1 += (h1[j][0] * h1[j][0] + h1[j][1] * h1[j][1]) + (h1[j][2] * h1[j][2] + h1[j][3] * h1[j][3]); }
                    const float r0 = rsqrtf(wave_sum(s0) * (1.0f / DM) + EPS), r1 = rsqrtf(wave_sum(s1) * (1.0f / DM) + EPS);
                    const f32x4* g4 = (const f32x4*)gmix + lane; const f32x4* sh4 = (const f32x4*)mod + lane; const f32x4* sc4 = (const f32x4*)(mod + 1024) + lane;
                    u32x2* oa = (u32x2*)((tg < TH ? XN + (size_t)tg * DM : XNB + (size_t)(tg - TH) * DM)) + lane; u32x2* ob = oa + DM / 4;
#pragma unroll
                    for (int j = 0; j < 4; ++j) { const f32x4 a = g4[64 * j] * (sc4[64 * j] + 1.0f), sh = sh4[64 * j]; const f32x4 y0 = h0[j] * r0 * a + sh, y1 = h1[j] * r1 * a + sh;
                        u32x2 w; w.x = cvt_pk_bf16(y0[0], y0[1]); w.y = cvt_pk_bf16(y0[2], y0[3]); oa[64 * j] = w;
                        w.x = cvt_pk_bf16(y1[0], y1[1]); w.y = cvt_pk_bf16(y1[2], y1[3]); ob[64 * j] = w; } } }
            TSEGB(1); GRIDBAR(); TSEG(1);
            }
            if (PH(2)) for (int rep_ = 0; rep_ < DUPN(2); ++rep_) { PHASE_BEGIN
              pg8::Gemm g{(const bf16_t*)(w_ + WS_ARENA + (half ? AR_XNB : AR_XN)), (const bf16_t*)(w_ + WS_WMIX + (size_t)l * WMIX_LAYER + WM_IN), DM, DM, DM, 0u}; pg8::StaticOrder S; S.init(TH, 8192, G, bx);
              pg8::EpiBf16<0> E{(bf16_t*)(w_ + WS_ARENA + AR_Z), ZLD, nullptr, nullptr, 0};
              pg8::gemm_phase<pg8::EpiBf16<0>, pg8::StaticOrder, true>(lds, g, S, E); }
            TSEGB(2); GRIDBAR(); TSEG(2);
            if (PH(3)) for (int rep_ = 0; rep_ < DUPN(3); ++rep_) { PHASE_BEGIN const float* convw = INP(13) + l * 3 * 512;
                { pg8::Gemm g{(const bf16_t*)(w_ + WS_ARENA + (half ? AR_XNB : AR_XN)), (const bf16_t*)(w_ + WS_WMIX + (size_t)l * WMIX_LAYER + WM_IN) + (size_t)8192 * DM, DM, DM, DM, 0u}; pg8::StaticOrder S; S.init(TH, 256, G, bx);
                  pg8::EpiBf16<0> E{(bf16_t*)(w_ + WS_ARENA + AR_Z) + 8192, ZLD, nullptr, nullptr, 0};
                  pg8::gemm_phase<pg8::EpiBf16<0>, pg8::StaticOrder, true>(lds, g, S, E); }
                f32x4 cw[3][2];
#pragma unroll
                for (int k = 0; k < 3; ++k) { cw[k][0] = *(const f32x4*)(convw + k * 512 + lane * 8); cw[k][1] = *(const f32x4*)(convw + k * 512 + lane * 8 + 4); }
                const int nlead = (G > 64) ? 64 : 0;
                const int R1 = nlead ? 9216 : 0;
                for (int pass = 0; pass < 2; ++pass) { const int rlo = pass ? R1 : 0, rhi = pass ? TH : R1;
                  const int vw = pass ? gw : (bx < nlead ? -1 : (bx - nlead) * NW + wave), nvw = pass ? NGW : (G - nlead) * NW;
                  if (vw >= 0) for (int r = rlo + vw * 2; r < rhi; r += nvw * 2)
                    prep_rows2(r, tok0 + r, (bf16_t*)(w_ + WS_ARENA + AR_Z), (bf16_t*)(w_ + WS_ARENA + AR_KROPE), (bf16_t*)(w_ + WS_ARENA + AR_AC), (float*)(w_ + WS_RSTDQ), (float*)(w_ + WS_RSTDKV),
                             (const float*)(w_ + WS_COSR), (const float*)(w_ + WS_SINR), (const float*)(w_ + WS_COSM), (const float*)(w_ + WS_SINM), cw, lane); } }
            TSEGB(3); GRIDBAR(); TSEG(3);
            if (PH(4)) for (int rep_ = 0; rep_ < DUPN(4); ++rep_) { PHASE_BEGIN
              pg8::Gemm g{(const bf16_t*)(w_ + WS_ARENA + AR_Z) + ZC_QLAT, (const bf16_t*)(w_ + WS_WMIX + (size_t)l * WMIX_LAYER + WM_UQ), ZLD, 384, 384, 0u}; pg8::StaticOrder S; S.init(TH, 768, G, bx);
              pg8::EpiBf16<0> E{(bf16_t*)(w_ + WS_ARENA + AR_QB), 768, (const float*)(w_ + WS_RSTDQ), nullptr, 0};
              pg8::gemm_phase<pg8::EpiBf16<0>, pg8::StaticOrder, true>(lds, g, S, E); }
            if (PH(5)) for (int rep_ = 0; rep_ < DUPN(5); ++rep_) { PHASE_BEGIN
              pg8::Gemm g{(const bf16_t*)(w_ + WS_ARENA + AR_Z) + ZC_KVLAT, (const bf16_t*)(w_ + WS_WMIX + (size_t)l * WMIX_LAYER + WM_UKV), ZLD, 256, 256, 0u}; pg8::StaticOrder S; S.init(TH, 1024, G, bx);
              pg8::EpiBf16<1> E{(bf16_t*)(w_ + WS_ARENA + AR_KB), 768, (const float*)(w_ + WS_RSTDKV), (bf16_t*)(w_ + WS_ARENA + AR_VB), 512};
              pg8::gemm_phase<pg8::EpiBf16<1>, pg8::StaticOrder, true>(lds, g, S, E); }
            if (PH(6)) for (int rep_ = 0; rep_ < DUPN(6); ++rep_) { PHASE_BEGIN
              ret::kvloc_phase(bx, G, (const bf16_t*)(w_ + WS_ARENA + AR_Z), (bf16_t*)(w_ + WS_ARENA + AR_RS), (LAS char*)lds); }
            TSEGB(4); GRIDBAR(); TSEG(4);
            if (PH(7)) for (int rep_ = 0; rep_ < DUPN(7); ++rep_) { PHASE_BEGIN
              for (int p = bx; p < 256; p += G) { const int bh = (G % 8 == 0) ? 2 * (p & 7) + ((p >> 3) >> 4) : p >> 4, s = (G % 8 == 0) ? (p >> 3) & 15 : p & 15;
#pragma unroll 1
                for (int k = 0; k < 2; ++k)
                  att::attn_unit<8>(bh >> 3, bh & 7, k ? s : 31 - s, (const bf16_t*)(w_ + WS_ARENA + AR_QB), (const bf16_t*)(w_ + WS_ARENA + AR_KB), (const bf16_t*)(w_ + WS_ARENA + AR_KROPE), (const bf16_t*)(w_ + WS_ARENA + AR_VB), (bf16_t*)(w_ + WS_ARENA + AR_AC),
                                 (const float*)(w_ + WS_COSM), (const float*)(w_ + WS_SINM), tok0, (LAS char*)lds); } }
            if (PH(8)) for (int rep_ = 0; rep_ < DUPN(8); ++rep_) { PHASE_BEGIN ret::scan_all((bf16_t*)(w_ + WS_ARENA + AR_RS), bx * NW * 64 + tid, G * NW * 64); }
            TSEGB(5); GRIDBAR(); TSEG(5);
            if (PH(9)) for (int rep_ = 0; rep_ < DUPN(9); ++rep_) { PHASE_BEGIN
              ret::out_phase(bx, G, (const bf16_t*)(w_ + WS_ARENA + AR_Z), (const bf16_t*)(w_ + WS_ARENA + AR_RS), (bf16_t*)(w_ + WS_ARENA + AR_AC), (LAS char*)lds); }
            TSEGB(6); GRIDBAR(); TSEG(6);
            if (PH(10)) for (int rep_ = 0; rep_ < DUPN(10); ++rep_) { PHASE_BEGIN
              pg8::Gemm g{(const bf16_t*)(w_ + WS_ARENA + AR_AC), (const bf16_t*)(w_ + WS_WMIX + (size_t)l * WMIX_LAYER + WM_CAT), ACLD, ACLD, 2048, 0u}; pg8::StaticOrder S; S.init(TH, DM, G, bx);
              pg8::EpiMerge E{(const bf16_t*)(w_ + WS_ARENA + AR_Z), (bf16_t*)(w_ + WS_ARENA + AR_XN)};
              pg8::gemm_phase<pg8::EpiMerge, pg8::StaticOrder, true>(lds, g, S, E); }
            TSEGB(7); GRIDBAR(); TSEG(7);
            if (PH(11)) for (int rep_ = 0; rep_ < DUPN(11); ++rep_) { PHASE_BEGIN bf16_t* XR = (bf16_t*)(w_ + WS_ARENA + AR_XR) + (size_t)tok0 * DM;
              pg8::Gemm g{(const bf16_t*)(w_ + WS_ARENA + AR_XN), (const bf16_t*)(w_ + WS_WMIX + (size_t)l * WMIX_LAYER + WM_MIX), DM, DM, DM, 0u}; pg8::StaticOrder S; S.init(TH, DM, G, bx);
              pg8::EpiResid E{(l == 0) ? INP(0) + (size_t)tok0 * DM : nullptr, (l == 0) ? nullptr : (const bf16_t*)XR, XR, (const float*)(w_ + WS_MODT) + (size_t)(l * 4 + half * 2) * 6144 + 2048};
              pg8::gemm_phase<pg8::EpiResid, pg8::StaticOrder, true>(lds, g, S, E); }
            if (half == 1) { TSEGB(8); GRIDBAR(); TSEG(8); }
        }
        if (PH(12)) for (int rep_ = 0; rep_ < DUPN(12); ++rep_) {
            PHASE_BEGIN
            constexpr int WPITCH = 2064;
            LAS unsigned char* WAH = lds; LAS unsigned char* WAL = lds + 36 * WPITCH;
            LAS float* SHW = (LAS float*)(lds + 72 * WPITCH);
            LAS float* RSTD = SHW + 48;
            LAS float* LG = (LAS float*)(lds + 72 * WPITCH + 704);
            LAS unsigned* LCNT = (LAS unsigned*)(lds + 72 * WPITCH + 704 + 9472); LAS unsigned* LBASE = LCNT + 32; LAS unsigned* LTOK = LCNT + 64;
            static_assert(72 * WPITCH + 704 + 9472 + 256 + 128 * 24 <= MISC_OFF, "routing LDS map");
            const float* gffn = INP(6) + l * DM; const float* MODT = (const float*)(w_ + WS_MODT);
            bf16_t* H2 = (bf16_t*)(w_ + WS_ARENA + AR_H2); const bf16_t* XR = (const bf16_t*)(w_ + WS_ARENA + AR_XR); unsigned* ROUTE = (unsigned*)(w_ + WS_ROUTE); unsigned* cnt = (unsigned*)(w_ + WS_CTL) + CW_CNT + l * 32 * 16;
            float* AFS = (float*)(w_ + WS_AFS) + (size_t)bx * DM;
            const float* wrg = INP(17) + (size_t)l * 1024 * 4; const float* wre = INP(19) + (size_t)l * 1024 * 32; const float* brg = INP(18) + l * 4; const float* bre = INP(20) + l * 32;
            if (tid < 32) LCNT[tid] = 0u;
            for (int chunk = bx; chunk < T / 128; chunk += G) {
              const int b = (chunk * 128) / SEQ; const float* mod = MODT + (size_t)(l * 4 + b) * 6144;
              { float part[36];
#pragma unroll
                for (int j = 0; j < 36; ++j) part[j] = 0.f;
                for (int k = tid; k < 1024; k += NW * 64) { const float ak = gffn[k] * (mod[4096 + k] + 1.0f), shk = mod[3072 + k]; AFS[k] = ak;
                    float wv[36]; { const f32x4 a = *(const f32x4*)(wrg + k * 4); wv[0] = a[0]; wv[1] = a[1]; wv[2] = a[2]; wv[3] = a[3]; }
#pragma unroll
                    for (int q = 0; q < 8; ++q) { const f32x4 e4 = *(const f32x4*)(wre + k * 32 + q * 4); wv[4 + 4 * q] = e4[0]; wv[5 + 4 * q] = e4[1]; wv[6 + 4 * q] = e4[2]; wv[7 + 4 * q] = e4[3]; }
#pragma unroll
                    for (int j = 0; j < 36; ++j) { const float wa = wv[j] * ak; const unsigned hi = f2bf(wa); const float rem = wa - __builtin_bit_cast(float, hi << 16);
                        *(LAS bf16_t*)(WAH + j * WPITCH + k * 2) = (bf16_t)hi; *(LAS bf16_t*)(WAL + j * WPITCH + k * 2) = (bf16_t)f2bf(rem); part[j] += shk * wv[j]; } }
                const float tot = reduce_scatter36(part, lane);
                if (rs36_valid(lane)) LG[wave * 36 + rs36_index(lane)] = tot; }
              __syncthreads();
              if (tid < 36) { float sacc = (tid < 4) ? brg[tid] : bre[tid - 4];
#pragma unroll
                  for (int w8 = 0; w8 < 8; ++w8) sacc += LG[w8 * 36 + tid];
                  SHW[tid] = sacc; }
              __syncthreads();
              const int i16 = lane & 15, g4 = lane >> 4; const int tok = chunk * 128 + wave * 16 + i16;
              const bf16_t* xrow = XR + (size_t)tok * DM + 8 * g4;
              float ss = 0.f; f32x4 acc[3];
#pragma unroll
              for (int nt = 0; nt < 3; ++nt) acc[nt] = (f32x4){0.f, 0.f, 0.f, 0.f};
#pragma unroll 1
              for (int kh = 0; kh < 2; ++kh) {
                  bf16x8 af[16];
#pragma unroll
                  for (int ks = 0; ks < 16; ++ks) af[ks] = *(const bf16x8*)(xrow + 512 * kh + 32 * ks);
#pragma unroll
                  for (int ks = 0; ks < 16; ++ks) { const u32x4 r = __builtin_bit_cast(u32x4, af[ks]);
#pragma unroll
                      for (int e = 0; e < 4; ++e) { const float x0 = bflo(r[e]), x1 = bfhi(r[e]); ss += x0 * x0 + x1 * x1; } }
                  const int r2 = (32 + i16 < 36) ? 32 + i16 : 35;
                  const LAS unsigned char* wh = WAH + i16 * WPITCH + (512 * kh + 8 * g4) * 2; const LAS unsigned char* wl = WAL + i16 * WPITCH + (512 * kh + 8 * g4) * 2;
                  const int o2 = (r2 - i16) * WPITCH;
#pragma unroll
                  for (int ks = 0; ks < 16; ++ks)
#pragma unroll
                      for (int nt = 0; nt < 3; ++nt) { const int ro = (nt == 2) ? o2 : 16 * nt * WPITCH; const bf16x8 bh = *(const LAS bf16x8*)(wh + ro + 64 * ks), bl = *(const LAS bf16x8*)(wl + ro + 64 * ks);
                          acc[nt] = __builtin_amdgcn_mfma_f32_16x16x32_bf16(af[ks], bh, acc[nt], 0, 0, 0); acc[nt] = __builtin_amdgcn_mfma_f32_16x16x32_bf16(af[ks], bl, acc[nt], 0, 0, 0);
                          if (nt == 2 && (ks & 1)) __builtin_amdgcn_sched_barrier(0); }
              }
              { auto rr = __builtin_amdgcn_permlane16_swap(__float_as_uint(ss), __float_as_uint(ss), false, false); ss = __uint_as_float(rr[0]) + __uint_as_float(rr[1]); }
              { auto rr = __builtin_amdgcn_permlane32_swap(__float_as_uint(ss), __float_as_uint(ss), false, false); ss = __uint_as_float(rr[0]) + __uint_as_float(rr[1]); }
              const float rstd = rsqrtf(ss * (1.0f / DM) + EPS);
              if (g4 == 0) RSTD[wave * 16 + i16] = rstd;
              float lgv[3][4];
#pragma unroll
              for (int jj = 0; jj < 4; ++jj) { const float rt = RSTD[wave * 16 + 4 * g4 + jj];
#pragma unroll
                  for (int nt = 0; nt < 3; ++nt) lgv[nt][jj] = acc[nt][jj] * rt + ((16 * nt + i16 < 36) ? SHW[16 * nt + i16] : 0.f); }
              { bf16_t* hr = H2 + (size_t)tok * DM + 8 * g4; const float* ap = AFS + 8 * g4; const float* sp = mod + 3072 + 8 * g4;
#pragma unroll 4
                for (int ks = 0; ks < 32; ++ks) { const u32x4 r = *(const u32x4*)(xrow + 32 * ks); const f32x4 a0 = *(const f32x4*)(ap + 32 * ks), a1 = *(const f32x4*)(ap + 32 * ks + 4), s0 = *(const f32x4*)(sp + 32 * ks), s1 = *(const f32x4*)(sp + 32 * ks + 4);
                    u32x4 w; w.x = cvt_pk_bf16(bflo(r.x) * rstd * a0[0] + s0[0], bfhi(r.x) * rstd * a0[1] + s0[1]); w.y = cvt_pk_bf16(bflo(r.y) * rstd * a0[2] + s0[2], bfhi(r.y) * rstd * a0[3] + s0[3]);
                    w.z = cvt_pk_bf16(bflo(r.z) * rstd * a1[0] + s1[0], bfhi(r.z) * rstd * a1[1] + s1[1]); w.w = cvt_pk_bf16(bflo(r.w) * rstd * a1[2] + s1[2], bfhi(r.w) * rstd * a1[3] + s1[3]);
                    *(u32x4*)(hr + 32 * ks) = w; } }
#pragma unroll 1
              for (int batch = 0; batch < 2; ++batch) {
                if ((wave >> 2) == batch) {
#pragma unroll
                    for (int jj = 0; jj < 4; ++jj)
#pragma unroll
                        for (int nt = 0; nt < 3; ++nt) if (16 * nt + i16 < 36) LG[((wave & 3) * 16 + 4 * g4 + jj) * 37 + 16 * nt + i16] = lgv[nt][jj]; }
                __syncthreads();
                if (tid < 64) {
                    const int tg = chunk * 128 + batch * 64 + tid; const LAS float* lgp = LG + tid * 37;
                    float gl[4];
#pragma unroll
                    for (int q = 0; q < 4; ++q) gl[q] = lgp[q];
                    float gm = gl[0]; int gi = 0;
#pragma unroll
                    for (int q = 1; q < 4; ++q) if (gl[q] > gm) { gm = gl[q]; gi = q; }
                    float gs = 0.f;
#pragma unroll
                    for (int q = 0; q < 4; ++q) gs += __expf(gl[q] - gm);
                    const float gval = 1.0f / gs;
                    float el[8];
#pragma unroll
                    for (int k = 0; k < 8; ++k) el[k] = lgp[4 + gi * 8 + k];
                    float m1 = el[0]; int i1 = 0;
#pragma unroll
                    for (int k = 1; k < 8; ++k) if (el[k] > m1) { m1 = el[k]; i1 = k; }
                    float m2 = -3.0e38f; int i2 = 0;
#pragma unroll
                    for (int k = 0; k < 8; ++k) if (k != i1 && el[k] > m2) { m2 = el[k]; i2 = k; }
                    const float p2 = __expf(m2 - m1); const float w1 = gval / (1.0f + p2), w2 = gval * p2 / (1.0f + p2);
                    const int e1 = gi * 8 + i1, e2 = gi * 8 + i2;
                    const unsigned r1 = __hip_atomic_fetch_add(LCNT + e1, 1u, __ATOMIC_RELAXED, __HIP_MEMORY_SCOPE_WORKGROUP), r2 = __hip_atomic_fetch_add(LCNT + e2, 1u, __ATOMIC_RELAXED, __HIP_MEMORY_SCOPE_WORKGROUP);
                    LAS unsigned* te = LTOK + (batch * 64 + tid) * 6; te[0] = (unsigned)e1; te[1] = (unsigned)e2; te[2] = __float_as_uint(w1); te[3] = __float_as_uint(w2); te[4] = r1; te[5] = r2;
                }
                __syncthreads();
              }
              if (tid < 32) { const unsigned c = LCNT[tid]; LBASE[tid] = c ? atomicAdd(cnt + tid * 16, c) : 0u; }
              __syncthreads();
              if (tid < 128) { const LAS unsigned* te = LTOK + tid * 6; const int tg = chunk * 128 + tid;
                  u32x4 a; a.x = te[0]; a.y = te[1]; a.z = te[2]; a.w = te[3]; u32x2 rr; rr.x = te[4] + LBASE[te[0]]; rr.y = te[5] + LBASE[te[1]];
                  *(u32x4*)(ROUTE + (size_t)tg * 8) = a; *(u32x2*)(ROUTE + (size_t)tg * 8 + 4) = rr; }
              if (tid < 32) LCNT[tid] = 0u;
              __syncthreads();
            }
        }
        TSEGB(9); GRIDBAR(); TSEG(9);
        if (PH(13)) for (int rep_ = 0; rep_ < DUPN(13); ++rep_) {
            PHASE_BEGIN unsigned* cnt = (unsigned*)(w_ + WS_CTL) + CW_CNT + l * 32 * 16;
            LAS int* CN = (LAS int*)(lds + MISC_OFF + 128);
            if (tid < 32) CN[tid] = (int)__hip_atomic_load(cnt + tid * 16, RLX_AGENT);
            __syncthreads();
            if (tid == 0) { int acc = 0;
                for (int e = 0; e < 32; ++e) { TP[e] = acc; acc += (int)(((unsigned)CN[e] + 255u) >> 8); }
                TP[32] = acc; }
            __syncthreads();
            unsigned* ROUTE = (unsigned*)(w_ + WS_ROUTE); int* PERM = (int*)(w_ + WS_PERM);
            for (int tg = bx * NW * 64 + tid; tg < T; tg += G * NW * 64) {
                const u32x4 a = *(const u32x4*)(ROUTE + (size_t)tg * 8); const u32x2 rk = *(const u32x2*)(ROUTE + (size_t)tg * 8 + 4);
                u32x2 pp; pp.x = (unsigned)TP[a.x] * 256u + rk.x; pp.y = (unsigned)TP[a.y] * 256u + rk.y;
                PERM[pp.x] = tg; PERM[pp.y] = tg; *(u32x2*)(ROUTE + (size_t)tg * 8 + 6) = pp; }
            for (int idx = bx * NW * 64 + tid; idx < 32 * 256; idx += G * NW * 64) { const int e = idx >> 8, i = idx & 255, c = CN[e] & 255;
                if (c != 0 && i >= c) PERM[(TP[e + 1] - 1) * 256 + i] = 0; }
            LAS float* scr = (LAS float*)(lds + wave * 16384);
            for (int it = gw; it < EI_GU_TOTAL; it += NGW) expert_gu_item(PT, l, it, w_ + WS_ARENA + AR_WEXP, scr, lane);
        }
        TSEGB(10); GRIDBAR(); TSEG(10);
        if (PH(14)) for (int rep_ = 0; rep_ < DUPN(14); ++rep_) { PHASE_BEGIN
          pg8::Gemm g{(const bf16_t*)(w_ + WS_ARENA + AR_H2), (const bf16_t*)(w_ + WS_ARENA + AR_WEXP + WE_GU), DM, DM, DM, 1024u * 1024u * 2u, (const int*)(w_ + WS_PERM)}; pg8::ExpertOrder S{TP, G, (G % 8 == 0) ? (bx % 8) * (G / 8) + bx / 8 : bx};
          pg8::EpiGU E{(bf16_t*)(w_ + WS_ARENA + AR_HID)};
          pg8::gemm_phase<pg8::EpiGU, pg8::ExpertOrder, true, true>(lds, g, S, E);
          { const int units = __builtin_amdgcn_readfirstlane(TP[32]) * 4, rem = units % G, nidle = rem ? G - rem : G, ii = rem ? S.c - rem : S.c;
            if (ii >= 0) { LAS float* scr = (LAS float*)(lds + wave * 16384);
              for (int it = ii * NW + wave; it < EI_D_TOTAL; it += nidle * NW) expert_d_item(PT, l, it, w_ + WS_ARENA + AR_WEXP, scr, lane); } } }
        TSEGB(11); GRIDBAR(); TSEG(11);
        if (PH(15)) for (int rep_ = 0; rep_ < DUPN(15); ++rep_) { PHASE_BEGIN
          pg8::Gemm g{(const bf16_t*)(w_ + WS_ARENA + AR_HID), (const bf16_t*)(w_ + WS_ARENA + AR_WEXP + WE_D), EFF, EFF, EFF, 1024u * 512u * 2u}; pg8::ExpertOrder S{TP, G, (G % 8 == 0) ? (bx % 8) * (G / 8) + bx / 8 : bx};
          pg8::EpiBf16<0> E{(bf16_t*)(w_ + WS_ARENA + AR_YS), DM, nullptr, nullptr, 0};
          pg8::gemm_phase<pg8::EpiBf16<0>, pg8::ExpertOrder, true>(lds, g, S, E);
          if (l + 1 < DEPTH) { const int units = __builtin_amdgcn_readfirstlane(TP[32]) * 4, rem = units % G, nidle = rem ? G - rem : G, ii = rem ? S.c - rem : S.c;
            if (ii >= 0) { LAS float* scr = (LAS float*)(lds + wave * 16384);
              for (int it = ii * NW + wave; it < MI_TOTAL; it += nidle * NW) mixer_weight_item(PT, l + 1, it, w_ + WS_WMIX + (size_t)(l + 1) * WMIX_LAYER, scr, lane); } } }
        TSEGB(12); GRIDBAR(); TSEG(12);
        if (PH(16)) for (int rep_ = 0; rep_ < DUPN(16); ++rep_) { PHASE_BEGIN const unsigned* ROUTE = (const unsigned*)(w_ + WS_ROUTE); const bf16_t* YS = (const bf16_t*)(w_ + WS_ARENA + AR_YS); const float* MODT = (const float*)(w_ + WS_MODT);
          bf16_t* XR = (bf16_t*)(w_ + WS_ARENA + AR_XR); const float* fgp = INP(24); const float* gnext = INP(5) + (l + 1 < DEPTH ? (l + 1) * DM : 0); bf16_t* XN = (bf16_t*)(w_ + WS_ARENA + AR_XN); bf16_t* XNB = (bf16_t*)(w_ + WS_ARENA + AR_XNB);
          for (int t4 = gw * 4; t4 < T; t4 += NGW * 4) { const int b = t4 / SEQ;
            const f32x4* gt = (const f32x4*)(MODT + (size_t)(l * 4 + b) * 6144 + 5120) + lane;
            u32x4 a[4]; u32x2 pp[4];
#pragma unroll
            for (int i = 0; i < 4; ++i) { a[i] = *(const u32x4*)(ROUTE + (size_t)(t4 + i) * 8); pp[i] = *(const u32x2*)(ROUTE + (size_t)(t4 + i) * 8 + 6); }
            f32x4 xv[4][4]; u32x2 ya[4][4], yb[4][4];
#pragma unroll
            for (int i = 0; i < 4; ++i) { const u32x2* xr = (const u32x2*)(XR + (size_t)(t4 + i) * DM) + lane; const u32x2* y1 = (const u32x2*)(YS + (size_t)pp[i].x * DM) + lane; const u32x2* y2 = (const u32x2*)(YS + (size_t)pp[i].y * DM) + lane;
#pragma unroll
                for (int j = 0; j < 4; ++j) { const u32x2 rx = xr[64 * j]; xv[i][j] = (f32x4){bflo(rx.x), bfhi(rx.x), bflo(rx.y), bfhi(rx.y)}; ya[i][j] = y1[64 * j]; yb[i][j] = y2[64 * j]; } }
            f32x4 gv[4], na[4], nsh[4];
#pragma unroll
            for (int j = 0; j < 4; ++j) gv[j] = gt[64 * j];
            if (l + 1 < DEPTH) { const float* nmod = MODT + (size_t)((l + 1) * 4 + b) * 6144; const f32x4* g4 = (const f32x4*)gnext + lane; const f32x4* sh4 = (const f32x4*)nmod + lane; const f32x4* sc4 = (const f32x4*)(nmod + 1024) + lane;
#pragma unroll
                for (int j = 0; j < 4; ++j) { na[j] = g4[64 * j] * (sc4[64 * j] + 1.0f); nsh[j] = sh4[64 * j]; } }
            else {
#pragma unroll
                for (int j = 0; j < 4; ++j) { na[j] = (f32x4){0.f, 0.f, 0.f, 0.f}; nsh[j] = na[j]; } }
#pragma unroll
            for (int i = 0; i < 4; ++i) { const float w1 = __uint_as_float(a[i].z), w2 = __uint_as_float(a[i].w); f32x4* xr = (f32x4*)(xres + (size_t)(t4 + i) * DM) + lane; u32x2* xq = (u32x2*)(XR + (size_t)(t4 + i) * DM) + lane; float ss = 0.f;
#pragma unroll
                for (int j = 0; j < 4; ++j) { const f32x4 m = (f32x4){bflo(ya[i][j].x), bfhi(ya[i][j].x), bflo(ya[i][j].y), bfhi(ya[i][j].y)} * w1 + (f32x4){bflo(yb[i][j].x), bfhi(yb[i][j].x), bflo(yb[i][j].y), bfhi(yb[i][j].y)} * w2;
                    xv[i][j] = xv[i][j] + gv[j] * m; ss += (xv[i][j][0] * xv[i][j][0] + xv[i][j][1] * xv[i][j][1]) + (xv[i][j][2] * xv[i][j][2] + xv[i][j][3] * xv[i][j][3]); }
                if (l == DEPTH - 1) { const float rstd = rsqrtf(wave_sum(ss) * (1.0f / DM) + EPS); const f32x4* fg = (const f32x4*)fgp + lane;
#pragma unroll
                    for (int j = 0; j < 4; ++j) xr[64 * j] = xv[i][j] * rstd * fg[64 * j]; }
                else { const float rstd = rsqrtf(wave_sum(ss) * (1.0f / DM) + EPS); const int t_ = t4 + i;
                    u32x2* oh = (u32x2*)((t_ < TH ? XN + (size_t)t_ * DM : XNB + (size_t)(t_ - TH) * DM)) + lane;
#pragma unroll
                    for (int j = 0; j < 4; ++j) { { u32x2 wq; wq.x = cvt_pk_bf16(xv[i][j][0], xv[i][j][1]); wq.y = cvt_pk_bf16(xv[i][j][2], xv[i][j][3]); xq[64 * j] = wq; } const f32x4 y = xv[i][j] * rstd * na[j] + nsh[j]; u32x2 w; w.x = cvt_pk_bf16(y[0], y[1]); w.y = cvt_pk_bf16(y[2], y[3]); oh[64 * j] = w; } } }
          } }
        if (l + 1 < DEPTH) { TSEGB(13); GRIDBAR(); } TSEG(13);
    }
    if ((TPROBE_MASK | TPROBE2_MASK) != 0u && blockIdx.x == 0 && threadIdx.x == 0) { volatile LAS unsigned long long* tp_ = (volatile LAS unsigned long long*)LDSP(MISC_OFF + 64);
        const unsigned long long t0_ = __builtin_amdgcn_s_memrealtime(), w_ = TPROBE_AMP * tp_[1]; while (__builtin_amdgcn_s_memrealtime() - t0_ < w_) __builtin_amdgcn_s_sleep(8); }
}

#undef G
#undef MISC
extern "C" void kernel_launch(void* const* d_in, const int* in_sizes, int n_in, void* d_out, int out_size, void* d_ws, size_t ws_size, hipStream_t stream) {
    static int grid = 0;
    if (grid == 0) {
        if (n_in != 25 || out_size != T * DM || ws_size < WS_END) { fprintf(stderr, "kernel_launch: unexpected shapes (n_in %d, out %d, ws %zu < %zu)\n", n_in, out_size, ws_size, (size_t)WS_END); grid = -1; return; }
        int dev = 0, cus = 0;
        if (hipGetDevice(&dev) != hipSuccess || hipDeviceGetAttribute(&cus, hipDeviceAttributeMultiprocessorCount, dev) != hipSuccess) { grid = -1; return; }
        if (hipFuncSetAttribute((const void*)fwd_kernel, hipFuncAttributeMaxDynamicSharedMemorySize, LDS_BYTES) != hipSuccess) { fprintf(stderr, "kernel_launch: hipFuncSetAttribute failed\n"); grid = -1; return; }
        int per_cu = 0;
        if (hipOccupancyMaxActiveBlocksPerMultiprocessor(&per_cu, (const void*)fwd_kernel, NW * 64, LDS_BYTES) != hipSuccess || per_cu < 1) { fprintf(stderr, "kernel_launch: occupancy query says %d\n", per_cu); }
        (void)hipGetLastError();
        grid = cus;
    }
    if (grid < 0) return;
    (void)hipMemsetAsync((char*)d_ws + WS_CTL, 0, CTL_ZERO_BYTES, stream);
    Args a{};
    for (int i = 0; i < 25; ++i) a.in[i] = (const float*)d_in[i];
    a.out = (float*)d_out; a.ws = (unsigned char*)d_ws;
    for (int i = 0; i < 64; ++i) a.invR[i] = powf(10000.0f, -(float)(2 * i) / 128.0f);
    for (int i = 0; i < 16; ++i) a.invM[i] = powf(10000.0f, -(float)(2 * i) / 32.0f);
    hipLaunchKernelGGL(fwd_kernel, dim3(grid), dim3(NW * 64), LDS_BYTES, stream, a);
    const hipError_t le = hipPeekAtLastError();
    if (le != hipSuccess) fprintf(stderr, "kernel_launch: launch failed: %s\n", hipGetErrorName(le));
}
```
